# Optimizing an MI355X kernel written in HIP

```python
import jax
import jax.numpy as jnp
from jax import lax
import numpy as np

D_MODEL = 1024
BATCH = 32
SEQ = 2048
DEPTH = 1

ATTN_HEAD_DIM = 64
ATTN_WIDTH = D_MODEL // 2
ATTN_HEADS = ATTN_WIDTH // ATTN_HEAD_DIM
HGRN_EXPAND = 128
HGRN_WIDTH = D_MODEL - ATTN_WIDTH
HGRN_HEADS = HGRN_WIDTH // HGRN_EXPAND
HGRN_HEAD_V = HGRN_WIDTH // HGRN_HEADS
IN_SPLITS = (ATTN_WIDTH, ATTN_WIDTH, ATTN_WIDTH, ATTN_HEADS,
             HGRN_WIDTH, HGRN_WIDTH, HGRN_WIDTH, HGRN_WIDTH)
IN_PROJ_WIDTH = 3 * ATTN_WIDTH + ATTN_HEADS + 4 * HGRN_WIDTH
Q_BLOCK = 128
HGRN_CHUNK = 64
N_GROUPS = 4
EXPERTS_PER_GROUP = 4
N_EXPERTS = N_GROUPS * EXPERTS_PER_GROUP
TOP_K_IN_GROUP = 2
D_EXPERT = D_MODEL // 2
NORM_EPS = 1e-6

kernel_name = "hybrid_fox_hgrn2_hmoe_adaln_layer"


def rms_norm(x, g):
    xf = x.astype(jnp.float32)
    y = xf * lax.rsqrt(jnp.mean(xf * xf, axis=-1, keepdims=True) + NORM_EPS)
    return (y * g.astype(jnp.float32)).astype(x.dtype)


def split_heads(t, n_heads):
    b, s, w = t.shape
    return t.reshape(b, s, n_heads, w // n_heads).transpose(0, 2, 1, 3)


def merge_heads(t):
    b, h, s, d = t.shape
    return t.transpose(0, 2, 1, 3).reshape(b, s, h * d)


def forgetting_attention(q, k, v, log_f):
    s_len, dh = q.shape[2], q.shape[3]
    scale = dh ** -0.5
    cum = jnp.cumsum(log_f, axis=-1)
    outs = []
    for i in range(s_len // Q_BLOCK):
        q0 = i * Q_BLOCK
        k_end = q0 + Q_BLOCK
        scores = jnp.einsum('bhqd,bhkd->bhqk', q[:, :, q0:k_end], k[:, :, :k_end]).astype(jnp.float32) * scale
        scores = scores + cum[:, :, q0:k_end, None] - cum[:, :, None, :k_end]
        causal = (q0 + jnp.arange(Q_BLOCK))[:, None] >= jnp.arange(k_end)[None, :]
        scores = jnp.where(causal, scores, -jnp.inf)
        probs = jax.nn.softmax(scores, axis=-1).astype(v.dtype)
        outs.append(jnp.einsum('bhqk,bhkd->bhqd', probs, v[:, :, :k_end]))
    return jnp.concatenate(outs, axis=2)


def hgrn2_chunkwise(q, k, v, log_f):
    b, h, s_len, dk = q.shape
    dv = v.shape[-1]
    n_chunks = s_len // HGRN_CHUNK

    def to_chunks(t):
        return t.reshape(b, h, n_chunks, HGRN_CHUNK, t.shape[-1]).transpose(2, 0, 1, 3, 4)

    tri = jnp.tril(jnp.ones((HGRN_CHUNK, HGRN_CHUNK), dtype=bool))[None, None, :, :, None]

    def step(state, inp):
        qc, kc, vc, gc = inp
        cum = jnp.cumsum(gc, axis=2)
        diff = jnp.where(tri, cum[:, :, :, None, :] - cum[:, :, None, :, :], -jnp.inf)
        scores = jnp.einsum('bhtk,bhtsk,bhsk->bhts', qc, jnp.exp(diff), kc)
        out = jnp.einsum('bhts,bhsv->bhtv', scores, vc) + jnp.einsum('bhtk,bhkv->bhtv', qc * jnp.exp(cum), state)
        last = cum[:, :, -1:, :]
        state = jnp.exp(last[:, :, 0, :])[..., None] * state + jnp.einsum('bhsk,bhsv->bhkv', kc * jnp.exp(last - cum), vc)
        return state, out

    state0 = jnp.zeros((b, h, dk, dv), jnp.float32)
    _, out = lax.scan(step, state0, (to_chunks(q), to_chunks(k), to_chunks(v), to_chunks(log_f)))
    return out.transpose(1, 2, 0, 3, 4).reshape(b, h, s_len, dv)


def hierarchical_moe(h, w_rg, b_rg, w_re, b_re, w_gate, w_up, w_down):
    f32 = jnp.float32
    hf = h.astype(f32)
    group_probs = jax.nn.softmax(hf @ w_rg.astype(f32) + b_rg.astype(f32), axis=-1)
    group_p, group_idx = lax.top_k(group_probs, 1)
    expert_logits = (hf @ w_re.astype(f32) + b_re.astype(f32)).reshape(-1, N_GROUPS, EXPERTS_PER_GROUP)
    group_onehot = jax.nn.one_hot(group_idx[:, 0], N_GROUPS, dtype=f32)
    in_group = jnp.einsum('tg,tge->te', group_onehot, expert_logits)
    top_logits, top_local = lax.top_k(in_group, TOP_K_IN_GROUP)
    weights = jax.nn.softmax(top_logits, axis=-1) * group_p
    expert_ids = group_idx * EXPERTS_PER_GROUP + top_local
    gates = jnp.einsum('tk,tke->te', weights, jax.nn.one_hot(expert_ids, N_EXPERTS, dtype=f32))
    y = jnp.zeros(h.shape, f32)
    for e in range(N_EXPERTS):
        act = jax.nn.silu(h @ w_gate[e]) * (h @ w_up[e])
        y = y + gates[:, e:e + 1] * (act @ w_down[e]).astype(f32)
    return y.astype(h.dtype)


def setup_inputs(seed: int = 0) -> dict:
    key = jax.random.key(seed)
    ks = jax.random.split(key, 21)
    f32 = jnp.float32

    def nrm(k, shape, s):
        return jax.random.normal(k, shape, f32) * s

    return {
        "x": nrm(ks[0], (BATCH, SEQ, D_MODEL), 1.0),
        "c": nrm(ks[1], (BATCH, D_MODEL), 1.0),
        "w_ada": nrm(ks[2], (DEPTH, D_MODEL, 6 * D_MODEL), D_MODEL ** -0.5),
        "b_ada": nrm(ks[3], (DEPTH, 6 * D_MODEL), 0.02),
        "norm1_g": 1.0 + nrm(ks[4], (DEPTH, D_MODEL), 0.02),
        "w_in": nrm(ks[5], (DEPTH, D_MODEL, IN_PROJ_WIDTH), D_MODEL ** -0.5),
        "b_fox": 1.0 + nrm(ks[6], (DEPTH, ATTN_HEADS), 0.1),
        "q_norm_g": 1.0 + nrm(ks[7], (DEPTH, ATTN_HEAD_DIM), 0.02),
        "k_norm_g": 1.0 + nrm(ks[8], (DEPTH, ATTN_HEAD_DIM), 0.02),
        "attn_out_g": 1.0 + nrm(ks[9], (DEPTH, ATTN_WIDTH), 0.02),
        "hgrn_lb": nrm(ks[10], (DEPTH + 1, HGRN_WIDTH), 1.0),
        "hgrn_out_g": 1.0 + nrm(ks[11], (DEPTH, HGRN_WIDTH), 0.02),
        "w_out": nrm(ks[12], (DEPTH, D_MODEL, D_MODEL), D_MODEL ** -0.5),
        "norm2_g": 1.0 + nrm(ks[13], (DEPTH, D_MODEL), 0.02),
        "w_router_group": nrm(ks[14], (DEPTH, D_MODEL, N_GROUPS), D_MODEL ** -0.5),
        "b_router_group": nrm(ks[15], (DEPTH, N_GROUPS), 0.01),
        "w_router_expert": nrm(ks[16], (DEPTH, D_MODEL, N_EXPERTS), D_MODEL ** -0.5),
        "b_router_expert": nrm(ks[17], (DEPTH, N_EXPERTS), 0.01),
        "w_gate": nrm(ks[18], (DEPTH, N_EXPERTS, D_MODEL, D_EXPERT), D_MODEL ** -0.5),
        "w_up": nrm(ks[19], (DEPTH, N_EXPERTS, D_MODEL, D_EXPERT), D_MODEL ** -0.5),
        "w_down": nrm(ks[20], (DEPTH, N_EXPERTS, D_EXPERT, D_MODEL), D_EXPERT ** -0.5),
    }


def reference(x, c, w_ada, b_ada, norm1_g, w_in, b_fox, q_norm_g, k_norm_g, attn_out_g,
              hgrn_lb, hgrn_out_g, w_out, norm2_g, w_router_group, b_router_group,
              w_router_expert, b_router_expert, w_gate, w_up, w_down):
    b, s, d = x.shape
    f32 = jnp.float32
    split_at = np.cumsum(IN_SPLITS)[:-1].tolist()
    lower_bounds = jnp.cumsum(jax.nn.softmax(hgrn_lb.astype(f32), axis=0), axis=0)
    for l in range(DEPTH):
        mod = jax.nn.silu(c) @ w_ada[l] + b_ada[l]
        shift1, scale1, gate1, shift2, scale2, gate2 = jnp.split(mod[:, None, :], 6, axis=-1)

        h = rms_norm(x, norm1_g[l]) * (1 + scale1) + shift1
        proj = h @ w_in[l]
        aq, ak, av, af, hq, hf, hi, hg = jnp.split(proj, split_at, axis=-1)

        aq = rms_norm(split_heads(aq, ATTN_HEADS), q_norm_g[l])
        ak = rms_norm(split_heads(ak, ATTN_HEADS), k_norm_g[l])
        av = split_heads(av, ATTN_HEADS)
        fox_log_f = jax.nn.log_sigmoid(af.astype(f32) + b_fox[l].astype(f32)).transpose(0, 2, 1)
        ao = forgetting_attention(aq, ak, av, fox_log_f)
        ao = merge_heads(rms_norm(ao, attn_out_g[l].reshape(ATTN_HEADS, 1, ATTN_HEAD_DIM)))

        lb = lower_bounds[l].reshape(HGRN_HEADS, 1, HGRN_EXPAND)
        forget = lb + (1 - lb) * jax.nn.sigmoid(split_heads(hf, HGRN_HEADS).astype(f32))
        ho = hgrn2_chunkwise(jax.nn.silu(split_heads(hq, HGRN_HEADS).astype(f32)), 1 - forget,
                             split_heads(hi, HGRN_HEADS).astype(f32), jnp.log(forget))
        ho = rms_norm(ho, hgrn_out_g[l].reshape(HGRN_HEADS, 1, HGRN_HEAD_V)) * jax.nn.silu(split_heads(hg, HGRN_HEADS).astype(f32))
        ho = merge_heads(ho).astype(x.dtype)

        x = x + gate1 * (jnp.concatenate([ao, ho], axis=-1) @ w_out[l])

        h2 = rms_norm(x, norm2_g[l]) * (1 + scale2) + shift2
        y = hierarchical_moe(h2.reshape(b * s, d), w_router_group[l], b_router_group[l],
                             w_router_expert[l], b_router_expert[l],
                             w_gate[l], w_up[l], w_down[l]).reshape(b, s, d)
        x = x + gate2 * y
    return x
```

```cpp
#include <hip/hip_runtime.h>
#include <hip/hip_bf16.h>
#include <cstdio>
#include <cstdint>
#include <cmath>

#define LAS __attribute__((address_space(3)))
#define GAS __attribute__((address_space(1)))
typedef unsigned short bf16_t;
typedef short bf16x8 __attribute__((ext_vector_type(8)));
typedef short s16x4 __attribute__((ext_vector_type(4)));
typedef float f32x4 __attribute__((ext_vector_type(4)));
typedef float f32x2 __attribute__((ext_vector_type(2)));
typedef float f32x16 __attribute__((ext_vector_type(16)));
typedef unsigned u32x4 __attribute__((ext_vector_type(4)));
typedef unsigned u32x2 __attribute__((ext_vector_type(2)));
typedef _Float16 h16x2 __attribute__((ext_vector_type(2)));

constexpr int BATCH = 32, SEQ = 2048, DMODEL = 1024, MTOK = BATCH * SEQ;
constexpr int AH = 8, AD = 64, AW = 512, HH = 4, HK = 128, HW = 512;
constexpr int INW = 3 * AW + AH + 4 * HW;
constexpr int PW = 3584;
constexpr int PC_Q = 0, PC_K = 512, PC_V = 1024, PC_HQ = 1536, PC_HG = 2048, PC_HV = 2560, PC_HO = 3072;
constexpr int NEXP = 16, DEXP = 512, NCLS = 24;
constexpr float NORM_EPS = 1e-6f;
constexpr float LOG2E = 1.4426950408889634f;
constexpr float QSCALE = 0.125f * LOG2E;
constexpr float W_SCALE = 32.0f, XN2_SCALE = 4.0f, ACT_SCALE = 16.0f;
constexpr int SCL_W = 0x7A7A7A7A, SCL_XN2 = 0x7D7D7D7D, SCL_ACT = 0x7B7B7B7B;

typedef __bf16 bf16x2_nat __attribute__((ext_vector_type(2)));
__device__ __forceinline__ unsigned cvt_pk_bf16(float lo, float hi) { f32x2 v = {lo, hi}; bf16x2_nat b = __builtin_convertvector(v, bf16x2_nat); return __builtin_bit_cast(unsigned, b); }
__device__ __forceinline__ float bf_lo(unsigned u) { return __uint_as_float(u << 16); }
__device__ __forceinline__ float bf_hi(unsigned u) { return __uint_as_float(u & 0xffff0000u); }
__device__ __forceinline__ unsigned cvt_pk_f16(float lo, float hi) { h16x2 v = {(_Float16)lo, (_Float16)hi}; return __builtin_bit_cast(unsigned, v); }
__device__ __forceinline__ float sigmoidf_(float v) { return __builtin_amdgcn_rcpf(1.0f + __builtin_amdgcn_exp2f(-v * LOG2E)); }
__device__ __forceinline__ float siluf_(float v) { return v * sigmoidf_(v); }

namespace pg8 {
constexpr int BM = 256, BK = 64, HALF = 128, HTB = HALF * BK * 2, STAGE_BYTES = 8 * HTB, NXCD = 8, WGM = 8;
typedef int v8i32 __attribute__((ext_vector_type(8)));
typedef int v4i32 __attribute__((ext_vector_type(4)));

__host__ __device__ __forceinline__ int lds_byte(int r, int c) { const int st = (r >> 4) * 2 + (c >> 5), rr = r & 15, cc = c & 31, ob = rr * 64 + cc * 2; return st * 1024 + (ob ^ (((ob >> 9) & 1) << 5)); }
__host__ __device__ __forceinline__ void stage_rc(int b, int& R, int& C) { const int st = b / 1024, sb = b % 1024, swz = sb ^ (((sb >> 9) & 1) << 5); R = (st >> 1) * 16 + swz / 64; C = (st & 1) * 32 + (swz % 64) / 2; }
__host__ __device__ __forceinline__ int perm32(int rho) { const int n = rho >> 4, i = rho & 15; return 8 * (i >> 2) + 4 * n + (i & 3); }

struct GUnit { const char* A; const char* B0; const char* B1; int pm, pn, e0, e1, e2; };

__device__ __forceinline__ bool order_id(int i, int G, int c, int nwg, int& wgid) {
    const long L = (long)i * G + c; if (L >= nwg) return false;
    const int q = nwg / NXCD, r = nwg % NXCD, w = (int)L, xcd = w % NXCD, off = w / NXCD;
    wgid = (xcd < r ? xcd * (q + 1) : r * (q + 1) + (xcd - r) * q) + off; return true;
}

template <class Pol, class Epi, int SK = 0, int KL = 0>
__device__ __forceinline__ void gemm_phase(LAS unsigned char* lds, const Pol& S, const Epi& E) {
    int tid = threadIdx.x; asm volatile("" : "+v"(tid));
    const int wid = __builtin_amdgcn_readfirstlane(tid >> 6), lane = tid & 63, wr = wid >> 2, wc = wid & 3, fr = lane & 15, fq = lane >> 4;
    const int RR0 = 8 * wid + (lane >> 3), RR1 = RR0 + 64, CC0 = 8 * ((lane & 7) ^ ((RR0 >> 1) & 7)), CC1 = CC0;
    const int Rb0 = Pol::HG ? (64 * (RR0 >> 5) + perm32(RR0 & 31)) : ((RR0 & ~31) + perm32(RR0 & 31)), Rb1 = Pol::HG ? (64 * (RR1 >> 5) + perm32(RR1 & 31)) : ((RR1 & ~31) + perm32(RR1 & 31));
    constexpr int NT = Pol::NT;
    const unsigned voffB00 = (unsigned)(Rb0 * S.ldb + CC0 * 2), voffB01 = (unsigned)(Rb1 * S.ldb + CC1 * 2), voffB10 = voffB00 + (unsigned)S.hstepB, voffB11 = voffB01 + (unsigned)S.hstepB;
    unsigned voffA00 = (unsigned)(RR0 * S.lda + CC0 * 2), voffA01 = (unsigned)(RR1 * S.lda + CC1 * 2), voffA10 = (unsigned)((HALF + RR0) * S.lda + CC0 * 2), voffA11 = (unsigned)((HALF + RR1) * S.lda + CC1 * 2);
    unsigned voffAn00 = voffA00, voffAn01 = voffA01, voffAn10 = voffA10, voffAn11 = voffA11;
    const size_t kstep = (size_t)(BK * 2);
    const unsigned ldsw = (unsigned)wid * 1024u;
    const int swz = (fr >> 1) & 7, aoff0 = (wr * 64 + fr) * 128 + ((fq ^ swz) << 4), aoff1 = (wr * 64 + fr) * 128 + (((4 + fq) ^ swz) << 4), boff0 = (wc * 32 + fr) * 128 + ((fq ^ swz) << 4), boff1 = (wc * 32 + fr) * 128 + (((4 + fq) ^ swz) << 4);
#define PG8_SA(b, h) (((b) * 2 + (h)) * HTB)
#define PG8_SB(b, h) ((4 + (b) * 2 + (h)) * HTB)
#define PG8_STAGE2(bufoff, gbase, v0, v1) do { if constexpr (SK != 3 && SK != 6) { \
        __builtin_amdgcn_global_load_lds((const unsigned*)((const char*)(gbase) + (v0)), (LAS unsigned*)(lds + (bufoff) + ldsw), 16, 0, 0); \
        __builtin_amdgcn_global_load_lds((const unsigned*)((const char*)(gbase) + (v1)), (LAS unsigned*)(lds + (bufoff) + ldsw + 8192), 16, 0, 0); } } while (0)
#define PG8_STAGE(bufoff, gbase, voff, h) PG8_STAGE2(bufoff, gbase, voff##h##0, voff##h##1)
#define PG8_CAT(x0, x1) __builtin_shufflevector(x0, x1, 0, 1, 2, 3, 4, 5, 6, 7)
#define PG8_LO(x) __builtin_bit_cast(bf16x8, __builtin_shufflevector(x, x, 0, 1, 2, 3))
#define PG8_HI(x) __builtin_bit_cast(bf16x8, __builtin_shufflevector(x, x, 4, 5, 6, 7))
#define PG8_LDA(dst, b, h) do { if constexpr (SK != 4 && SK != 6) _Pragma("unroll") for (int m = 0; m < 4; ++m) dst[m] = PG8_CAT(*(const LAS v4i32*)(lds + PG8_SA(b, h) + aoff0 + m * 2048), *(const LAS v4i32*)(lds + PG8_SA(b, h) + aoff1 + m * 2048)); } while (0)
#define PG8_LDB(dst, b, h) do { if constexpr (SK != 4 && SK != 6) _Pragma("unroll") for (int n = 0; n < 2; ++n) dst[n] = PG8_CAT(*(const LAS v4i32*)(lds + PG8_SB(b, h) + boff0 + n * 2048), *(const LAS v4i32*)(lds + PG8_SB(b, h) + boff1 + n * 2048)); } while (0)
#define PG8_MMA(ai, bj, At, Bt) do { __builtin_amdgcn_s_setprio(1); _Pragma("unroll") for (int m = 0; m < ((SK == 2 || SK == 6) ? 0 : (SK == 1 ? 2 : 4)); ++m) _Pragma("unroll") for (int n = 0; n < 2; ++n) { \
        if constexpr (Pol::FP8) asm volatile("v_mfma_scale_f32_16x16x128_f8f6f4 %0, %1, %2, %0, %3, %4 op_sel_hi:[0,0,0]" : "+v"(acc[ai][bj][m][n]) : "v"(Bt[n]), "v"(At[m]), "v"(sclW), "v"(sclX)); \
        else { acc[ai][bj][m][n] = __builtin_amdgcn_mfma_f32_16x16x32_bf16(PG8_LO(Bt[n]), PG8_LO(At[m]), acc[ai][bj][m][n], 0, 0, 0); \
               acc[ai][bj][m][n] = __builtin_amdgcn_mfma_f32_16x16x32_bf16(PG8_HI(Bt[n]), PG8_HI(At[m]), acc[ai][bj][m][n], 0, 0, 0); } } \
        __builtin_amdgcn_s_setprio(0); } while (0)
#define PG8_WAIT_V(n) asm volatile("s_waitcnt vmcnt(" #n ")" ::: "memory")
#define PG8_WAIT_L(n) asm volatile("s_waitcnt lgkmcnt(" #n ")" ::: "memory")
#define PG8_BAR do { if constexpr (SK != 5) __builtin_amdgcn_s_barrier(); } while (0)
#define PG8_SCHED __builtin_amdgcn_sched_barrier(0)
    int sclW = 0, sclX = 0; if constexpr (Pol::FP8) { sclW = S.sclW; sclX = S.sclX; }
    GUnit cur, nxt; int ui = 0;
    if (!S.next(0, cur)) return;
    if constexpr (Pol::GATHER) {
        const u32x4 ix = S.rows(cur, RR0, RR1);
        voffA00 = ix.x * (unsigned)S.lda + (unsigned)CC0 * 2u; voffA01 = ix.y * (unsigned)S.lda + (unsigned)CC1 * 2u;
        voffA10 = ix.z * (unsigned)S.lda + (unsigned)CC0 * 2u; voffA11 = ix.w * (unsigned)S.lda + (unsigned)CC1 * 2u;
    }
    f32x4 acc[2][2][4][2];
#pragma unroll
    for (int a = 0; a < 2; ++a)
#pragma unroll
        for (int b = 0; b < 2; ++b)
#pragma unroll
            for (int m = 0; m < 4; ++m)
#pragma unroll
                for (int n = 0; n < 2; ++n) acc[a][b][m][n] = (f32x4){0.f, 0.f, 0.f, 0.f};
    v8i32 At[4], B0[2], B1[2];
    if constexpr (SK == 4 || SK == 6) { _Pragma("unroll") for (int m = 0; m < 4; ++m) At[m] = (v8i32){1, 2, 3, 4, 5, 6, 7, 8}; B0[0] = B0[1] = B1[0] = B1[1] = (v8i32){1, 2, 3, 4, 5, 6, 7, 8}; }
    const char* cA = cur.A;
    if constexpr (KL == 1) {
        PG8_STAGE(PG8_SB(0, 0), cur.B0, voffB, 0); PG8_STAGE(PG8_SB(0, 1), cur.B0, voffB, 1); PG8_STAGE(PG8_SA(0, 0), cA, voffA, 0); PG8_STAGE(PG8_SA(0, 1), cA, voffA, 1);
        PG8_WAIT_V(0); PG8_BAR;
    } else {
    PG8_STAGE(PG8_SB(0, 0), cur.B0, voffB, 0); PG8_STAGE(PG8_SB(0, 1), cur.B0, voffB, 1); PG8_STAGE(PG8_SA(0, 0), cA, voffA, 0); PG8_STAGE(PG8_SA(0, 1), cA, voffA, 1);
    if (wr == 1) PG8_BAR;
    PG8_WAIT_V(2); PG8_BAR;
    PG8_STAGE(PG8_SB(1, 0), cur.B0 + kstep, voffB, 0); PG8_STAGE(PG8_SA(1, 0), cA + kstep, voffA, 0); PG8_STAGE(PG8_SB(1, 1), cur.B0 + kstep, voffB, 1);
    PG8_WAIT_V(6); PG8_BAR;
    }
    for (;;) {
        const bool has_next = S.next(ui + 1, nxt);
        const char* nA = has_next ? nxt.A : cA; const char* nB = has_next ? nxt.B0 : cur.B0;
        if constexpr (Pol::GATHER) {
            if (has_next) { int r0_ = RR0, r1_ = RR1; asm volatile("" : "+v"(r0_), "+v"(r1_)); const u32x4 ix = S.rows(nxt, r0_, r1_);
                voffAn00 = ix.x * (unsigned)S.lda + (unsigned)CC0 * 2u; voffAn01 = ix.y * (unsigned)S.lda + (unsigned)CC1 * 2u;
                voffAn10 = ix.z * (unsigned)S.lda + (unsigned)CC0 * 2u; voffAn11 = ix.w * (unsigned)S.lda + (unsigned)CC1 * 2u; }
            else { voffAn00 = voffA00; voffAn01 = voffA01; voffAn10 = voffA10; voffAn11 = voffA11; }
        }
        if constexpr (KL == 1) {
#define PG8_TRIP(tt, b) do { const bool lastt_ = ((tt) == NT - 1); \
            const char* an_ = lastt_ ? nA : cA + (size_t)((tt) + 1) * kstep; \
            const char* bn_ = lastt_ ? nB : (((tt) + 1 < S.ks) ? cur.B0 + (size_t)((tt) + 1) * kstep : cur.B1 + (size_t)((tt) + 1 - S.ks) * kstep); \
            asm volatile("" : "+s"(an_), "+s"(bn_)); \
            const bool gl_ = Pol::GATHER && lastt_; \
            const unsigned va00 = gl_ ? voffAn00 : voffA00, va01 = gl_ ? voffAn01 : voffA01, va10 = gl_ ? voffAn10 : voffA10, va11 = gl_ ? voffAn11 : voffA11; \
            PG8_LDB(B0, b, 0); PG8_LDB(B1, b, 1); PG8_SCHED; PG8_LDA(At, b, 0); \
            PG8_STAGE(PG8_SB(1 - (b), 0), bn_, voffB, 0); PG8_STAGE(PG8_SB(1 - (b), 1), bn_, voffB, 1); \
            PG8_STAGE(PG8_SA(1 - (b), 0), an_, va, 0); PG8_STAGE(PG8_SA(1 - (b), 1), an_, va, 1); \
            PG8_WAIT_L(0); PG8_SCHED; \
            PG8_MMA(0, 0, At, B0); PG8_MMA(0, 1, At, B1); PG8_SCHED; \
            PG8_LDA(At, b, 1); \
            PG8_WAIT_L(0); PG8_SCHED; \
            PG8_MMA(1, 0, At, B0); PG8_MMA(1, 1, At, B1); \
            PG8_WAIT_V(0); PG8_BAR; PG8_SCHED; } while (0)
#pragma unroll 1
            for (int t = 0; t < NT; t += 2) { PG8_TRIP(t, 0); PG8_TRIP(t + 1, 1); }
#undef PG8_TRIP
        } else
#pragma unroll 1
        for (int t = 0; t < NT; t += 2) {
            const bool last = (t == NT - 2);
            const char* a1 = cA + (size_t)(t + 1) * kstep;
            const char* a2 = last ? nA : cA + (size_t)(t + 2) * kstep;
            const char* b2 = last ? nB : ((t + 2 < S.ks) ? cur.B0 + (size_t)(t + 2) * kstep : cur.B1 + (size_t)(t + 2 - S.ks) * kstep);
            const char* a3 = a2 + kstep; const char* b3 = b2 + kstep;
            asm volatile("" : "+s"(a1), "+s"(a2), "+s"(a3), "+s"(b2), "+s"(b3));
            const bool gl_ = Pol::GATHER && last;
            const unsigned va00 = gl_ ? voffAn00 : voffA00, va01 = gl_ ? voffAn01 : voffA01, va10 = gl_ ? voffAn10 : voffA10, va11 = gl_ ? voffAn11 : voffA11;
            PG8_LDB(B0, 0, 0); PG8_LDB(B1, 0, 1); PG8_SCHED; PG8_LDA(At, 0, 0); PG8_STAGE(PG8_SA(1, 1), a1, voffA, 1);
            PG8_WAIT_V(8); PG8_WAIT_L(0); PG8_BAR; PG8_MMA(0, 0, At, B0); PG8_MMA(0, 1, At, B1); PG8_BAR; PG8_SCHED;
            PG8_LDA(At, 0, 1); PG8_STAGE(PG8_SB(0, 0), b2, voffB, 0); PG8_STAGE(PG8_SB(0, 1), b2, voffB, 1); PG8_STAGE(PG8_SA(0, 0), a2, va, 0);
            PG8_WAIT_V(8); PG8_WAIT_L(0); PG8_BAR; PG8_MMA(1, 0, At, B0); PG8_MMA(1, 1, At, B1); PG8_BAR; PG8_SCHED;
            PG8_LDB(B0, 1, 0); PG8_LDB(B1, 1, 1); PG8_SCHED; PG8_LDA(At, 1, 0); PG8_STAGE(PG8_SA(0, 1), a2, va, 1);
            PG8_WAIT_V(8); PG8_WAIT_L(0); PG8_BAR; PG8_MMA(0, 0, At, B0); PG8_MMA(0, 1, At, B1); PG8_BAR; PG8_SCHED;
            PG8_LDA(At, 1, 1); PG8_STAGE(PG8_SB(1, 0), b3, voffB, 0); PG8_STAGE(PG8_SB(1, 1), b3, voffB, 1); PG8_STAGE(PG8_SA(1, 0), a3, va, 0);
            PG8_WAIT_V(8); PG8_WAIT_L(0); PG8_BAR; PG8_MMA(1, 0, At, B0); PG8_MMA(1, 1, At, B1); PG8_BAR; PG8_SCHED;
        }
        if constexpr (KL == 0) { if (wr == 0) PG8_BAR; }
        if constexpr (Pol::FP8) asm volatile("s_nop 15\n\ts_nop 7" ::: "memory");
        { int fr_e = fr, fq_e = fq; asm volatile("" : "+v"(fr_e), "+v"(fq_e));
          E(acc, cur, wr, wc, fr_e, fq_e); }
        if (!has_next) break;
#pragma unroll
        for (int a = 0; a < 2; ++a)
#pragma unroll
            for (int b = 0; b < 2; ++b)
#pragma unroll
                for (int m = 0; m < 4; ++m)
#pragma unroll
                    for (int n = 0; n < 2; ++n) acc[a][b][m][n] = (f32x4){0.f, 0.f, 0.f, 0.f};
        cur = nxt; cA = nA; ++ui;
        if constexpr (Pol::GATHER) { voffA00 = voffAn00; voffA01 = voffAn01; voffA10 = voffAn10; voffA11 = voffAn11; }
        if constexpr (KL == 0) { if (wr == 1) PG8_BAR; }
    }
    PG8_WAIT_V(0);
    PG8_BAR;
#undef PG8_SA
#undef PG8_SB
#undef PG8_STAGE
#undef PG8_STAGE2
#undef PG8_LDA
#undef PG8_LDB
#undef PG8_MMA
#undef PG8_CAT
#undef PG8_LO
#undef PG8_HI
#undef PG8_WAIT_V
#undef PG8_WAIT_L
#undef PG8_BAR
#undef PG8_SCHED
}
}
namespace pg8 {
struct DensePol {
    static constexpr bool GATHER = false, FP8 = false; static constexpr int NT = 16;
    const char* A; const char* Bt; int lda, ldb, hstepB, ks, nN, G, c, bt_tile_rows  ;
    __device__ __forceinline__ bool next(int i, GUnit& u) const {
        const int nM = MTOK / BM, nwg = nM * nN; int wgid; if (!order_id(i, G, c, nwg, wgid)) return false;
        const int nig = WGM * nN, gid = wgid / nig, fm = gid * WGM, gsz = (nM - fm) < WGM ? (nM - fm) : WGM;
        u.pm = fm + ((wgid % nig) % gsz); u.pn = (wgid % nig) / gsz; u.e0 = 0; u.e1 = 0; u.e2 = 0;
        u.A = A + (size_t)u.pm * BM * lda; u.B0 = Bt + (size_t)u.pn * BM * ldb; u.B1 = u.B0; return true;
    }
};
struct ProjPol : DensePol { static constexpr bool HG = true; };
struct PlainPol : DensePol { static constexpr bool HG = false; };

struct MoeTab { const LAS int* t; __device__ __forceinline__ int cnt(int c) const { return t[c]; } __device__ __forceinline__ int tpre(int c) const { return t[32 + c]; } };
__device__ __forceinline__ void moe_class_experts(int cls, int& elo, int& ehi) {
    const int g = cls / 6, p = cls % 6; const int lo = p < 3 ? 0 : (p < 5 ? 1 : 2); const int hi = p < 3 ? p + 1 : (p < 5 ? p - 1 : 3);
    elo = 4 * g + lo; ehi = 4 * g + hi;
}
struct Moe1Pol {
    static constexpr bool GATHER = true, HG = false, FP8 = true; static constexpr int NT = 8;
    const char* A; const char* W1T; const int* list; MoeTab tab; int lda, ldb, hstepB, ks, G, c, sclW, sclX;
    __device__ __forceinline__ bool next(int i, GUnit& u) const {
        const int ntile = tab.tpre(NCLS), nwg = ntile * 8; int wgid; if (!order_id(i, G, c, nwg, wgid)) return false;
        const int rtg = wgid >> 3, sub = wgid & 7, e01 = sub >> 2, ct = sub & 3;
        int cls = 0;
#pragma unroll 1
        for (int k = 1; k < NCLS; ++k) cls += (tab.tpre(k) <= rtg) ? 1 : 0;
        int elo, ehi; moe_class_experts(cls, elo, ehi); const int ex = e01 ? ehi : elo;
        u.pm = rtg; u.pn = ct; u.e0 = cls; u.e1 = rtg - tab.tpre(cls); u.e2 = e01;
        u.A = A; u.B0 = W1T + ((size_t)ex * 1024 + (size_t)ct * 128) * 1024; u.B1 = u.B0; return true;
    }
    __device__ __forceinline__ u32x4 rows(const GUnit& u, int R0, int R1) const {
        const int base = u.e1 * 256, n = tab.cnt(u.e0) - base; const int* L = list + (size_t)u.e0 * MTOK + base;
        u32x4 r;
        r.x = R0 < n ? (unsigned)L[R0] : 0u; r.y = R1 < n ? (unsigned)L[R1] : 0u;
        r.z = HALF + R0 < n ? (unsigned)L[HALF + R0] : 0u; r.w = HALF + R1 < n ? (unsigned)L[HALF + R1] : 0u;
        return r;
    }
};
struct Moe2Pol {
    static constexpr bool GATHER = false, HG = false, FP8 = true; static constexpr int NT = 8;
    const char* A; const char* WdT; MoeTab tab; int lda, ldb, hstepB, ks, G, c, sclW, sclX;
    __device__ __forceinline__ bool next(int i, GUnit& u) const {
        const int ntile = tab.tpre(NCLS), nwg = ntile * 4; int wgid; if (!order_id(i, G, c, nwg, wgid)) return false;
        const int rtg = wgid >> 2, ct = wgid & 3;
        int cls = 0;
#pragma unroll 1
        for (int k = 1; k < NCLS; ++k) cls += (tab.tpre(k) <= rtg) ? 1 : 0;
        int elo, ehi; moe_class_experts(cls, elo, ehi);
        u.pm = rtg; u.pn = ct; u.e0 = cls; u.e1 = rtg - tab.tpre(cls); u.e2 = 0;
        u.A = A + (size_t)rtg * BM * lda;
        u.B0 = WdT + ((size_t)elo * 1024 + (size_t)ct * 256) * 512; u.B1 = WdT + ((size_t)ehi * 1024 + (size_t)ct * 256) * 512; return true;
    }
};

struct EpiProj {
    bf16_t* P; const float* gq; const float* gk; const float* lbp;
    __device__ __forceinline__ void operator()(const f32x4 (&acc)[2][2][4][2], const GUnit& u, int wr, int wc, int fr, int fq) const {
#ifdef REP_EPIPROJ
        for (int rep_ = 0; rep_ < REP_EPIPROJ - 1; ++rep_) { asm volatile("" ::: "memory"); body(acc, u, wr, wc, fr, fq); }
#endif
        body(acc, u, wr, wc, fr, fq);
    }
    __device__ __forceinline__ void body(const f32x4 (&acc)[2][2][4][2], const GUnit& u, int wr, int wc, int fr, int fq) const {
        const int type = u.pn >> 1;
        const int row0 = u.pm * BM + wr * 64 + fr, lc0 = 64 * wc + 8 * fq;
        bf16_t* base = P + (size_t)row0 * PW + u.pn * BM + lc0;
        if (type <= 1) {
            const float* g = type == 0 ? gq : gk; const float sc = type == 0 ? QSCALE : 1.0f;
            f32x4 gv[2][2];
#pragma unroll
            for (int bj = 0; bj < 2; ++bj)
#pragma unroll
                for (int n = 0; n < 2; ++n) gv[bj][n] = *(const f32x4*)(g + 32 * bj + 8 * fq + 4 * n) * sc;
#pragma unroll
            for (int ai = 0; ai < 2; ++ai)
#pragma unroll
                for (int m = 0; m < 4; ++m) {
                    float ss = 0.f;
#pragma unroll
                    for (int bj = 0; bj < 2; ++bj)
#pragma unroll
                        for (int n = 0; n < 2; ++n) { const f32x4 v = acc[ai][bj][m][n]; ss += (v[0] * v[0] + v[1] * v[1]) + (v[2] * v[2] + v[3] * v[3]); }
                    ss += __shfl_xor(ss, 16); ss += __shfl_xor(ss, 32);
                    const float rstd = __builtin_amdgcn_rsqf(ss * (1.0f / 64.0f) + NORM_EPS);
                    bf16_t* rowp = base + (size_t)(ai * HALF + m * 16) * PW;
#pragma unroll
                    for (int bj = 0; bj < 2; ++bj) { const f32x4 v0 = acc[ai][bj][m][0] * rstd * gv[bj][0], v1 = acc[ai][bj][m][1] * rstd * gv[bj][1];
                        u32x4 w; w.x = cvt_pk_bf16(v0[0], v0[1]); w.y = cvt_pk_bf16(v0[2], v0[3]); w.z = cvt_pk_bf16(v1[0], v1[1]); w.w = cvt_pk_bf16(v1[2], v1[3]);
                        *(u32x4*)(rowp + 32 * bj) = w; }
                }
        } else if (type == 4) {
            const int ch0 = (u.pn - 8) * BM + lc0;
            f32x4 lbv[2][2];
#pragma unroll
            for (int bj = 0; bj < 2; ++bj)
#pragma unroll
                for (int n = 0; n < 2; ++n) { const f32x4 l0 = *(const f32x4*)(lbp + ch0 + 32 * bj + 4 * n), l1 = *(const f32x4*)(lbp + 512 + ch0 + 32 * bj + 4 * n);
#pragma unroll
                    for (int e = 0; e < 4; ++e) lbv[bj][n][e] = sigmoidf_(l0[e] - l1[e]); }
#pragma unroll
            for (int ai = 0; ai < 2; ++ai)
#pragma unroll
                for (int m = 0; m < 4; ++m) { bf16_t* rowp = base + (size_t)(ai * HALF + m * 16) * PW;
#pragma unroll
                    for (int bj = 0; bj < 2; ++bj) { float o[8];
#pragma unroll
                        for (int n = 0; n < 2; ++n)
#pragma unroll
                            for (int e = 0; e < 4; ++e) { const float lb = lbv[bj][n][e]; o[4 * n + e] = lb + (1.0f - lb) * sigmoidf_(acc[ai][bj][m][n][e]); }
                        u32x4 w; w.x = cvt_pk_f16(o[0], o[1]); w.y = cvt_pk_f16(o[2], o[3]); w.z = cvt_pk_f16(o[4], o[5]); w.w = cvt_pk_f16(o[6], o[7]);
                        *(u32x4*)(rowp + 32 * bj) = w; } }
        } else {
            const bool act = (type == 3 || type == 6);
#pragma unroll
            for (int ai = 0; ai < 2; ++ai)
#pragma unroll
                for (int m = 0; m < 4; ++m) { bf16_t* rowp = base + (size_t)(ai * HALF + m * 16) * PW;
#pragma unroll
                    for (int bj = 0; bj < 2; ++bj) { f32x4 v0 = acc[ai][bj][m][0], v1 = acc[ai][bj][m][1];
                        if (act) {
#pragma unroll
                            for (int e = 0; e < 4; ++e) { v0[e] = siluf_(v0[e]); v1[e] = siluf_(v1[e]); } }
                        u32x4 w; w.x = cvt_pk_bf16(v0[0], v0[1]); w.y = cvt_pk_bf16(v0[2], v0[3]); w.z = cvt_pk_bf16(v1[0], v1[1]); w.w = cvt_pk_bf16(v1[2], v1[3]);
                        *(u32x4*)(rowp + 32 * bj) = w; } }
        }
    }
};
struct EpiRes {
    const float* __restrict__ x; bf16_t* __restrict__ x1; const float* __restrict__ gate;
    __device__ __forceinline__ void operator()(const f32x4 (&acc)[2][2][4][2], const GUnit& u, int wr, int wc, int fr, int fq) const {
        const int row0 = u.pm * BM + wr * 64 + fr, col0 = u.pn * BM + 32 * wc + 8 * fq, b = (u.pm * BM) >> 11;
        f32x4 gv[2][2];
#pragma unroll
        for (int bj = 0; bj < 2; ++bj)
#pragma unroll
            for (int n = 0; n < 2; ++n) gv[bj][n] = *(const f32x4*)(gate + (size_t)b * 6144 + col0 + HALF * bj + 4 * n);
#pragma unroll
        for (int ai = 0; ai < 2; ++ai) {
            f32x4 xv[4][2][2];
#pragma unroll
            for (int m = 0; m < 4; ++m) { const size_t off = (size_t)(row0 + ai * HALF + m * 16) * DMODEL + col0;
#pragma unroll
                for (int bj = 0; bj < 2; ++bj) { xv[m][bj][0] = *(const f32x4*)(x + off + HALF * bj); xv[m][bj][1] = *(const f32x4*)(x + off + HALF * bj + 4); } }
#pragma unroll
            for (int m = 0; m < 4; ++m) { const size_t off = (size_t)(row0 + ai * HALF + m * 16) * DMODEL + col0;
#pragma unroll
                for (int bj = 0; bj < 2; ++bj) { const f32x4 o0 = xv[m][bj][0] + gv[bj][0] * acc[ai][bj][m][0], o1 = xv[m][bj][1] + gv[bj][1] * acc[ai][bj][m][1];
                    u32x4 w; w.x = cvt_pk_bf16(o0[0], o0[1]); w.y = cvt_pk_bf16(o0[2], o0[3]); w.z = cvt_pk_bf16(o1[0], o1[1]); w.w = cvt_pk_bf16(o1[2], o1[3]);
                    *(u32x4*)(x1 + off + HALF * bj) = w; } }
        }
    }
};
__device__ __forceinline__ float clamp448(float v) { return __builtin_amdgcn_fmed3f(v, -448.0f, 448.0f); }
__device__ __forceinline__ unsigned pk4_fp8(float a, float b, float c, float d) { int r = 0; r = __builtin_amdgcn_cvt_pk_fp8_f32(clamp448(a), clamp448(b), r, false); r = __builtin_amdgcn_cvt_pk_fp8_f32(clamp448(c), clamp448(d), r, true); return (unsigned)r; }
struct EpiSwiglu {
    unsigned char* __restrict__ act; const float* __restrict__ lw; MoeTab tab;
    __device__ __forceinline__ void operator()(const f32x4 (&acc)[2][2][4][2], const GUnit& u, int wr, int wc, int fr, int fq) const {
        const int r0 = wr * 64 + fr, n = tab.cnt(u.e0) - u.e1 * 256;
        const float* lwp = lw + ((size_t)u.e0 * MTOK + (size_t)u.e1 * 256) * 2 + u.e2;
        unsigned char* base = act + (size_t)(u.pm * BM + r0) * DMODEL + u.e2 * 512 + u.pn * 128 + 32 * wc + 8 * fq;
        float wrow[2][4];
#pragma unroll
        for (int ai = 0; ai < 2; ++ai)
#pragma unroll
            for (int m = 0; m < 4; ++m) { const int r = r0 + ai * HALF + m * 16; wrow[ai][m] = (r < n ? lwp[(size_t)r * 2] : 0.f) * ACT_SCALE; }
#pragma unroll
        for (int ai = 0; ai < 2; ++ai)
#pragma unroll
            for (int m = 0; m < 4; ++m) { const float w = wrow[ai][m];
                float o[8];
#pragma unroll
                for (int nn = 0; nn < 2; ++nn)
#pragma unroll
                    for (int e = 0; e < 4; ++e) o[4 * nn + e] = w * siluf_(acc[ai][0][m][nn][e]) * acc[ai][1][m][nn][e];
                *(u32x2*)(base + (size_t)(ai * HALF + m * 16) * DMODEL) = (u32x2){pk4_fp8(o[0], o[1], o[2], o[3]), pk4_fp8(o[4], o[5], o[6], o[7])}; }
    }
};
struct EpiMoeOut {
    float* __restrict__ out; const bf16_t* __restrict__ x1; const float* __restrict__ gate; const int* __restrict__ list; MoeTab tab;
    __device__ __forceinline__ void operator()(const f32x4 (&acc)[2][2][4][2], const GUnit& u, int wr, int wc, int fr, int fq) const {
        const int r0 = wr * 64 + fr, n = tab.cnt(u.e0) - u.e1 * 256, col0 = u.pn * BM + 32 * wc + 8 * fq;
        const int* L = list + (size_t)u.e0 * MTOK + (size_t)u.e1 * 256;
        int tok[2][4];
#pragma unroll
        for (int ai = 0; ai < 2; ++ai)
#pragma unroll
            for (int m = 0; m < 4; ++m) { const int r = r0 + ai * HALF + m * 16; tok[ai][m] = r < n ? L[r] : 0; }
#pragma unroll
        for (int ai = 0; ai < 2; ++ai)
#pragma unroll
            for (int m = 0; m < 4; ++m) { const int r = r0 + ai * HALF + m * 16, tk = tok[ai][m];
                const float* gp = gate + (size_t)(tk >> 11) * 6144 + col0; float* op = out + (size_t)tk * DMODEL + col0; const bf16_t* xp = x1 + (size_t)tk * DMODEL + col0;
                const u32x4 xa = *(const u32x4*)(xp), xb = *(const u32x4*)(xp + HALF);
                const f32x4 ga0 = *(const f32x4*)(gp), ga1 = *(const f32x4*)(gp + 4), gb0 = *(const f32x4*)(gp + HALF), gb1 = *(const f32x4*)(gp + HALF + 4);
                const f32x4 o0 = (f32x4){bf_lo(xa.x), bf_hi(xa.x), bf_lo(xa.y), bf_hi(xa.y)} + ga0 * acc[ai][0][m][0], o1 = (f32x4){bf_lo(xa.z), bf_hi(xa.z), bf_lo(xa.w), bf_hi(xa.w)} + ga1 * acc[ai][0][m][1];
                const f32x4 o2 = (f32x4){bf_lo(xb.x), bf_hi(xb.x), bf_lo(xb.y), bf_hi(xb.y)} + gb0 * acc[ai][1][m][0], o3 = (f32x4){bf_lo(xb.z), bf_hi(xb.z), bf_lo(xb.w), bf_hi(xb.w)} + gb1 * acc[ai][1][m][1];
                if (r < n) { *(f32x4*)(op) = o0; *(f32x4*)(op + 4) = o1; *(f32x4*)(op + HALF) = o2; *(f32x4*)(op + HALF + 4) = o3; } }
    }
};
}
namespace attn_body {
using bf16 = __hip_bfloat16;
constexpr int D = 64, DM = PW;
constexpr int NW = 8, QBLK = 32, QB = QBLK * NW, KVBLK = 64, NQB = SEQ / QB;
__device__ __forceinline__ int crow(int r, int hi) { return (r & 3) + 8 * (r >> 2) + 4 * hi; }
#define SBAR() __builtin_amdgcn_sched_barrier(0)
__device__ __forceinline__ void cmask(f32x16& p0, f32x16& p1, int jb, int qrel, int hi) {
    const float NEG = -INFINITY; int kb = 64 * jb + 4 * hi;
#pragma unroll
    for (int r = 0; r < 16; ++r) { int kv = kb + (r & 3) + 8 * (r >> 2); if (kv > qrel) p0[r] = NEG; if (kv + 32 > qrel) p1[r] = NEG; }
}
constexpr int NSLOT = 3, SLOTB = 8192;
constexpr int LDS_K = 0, LDS_V = NSLOT * SLOTB, LDS_WS = 2 * NSLOT * SLOTB, LDS_OST = LDS_WS + NW * 64 * 4, LDS_CUM = LDS_OST + NW * 4096, LDS_OG = LDS_CUM + SEQ * 4, LDS_BYTES = LDS_OG + 256;
__device__ __forceinline__ void glds16(const void* gsrc, unsigned lds_dst) { unsigned keep;
    asm volatile("s_mov_b32 %0, m0\n\ts_mov_b32 m0, %2\n\ts_nop 0\n\tglobal_load_lds_dwordx4 %1, off\n\ts_mov_b32 m0, %0" : "=&s"(keep) : "v"(gsrc), "s"(lds_dst) : "memory"); }
typedef float f32x2_t __attribute__((ext_vector_type(2))); typedef __bf16 bf16x2_t __attribute__((ext_vector_type(2)));
__device__ __forceinline__ unsigned cvtpk_s(float lo, float hi) { f32x2_t v = {lo, hi}; bf16x2_t b = __builtin_convertvector(v, bf16x2_t); return __builtin_bit_cast(unsigned, b); }
#define WAIT_BAR(N) asm volatile("s_waitcnt vmcnt(" #N ") lgkmcnt(0)\n\ts_barrier" ::: "memory")
typedef LAS const char* lds_cptr;
typedef short v4i16_t __attribute__((ext_vector_type(4)));
__device__ __forceinline__ void split3(float x, unsigned& w0, unsigned& w1) {
    const unsigned xb = __float_as_uint(x), hb = xb & 0xffff0000u; const float r1 = x - __uint_as_float(hb);
    const unsigned mb = __float_as_uint(r1) & 0xffff0000u; const float r2 = r1 - __uint_as_float(mb);
    w0 = (hb >> 16) | mb; w1 = __float_as_uint(r2) >> 16;
}
__device__ __forceinline__ bf16x8 kbias_frag(float nk, int hi) {
    unsigned w0, w1; split3(nk, w0, w1);
    const u32x4 v = (u32x4){hi ? w0 : 0x3F803F80u, hi ? w1 : 0x00003F80u, 0u, 0u};
    return __builtin_bit_cast(bf16x8, v);
}
__device__ __forceinline__ bf16x8 qbias_frag(float cq, int hi) {
    unsigned w0, w1; split3(cq, w0, w1);
    const u32x4 v = (u32x4){hi ? 0x3F803F80u : w0, hi ? 0x00003F80u : w1, 0u, 0u};
    return __builtin_bit_cast(bf16x8, v);
}
#define Z16 (f32x16){0.f, 0.f, 0.f, 0.f, 0.f, 0.f, 0.f, 0.f, 0.f, 0.f, 0.f, 0.f, 0.f, 0.f, 0.f, 0.f}
__device__ __forceinline__ void qkt(f32x16& p0, f32x16& p1, const char* Kslot, const bf16x8* qr, bf16x8 kb0, bf16x8 kb1, bf16x8 qb, int r32, int hi) {
    const char* kb = Kslot + hi * 1024 + r32 * 16;
    p0 = __builtin_amdgcn_mfma_f32_32x32x16_bf16(kb0, qb, Z16, 0, 0, 0); p1 = __builtin_amdgcn_mfma_f32_32x32x16_bf16(kb1, qb, Z16, 0, 0, 0);
#pragma unroll
    for (int d0 = 0; d0 < 4; ++d0) {
        const bf16x8 b0 = *reinterpret_cast<const bf16x8*>(kb + d0 * 2048);
        const bf16x8 b1 = *reinterpret_cast<const bf16x8*>(kb + d0 * 2048 + 512);
        p0 = __builtin_amdgcn_mfma_f32_32x32x16_bf16(b0, qr[d0], p0, 0, 0, 0); p1 = __builtin_amdgcn_mfma_f32_32x32x16_bf16(b1, qr[d0], p1, 0, 0, 0); }
}
__device__ __forceinline__ void kload8(bf16x8* kf, lds_cptr kp) {
    kf[0] = *(const LAS bf16x8*)(kp);        kf[1] = *(const LAS bf16x8*)(kp + 512);
    kf[2] = *(const LAS bf16x8*)(kp + 2048); kf[3] = *(const LAS bf16x8*)(kp + 2560);
    kf[4] = *(const LAS bf16x8*)(kp + 4096); kf[5] = *(const LAS bf16x8*)(kp + 4608);
    kf[6] = *(const LAS bf16x8*)(kp + 6144); kf[7] = *(const LAS bf16x8*)(kp + 6656);
}
__device__ __forceinline__ void kload2(bf16x8* kf, lds_cptr kp, int j) { kf[2 * j] = *(const LAS bf16x8*)(kp + j * 2048); kf[2 * j + 1] = *(const LAS bf16x8*)(kp + j * 2048 + 512); }
__device__ __forceinline__ s16x4 vtr(lds_cptr p) { return __builtin_bit_cast(s16x4, __builtin_amdgcn_ds_read_tr16_b64_v4i16((LAS v4i16_t*)p)); }
__device__ __forceinline__ void pv(f32x16* o, int vb, bf16x8 pa0, bf16x8 pa1, bf16x8 pa2, bf16x8 pa3) {
#pragma unroll
    for (int d0 = 0; d0 < 2; ++d0) { s16x4 lo[4], hi[4];
#pragma unroll
        for (int ks = 0; ks < 4; ++ks) {
            asm volatile("ds_read_b64_tr_b16 %0,%1 offset:%c2" : "=&v"(lo[ks]) : "v"(vb), "i"(d0 * 4096 + ks * 1024) : "memory");
            asm volatile("ds_read_b64_tr_b16 %0,%1 offset:%c2" : "=&v"(hi[ks]) : "v"(vb), "i"(d0 * 4096 + ks * 1024 + 512) : "memory"); }
        asm volatile("s_waitcnt lgkmcnt(0)" ::: "memory"); SBAR();
#define PK(k) (bf16x8){lo[k][0], lo[k][1], lo[k][2], lo[k][3], hi[k][0], hi[k][1], hi[k][2], hi[k][3]}
        o[d0] = __builtin_amdgcn_mfma_f32_32x32x16_bf16(pa0, PK(0), o[d0], 0, 0, 0);
        o[d0] = __builtin_amdgcn_mfma_f32_32x32x16_bf16(pa1, PK(1), o[d0], 0, 0, 0);
        o[d0] = __builtin_amdgcn_mfma_f32_32x32x16_bf16(pa2, PK(2), o[d0], 0, 0, 0);
        o[d0] = __builtin_amdgcn_mfma_f32_32x32x16_bf16(pa3, PK(3), o[d0], 0, 0, 0);
#undef PK
    }
}

__device__ __forceinline__ void attn_unit(int b, int h, int qb, const bf16* P, bf16* O, float m0l, char* shm, bool pre, bool nxt) {
    int tid = threadIdx.x; asm volatile("" : "+v"(tid));
    const int lane = tid & 63, r32 = lane & 31, hi = lane >> 5; const int wid = __builtin_amdgcn_readfirstlane(tid >> 6);
    const long rowbase = (long)b * SEQ; const int q0 = qb * QB;
    const bf16* Qw = P + (rowbase + q0 + wid * QBLK) * DM + PC_Q + h * D;
    const bf16* Kh = P + rowbase * DM + PC_K + h * D, *Vh = P + rowbase * DM + PC_V + h * D;
    const unsigned lds0 = (unsigned)(uintptr_t)shm;
    float* wsf = (float*)(shm + LDS_WS) + wid * 64;
    const bf16* ksrc = Kh + (long)lane * DM + wid * 8;
    const bf16* vsrc = Vh + (long)(16 * (wid & 3) + (lane >> 2)) * DM + (wid >> 2) * 32 + (lane & 3) * 8;
    const unsigned kdst = lds0 + LDS_K + wid * 1024, vdst = lds0 + LDS_V + wid * 1024;
#define DMA_K(t, slot) glds16(ksrc + (long)(t) * KVBLK * DM, (unsigned)__builtin_amdgcn_readfirstlane(kdst + (slot)))
#define DMA_V(t, slot) glds16(vsrc + (long)(t) * KVBLK * DM, (unsigned)__builtin_amdgcn_readfirstlane(vdst + (slot)))
    const int vb0 = (int)(lds0 + LDS_V) + ((lane >> 4) & 1) * 32 + (lane & 3) * 8 + (4 * hi + ((lane & 15) >> 2)) * 64;
    const char* Kbase = shm + LDS_K; bf16x8 kf[8];
    const lds_cptr shm3 = (lds_cptr)shm; const lds_cptr kp0 = shm3 + LDS_K + hi * 1024 + r32 * 16; const lds_cptr vp0 = shm3 + LDS_V + ((lane >> 4) & 1) * 32 + (lane & 3) * 8 + (4 * hi + ((lane & 15) >> 2)) * 64;
    const lds_cptr cump = shm3 + LDS_CUM + r32 * 4;
    const int NT = (q0 + QB) / KVBLK;
    if (!pre) { DMA_K(0, 0); DMA_V(0, 0); DMA_K(1, SLOTB); }
    bf16x8 qr[4];
#pragma unroll
    for (int d0 = 0; d0 < 4; ++d0) qr[d0] = *reinterpret_cast<const bf16x8*>(&Qw[(long)r32 * DM + d0 * 16 + hi * 8]);
    float l_reg = 0.f; f32x16 o[2]; o[0] = f32x16{}; o[1] = f32x16{};
    const int qrel = wid * QBLK + r32;
    const bf16x8 qbf = qbias_frag(-*(const LAS float*)(shm3 + LDS_CUM + (q0 + qrel) * 4) - m0l, hi);
#define CMASK(P0, P1, t) do { int jb_ = (t) - (NT - 4); if (jb_ >= 0) cmask(P0, P1, jb_, qrel, hi); } while (0)
#define CKL(t, off) (*(const LAS float*)(cump + (t) * 256 + (off)))
    f32x16 pA0, pA1, pB0, pB1;
    int sl_prev = 0, sl_cur = 0, sl_next = SLOTB;
#define ROT() do { sl_prev = sl_cur; sl_cur = sl_next; sl_next = (sl_next == (NSLOT - 1) * SLOTB) ? 0 : sl_next + SLOTB; } while (0)
    DMA_K(2, 2 * SLOTB);
    bf16x8 kb0 = kbias_frag(CKL(0, 0), hi), kb1 = kbias_frag(CKL(0, 128), hi);
    WAIT_BAR(3);
    qkt(pA0, pA1, Kbase, qr, kb0, kb1, qbf, r32, hi); asm volatile("s_nop 15\n\ts_nop 7" : "+v"(pA0), "+v"(pA1)); CMASK(pA0, pA1, 0);
#pragma unroll
    for (int r = 0; r < 16; ++r) { pA0[r] = __builtin_amdgcn_exp2f(pA0[r]); pA1[r] = __builtin_amdgcn_exp2f(pA1[r]); }
    kb0 = kbias_frag(CKL(1, 0), hi); kb1 = kbias_frag(CKL(1, 128), hi);
    WAIT_BAR(0);
    DMA_K(3, 0); DMA_V(1, SLOTB);
    ROT();
    kload8(kf, kp0 + sl_cur);
    WAIT_BAR(2);
    s16x4 vlo[8], vhi[8]; u32x4 pw0, pw1, pw2, pw3; float nk0 = 0.f, nk1 = 0.f;
#define PKW(P, B) cvtpk_s(P[B], P[B + 1])
#define PAF(k) __builtin_bit_cast(bf16x8, pw##k)
#define VFR(i) (bf16x8){vlo[i][0], vlo[i][1], vlo[i][2], vlo[i][3], vhi[i][0], vhi[i][1], vhi[i][2], vhi[i][3]}
#define PIN(x) asm volatile("" : "+v"(x))
#define GAPA(MF, A0, A1, A2, A3, W0, W1, PW_) do { MF; sacc += A0; sacc += A1; sacc += A2; sacc += A3; PIN(sacc); W0; W1; PIN(PW_); SBAR(); } while (0)
#define EX(v) __builtin_amdgcn_exp2f(v)
#define GAPB(MF, X, B) do { MF; X[B] = EX(X[B]); X[B + 1] = EX(X[B + 1]); X[B + 2] = EX(X[B + 2]); X[B + 3] = EX(X[B + 3]); PIN(X); SBAR(); } while (0)
#define VRD(i) do { vlo[i] = vtr(vp_ + (((i) >> 2) * 4096 + ((i) & 3) * 1024)); vhi[i] = vtr(vp_ + (((i) >> 2) * 4096 + ((i) & 3) * 1024 + 512)); } while (0)
#define KRD(G, j) do { if (G) { kload2(kf, kp0 + sl_next, j); SBAR(); } } while (0)
#define STEP(C0, C1, P0, P1, t, GK, GV, GL, GI) do { SBAR(); \
    const lds_cptr vp_ = vp0 + sl_prev; \
    C0 = __builtin_amdgcn_mfma_f32_32x32x16_bf16(kb0, qbf, Z16, 0, 0, 0); C1 = __builtin_amdgcn_mfma_f32_32x32x16_bf16(kb1, qbf, Z16, 0, 0, 0); \
    if (GI) { nk0 = CKL((t) + 1, 0); nk1 = CKL((t) + 1, 128); } \
    SBAR(); \
    VRD(0); SBAR(); float sacc = (P0[0] + P0[1]); \
    GAPA(C0 = __builtin_amdgcn_mfma_f32_32x32x16_bf16(kf[0], qr[0], C0, 0, 0, 0), P0[2], P0[3], P0[4], P0[5],     pw0[0] = PKW(P0, 0), pw0[1] = PKW(P0, 2), pw0); \
    VRD(4); SBAR(); GAPA(C1 = __builtin_amdgcn_mfma_f32_32x32x16_bf16(kf[1], qr[0], C1, 0, 0, 0), P0[6], P0[7], P0[8], P0[9],     pw0[2] = PKW(P0, 4), pw0[3] = PKW(P0, 6), pw0); \
    VRD(1); SBAR(); GAPA(C0 = __builtin_amdgcn_mfma_f32_32x32x16_bf16(kf[2], qr[1], C0, 0, 0, 0), P0[10], P0[11], P0[12], P0[13], pw1[0] = PKW(P0, 8), pw1[1] = PKW(P0, 10), pw1); \
    VRD(5); SBAR(); GAPA(C1 = __builtin_amdgcn_mfma_f32_32x32x16_bf16(kf[3], qr[1], C1, 0, 0, 0), P0[14], P0[15], P1[0], P1[1],   pw1[2] = PKW(P0, 12), pw1[3] = PKW(P0, 14), pw1); \
    VRD(2); SBAR(); GAPA(C0 = __builtin_amdgcn_mfma_f32_32x32x16_bf16(kf[4], qr[2], C0, 0, 0, 0), P1[2], P1[3], P1[4], P1[5],     pw2[0] = PKW(P1, 0), pw2[1] = PKW(P1, 2), pw2); \
    VRD(6); SBAR(); GAPA(C1 = __builtin_amdgcn_mfma_f32_32x32x16_bf16(kf[5], qr[2], C1, 0, 0, 0), P1[6], P1[7], P1[8], P1[9],     pw2[2] = PKW(P1, 4), pw2[3] = PKW(P1, 6), pw2); \
    VRD(3); SBAR(); GAPA(C0 = __builtin_amdgcn_mfma_f32_32x32x16_bf16(kf[6], qr[3], C0, 0, 0, 0), P1[10], P1[11], P1[12], P1[13], pw3[0] = PKW(P1, 8), pw3[1] = PKW(P1, 10), pw3); \
    VRD(7); SBAR(); GAPA(C1 = __builtin_amdgcn_mfma_f32_32x32x16_bf16(kf[7], qr[3], C1, 0, 0, 0), P1[14], P1[15], 0.f, 0.f,       pw3[2] = PKW(P1, 12), pw3[3] = PKW(P1, 14), pw3); \
    l_reg += sacc; \
    if (GI) { kb0 = kbias_frag(nk0, hi); kb1 = kbias_frag(nk1, hi); } \
    if (GK) { DMA_K((t) + 3, sl_cur); } if (GV) { DMA_V((t) + 1, sl_next); } \
    CMASK(C0, C1, t); \
    SBAR(); \
    GAPB(o[0] = __builtin_amdgcn_mfma_f32_32x32x16_bf16(PAF(0), VFR(0), o[0], 0, 0, 0), C0, 0); \
    GAPB(o[1] = __builtin_amdgcn_mfma_f32_32x32x16_bf16(PAF(0), VFR(4), o[1], 0, 0, 0), C0, 4); \
    KRD(GL, 0); GAPB(o[0] = __builtin_amdgcn_mfma_f32_32x32x16_bf16(PAF(1), VFR(1), o[0], 0, 0, 0), C0, 8); \
    KRD(GL, 1); GAPB(o[1] = __builtin_amdgcn_mfma_f32_32x32x16_bf16(PAF(1), VFR(5), o[1], 0, 0, 0), C0, 12); \
    KRD(GL, 2); GAPB(o[0] = __builtin_amdgcn_mfma_f32_32x32x16_bf16(PAF(2), VFR(2), o[0], 0, 0, 0), C1, 0); \
    KRD(GL, 3); GAPB(o[1] = __builtin_amdgcn_mfma_f32_32x32x16_bf16(PAF(2), VFR(6), o[1], 0, 0, 0), C1, 4); \
    GAPB(o[0] = __builtin_amdgcn_mfma_f32_32x32x16_bf16(PAF(3), VFR(3), o[0], 0, 0, 0), C1, 8); \
    GAPB(o[1] = __builtin_amdgcn_mfma_f32_32x32x16_bf16(PAF(3), VFR(7), o[1], 0, 0, 0), C1, 12); \
    } while (0)
    int t = 1;
#undef CMASK
#define CMASK(P0, P1, t) do {} while (0)
    for (; t + 5 < NT; t += 2) {
        STEP(pB0, pB1, pA0, pA1, t, true, true, true, true);     WAIT_BAR(2); ROT();
        STEP(pA0, pA1, pB0, pB1, t + 1, true, true, true, true); WAIT_BAR(2); ROT();
    }
#undef CMASK
#define CMASK(P0, P1, t) do { int jb_ = (t) - (NT - 4); if (jb_ >= 0) cmask(P0, P1, jb_, qrel, hi); } while (0)
#define ENDW(tt) do { if ((tt) + 3 < NT) { WAIT_BAR(2); } else if ((tt) + 2 < NT) { WAIT_BAR(1); } else { WAIT_BAR(0); } } while (0)
    for (; t + 1 < NT; t += 2) {
        STEP(pB0, pB1, pA0, pA1, t, (t + 3 < NT), (t + 1 < NT), (t + 1 < NT), (t + 1 < NT));     ENDW(t);     ROT();
        STEP(pA0, pA1, pB0, pB1, t + 1, (t + 4 < NT), (t + 2 < NT), (t + 2 < NT), (t + 2 < NT)); ENDW(t + 1); ROT();
    }
    STEP(pB0, pB1, pA0, pA1, NT - 1, false, false, false, false);
    { float sacc = pB0[0] + pB0[1];
#pragma unroll
      for (int r = 2; r < 16; ++r) sacc += pB0[r];
#pragma unroll
      for (int r = 0; r < 16; ++r) sacc += pB1[r];
      l_reg += sacc;
      pw0 = (u32x4){PKW(pB0, 0), PKW(pB0, 2), PKW(pB0, 4), PKW(pB0, 6)}; pw1 = (u32x4){PKW(pB0, 8), PKW(pB0, 10), PKW(pB0, 12), PKW(pB0, 14)}; pw2 = (u32x4){PKW(pB1, 0), PKW(pB1, 2), PKW(pB1, 4), PKW(pB1, 6)}; pw3 = (u32x4){PKW(pB1, 8), PKW(pB1, 10), PKW(pB1, 12), PKW(pB1, 14)};
      SBAR(); pv(o, vb0 + sl_cur, PAF(0), PAF(1), PAF(2), PAF(3)); }
#undef PKW
#undef PAF
#undef VFR
#undef PIN
#undef GAPA
#undef GAPB
#undef EX
#undef VRD
#undef KRD
#undef STEP
#undef ENDW
    if (nxt) { asm volatile("s_waitcnt lgkmcnt(0)\n\ts_barrier" ::: "memory");
        DMA_K(0, 0); DMA_V(0, 0); DMA_K(1, SLOTB); }
    { auto rr = __builtin_amdgcn_permlane32_swap(__float_as_uint(l_reg), __float_as_uint(l_reg), false, false); l_reg = __uint_as_float(rr[0]) + __uint_as_float(rr[1]); }
    if (hi == 0) wsf[32 + r32] = l_reg; asm volatile("s_waitcnt lgkmcnt(0)" ::: "memory");
    float rli[16];
#pragma unroll
    for (int r = 0; r < 16; ++r) rli[r] = __builtin_amdgcn_rcpf(wsf[32 + crow(r, hi)]);
    bf16* Ow = O + (rowbase + q0 + wid * QBLK) * DMODEL + h * D;
    { bf16* stg = (bf16*)(shm + LDS_OST) + wid * 2048;
#pragma unroll
      for (int r = 0; r < 16; ++r) { const int orow = crow(r, hi);
#pragma unroll
          for (int d0 = 0; d0 < 2; ++d0) stg[orow * 64 + d0 * 32 + r32] = __float2bfloat16(o[d0][r] * rli[r]); }
      asm volatile("s_waitcnt lgkmcnt(0)" ::: "memory");
      const int ch = lane & 7; const f32x4 g0 = *(const LAS f32x4*)(shm3 + LDS_OG + ch * 32), g1 = *(const LAS f32x4*)(shm3 + LDS_OG + ch * 32 + 16);
#pragma unroll
      for (int i = 0; i < 4; ++i) { const int row = i * 8 + (lane >> 3); const u32x4 v = *(const u32x4*)(stg + row * 64 + ch * 8);
          float f[8]; f[0] = bf_lo(v.x); f[1] = bf_hi(v.x); f[2] = bf_lo(v.y); f[3] = bf_hi(v.y); f[4] = bf_lo(v.z); f[5] = bf_hi(v.z); f[6] = bf_lo(v.w); f[7] = bf_hi(v.w);
          float ss = 0.f;
#pragma unroll
          for (int j = 0; j < 8; ++j) ss += f[j] * f[j];
          ss += __shfl_xor(ss, 1); ss += __shfl_xor(ss, 2); ss += __shfl_xor(ss, 4);
          const float rs = __builtin_amdgcn_rsqf(ss * (1.0f / 64.0f) + NORM_EPS);
          u32x4 w; w.x = cvtpk_s(f[0] * rs * g0[0], f[1] * rs * g0[1]); w.y = cvtpk_s(f[2] * rs * g0[2], f[3] * rs * g0[3]); w.z = cvtpk_s(f[4] * rs * g1[0], f[5] * rs * g1[1]); w.w = cvtpk_s(f[6] * rs * g1[2], f[7] * rs * g1[3]);
          *(u32x4*)(Ow + (long)row * DMODEL + ch * 8) = w; } }
    asm volatile("s_waitcnt lgkmcnt(0)\n\ts_barrier" ::: "memory");
#undef DMA_K
#undef DMA_V
#undef CMASK
#undef CKL
#undef ROT
}
constexpr int ATTN_LDS_BYTES = LDS_BYTES;

__device__ __forceinline__ float attn_prep(int b, int h, const float* logf, const float* gq, const float* gk, const float* og, char* shm) {
    int tid = threadIdx.x; asm volatile("" : "+v"(tid));
    const int lane = tid & 63, wid = tid >> 6;
    LAS float* cum = (LAS float*)((lds_cptr)shm + LDS_CUM);
    LAS float* wtot = (LAS float*)((lds_cptr)shm + LDS_WS);
    const float* src = logf + ((size_t)b * SEQ + 4 * tid) * AH + h;
    float v0 = src[0], v1 = src[AH], v2 = src[2 * AH], v3 = src[3 * AH];
    v1 += v0; v2 += v1; v3 += v2;
    float inc = v3;
#pragma unroll
    for (int o = 1; o < 64; o <<= 1) { const float y = __shfl_up(inc, o); if (lane >= o) inc += y; }
    if (lane == 63) wtot[wid] = inc;
    if (tid < D) *(LAS float*)((lds_cptr)shm + LDS_OG + tid * 4) = og[h * D + tid];
    float mq = fabsf(gq[lane]), mk = fabsf(gk[lane]);
#pragma unroll
    for (int o = 1; o < 64; o <<= 1) { mq = fmaxf(mq, __shfl_xor(mq, o)); mk = fmaxf(mk, __shfl_xor(mk, o)); }
    __syncthreads();
    float off = inc - v3;
    for (int w = 0; w < wid; ++w) off += wtot[w];
    *(LAS f32x4*)(cum + 4 * tid) = (f32x4){-(off + v0) * LOG2E, -(off + v1) * LOG2E, -(off + v2) * LOG2E, -(off + v3) * LOG2E};
    __syncthreads();
    return 8.0f * mq * mk * LOG2E;
}
#undef SBAR
#undef WAIT_BAR
}
namespace hgrn {
constexpr int C = 64, NCHUNK = SEQ / C;
constexpr int RS = 272, RS64 = 144;
constexpr int L_QT = 0, L_KT = 17408, L_QH = 34816, L_KHT = 52224, L_VT = 70656, L_ST = 89088, L_P = 123904, L_DL = 133120, L_OG = 133632, L_OUT = 134144, L_BYTES = 151552;
__device__ __forceinline__ bf16x8 frag(LAS unsigned char* lds, int base, int row, int rs, int kb) { return *(const LAS bf16x8*)(lds + base + row * rs + kb); }
__device__ __forceinline__ bf16x8 fragr(LAS unsigned char* lds, int base, int row, int kb) { return *(const LAS bf16x8*)(lds + base + row * RS + ((kb + ((row >> 3) << 5)) & 255)); }
__device__ __forceinline__ float h_lo(unsigned u) { h16x2 v = __builtin_bit_cast(h16x2, u); return (float)v.x; }
__device__ __forceinline__ float h_hi(unsigned u) { h16x2 v = __builtin_bit_cast(h16x2, u); return (float)v.y; }

template <int SKH = 0>
__device__ __forceinline__ void hgrn_unit(int b, int h, const bf16_t* P, bf16_t* AO, const float* og, LAS unsigned char* lds) {
#define HG_SYNC() do { if constexpr (SKH != 4) __syncthreads(); } while (0)
    int tid = threadIdx.x; asm volatile("" : "+v"(tid));
    const int lane = tid & 63, w = __builtin_amdgcn_readfirstlane(tid >> 6);
    const int cp = lane & 7, oct = lane >> 3, fr = lane & 15, fq = lane >> 4;
    const int k0 = 16 * w + 2 * cp;
    const size_t rowbase = (size_t)b * SEQ;
    const bf16_t* pq = P + (rowbase + 8 * oct) * PW + PC_HQ + h * HK + k0;
    const bf16_t* pg = P + (rowbase + 8 * oct) * PW + PC_HG + h * HK + k0;
    const bf16_t* pv = P + (rowbase + 8 * oct) * PW + PC_HV + h * HK + k0;
    const int tn = tid >> 3, seg = tid & 7;
    const bf16_t* pgate = P + (rowbase + tn) * PW + PC_HO + h * HK + 16 * seg;
    bf16_t* pout = AO + (rowbase + tn) * DMODEL + AW + h * HK + 16 * seg;
    if (tid < HK) *(LAS float*)(lds + L_OG + tid * 4) = og[h * HK + tid];
    for (int i = tid; i < (128 * RS) / 16; i += 512) *(LAS u32x4*)(lds + L_ST + i * 16) = (u32x4){0u, 0u, 0u, 0u};
    f32x4 sacc[8];
#pragma unroll
    for (int i = 0; i < 8; ++i) sacc[i] = (f32x4){0.f, 0.f, 0.f, 0.f};
    unsigned rq[8], rg[8], rv[8];
#pragma unroll
    for (int i = 0; i < 8; ++i) { rq[i] = *(const unsigned*)(pq + (size_t)i * PW); rg[i] = *(const unsigned*)(pg + (size_t)i * PW); rv[i] = *(const unsigned*)(pv + (size_t)i * PW); }
    const int ti = w >> 1, vh = w & 1;
#define HG_NORM(cc, G0, G1) do { if constexpr (SKH != 3) { \
        const u32x4 oa = *(const LAS u32x4*)(lds + L_OUT + tn * RS + 32 * seg), ob = *(const LAS u32x4*)(lds + L_OUT + tn * RS + 32 * seg + 16); \
        const unsigned ou[8] = {oa.x, oa.y, oa.z, oa.w, ob.x, ob.y, ob.z, ob.w}; float ss = 0.f; \
        _Pragma("unroll") for (int j = 0; j < 8; ++j) ss += bf_lo(ou[j]) * bf_lo(ou[j]) + bf_hi(ou[j]) * bf_hi(ou[j]); \
        ss += __shfl_xor(ss, 1); ss += __shfl_xor(ss, 2); ss += __shfl_xor(ss, 4); \
        const float rs = __builtin_amdgcn_rsqf(ss * (1.0f / 128.0f) + NORM_EPS); \
        const unsigned gw[8] = {G0.x, G0.y, G0.z, G0.w, G1.x, G1.y, G1.z, G1.w}; unsigned ow[8]; \
        _Pragma("unroll") for (int j = 0; j < 4; ++j) { const f32x4 g = *(const LAS f32x4*)(lds + L_OG + (16 * seg + 4 * j) * 4); \
            ow[2 * j] = cvt_pk_bf16(bf_lo(ou[2 * j]) * rs * g[0] * bf_lo(gw[2 * j]), bf_hi(ou[2 * j]) * rs * g[1] * bf_hi(gw[2 * j])); \
            ow[2 * j + 1] = cvt_pk_bf16(bf_lo(ou[2 * j + 1]) * rs * g[2] * bf_lo(gw[2 * j + 1]), bf_hi(ou[2 * j + 1]) * rs * g[3] * bf_hi(gw[2 * j + 1])); } \
        bf16_t* po = pout + (size_t)(C * (cc)) * DMODEL; \
        *(u32x4*)po = (u32x4){ow[0], ow[1], ow[2], ow[3]}; *(u32x4*)(po + 8) = (u32x4){ow[4], ow[5], ow[6], ow[7]}; } } while (0)
#pragma unroll 1
    for (int c = 0; c < NCHUNK; ++c) {
        const int cprev = c > 0 ? c - 1 : 0;
        const u32x4 gt0 = *(const u32x4*)(pgate + (size_t)(C * cprev) * PW), gt1 = *(const u32x4*)(pgate + (size_t)(C * cprev) * PW + 8);
        if constexpr (SKH != 2) {
            float f0[8], f1[8], p0[8], p1[8], s0[8], s1[8];
#pragma unroll
            for (int i = 0; i < 8; ++i) { f0[i] = h_lo(rg[i]); f1[i] = h_hi(rg[i]); }
            p0[0] = f0[0]; p1[0] = f1[0];
#pragma unroll
            for (int i = 1; i < 8; ++i) { p0[i] = p0[i - 1] * f0[i]; p1[i] = p1[i - 1] * f1[i]; }
            s0[7] = 1.0f; s1[7] = 1.0f;
#pragma unroll
            for (int i = 6; i >= 0; --i) { s0[i] = s0[i + 1] * f0[i + 1]; s1[i] = s1[i + 1] * f1[i + 1]; }
            const float lt0 = __builtin_amdgcn_logf(p0[7]), lt1 = __builtin_amdgcn_logf(p1[7]);
            float x0 = lt0, x1 = lt1;
#pragma unroll
            for (int o = 8; o < 64; o <<= 1) { const float y0 = __shfl_up(x0, o), y1 = __shfl_up(x1, o); if (lane >= o) { x0 += y0; x1 += y1; } }
            const float off0 = x0 - lt0, off1 = x1 - lt1;
            const float a0 = __shfl(x0, cp + 24), a1 = __shfl(x1, cp + 24), e0 = __shfl(x0, cp + 56), e1 = __shfl(x1, cp + 56);
            const float Eq0 = __builtin_amdgcn_exp2f(fminf(off0 - a0, 120.f)), Eq1 = __builtin_amdgcn_exp2f(fminf(off1 - a1, 120.f));
            const float Ek0 = __builtin_amdgcn_exp2f(fminf(a0 - x0, 120.f)), Ek1 = __builtin_amdgcn_exp2f(fminf(a1 - x1, 120.f));
            const float Eh0 = __builtin_amdgcn_exp2f(off0), Eh1 = __builtin_amdgcn_exp2f(off1);
            const float El0 = __builtin_amdgcn_exp2f(e0 - x0), El1 = __builtin_amdgcn_exp2f(e1 - x1);
            unsigned kh0[4], kh1[4], vt0[4], vt1[4];
            float pkh0 = 0.f, pkh1 = 0.f;
            const int rotw = (32 * (w + oct)) & 255;
#pragma unroll
            for (int i = 0; i < 8; ++i) {
                const int t = 8 * oct + i;
                const float qp0 = bf_lo(rq[i]) * p0[i], qp1 = bf_hi(rq[i]) * p1[i];
                const float ks0 = (1.0f - f0[i]) * s0[i], ks1 = (1.0f - f1[i]) * s1[i];
                *(LAS unsigned*)(lds + L_QT + t * RS + rotw + 4 * cp) = cvt_pk_bf16(qp0 * Eq0, qp1 * Eq1);
                *(LAS unsigned*)(lds + L_KT + t * RS + rotw + 4 * cp) = cvt_pk_bf16(ks0 * Ek0, ks1 * Ek1);
                *(LAS unsigned*)(lds + L_QH + t * RS + rotw + 4 * cp) = cvt_pk_bf16(qp0 * Eh0, qp1 * Eh1);
                const float kha = ks0 * El0, khb = ks1 * El1;
                if (i & 1) { kh0[i >> 1] = cvt_pk_bf16(pkh0, kha); kh1[i >> 1] = cvt_pk_bf16(pkh1, khb); vt0[i >> 1] = (rv[i - 1] & 0xffffu) | (rv[i] << 16); vt1[i >> 1] = (rv[i - 1] >> 16) | (rv[i] & 0xffff0000u); }
                else { pkh0 = kha; pkh1 = khb; }
            }
            *(LAS u32x4*)(lds + L_KHT + k0 * RS64 + 16 * oct) = (u32x4){kh0[0], kh0[1], kh0[2], kh0[3]};
            *(LAS u32x4*)(lds + L_KHT + (k0 + 1) * RS64 + 16 * oct) = (u32x4){kh1[0], kh1[1], kh1[2], kh1[3]};
            *(LAS u32x4*)(lds + L_VT + k0 * RS64 + 16 * oct) = (u32x4){vt0[0], vt0[1], vt0[2], vt0[3]};
            *(LAS u32x4*)(lds + L_VT + (k0 + 1) * RS64 + 16 * oct) = (u32x4){vt1[0], vt1[1], vt1[2], vt1[3]};
            if (oct == 0) *(LAS f32x2*)(lds + L_DL + k0 * 4) = (f32x2){__builtin_amdgcn_exp2f(e0), __builtin_amdgcn_exp2f(e1)};
        }
        if (c + 1 < NCHUNK) {
#pragma unroll
            for (int i = 0; i < 8; ++i) { const size_t o = (size_t)(C * (c + 1) + i) * PW; rq[i] = *(const unsigned*)(pq + o); rg[i] = *(const unsigned*)(pg + o); rv[i] = *(const unsigned*)(pv + o); }
        }
        HG_SYNC();
        f32x4 oacc[4] = {(f32x4){0.f, 0.f, 0.f, 0.f}, (f32x4){0.f, 0.f, 0.f, 0.f}, (f32x4){0.f, 0.f, 0.f, 0.f}, (f32x4){0.f, 0.f, 0.f, 0.f}};
        if constexpr (SKH != 1) {
            bf16x8 qf[4];
#pragma unroll
            for (int ks = 0; ks < 4; ++ks) qf[ks] = fragr(lds, L_QT, 16 * ti + fr, 64 * ks + 16 * fq);
#pragma unroll
            for (int sj = 0; sj < 2; ++sj) { const int si = 2 * vh + sj; u32x2 pk = (u32x2){0u, 0u};
                if (si <= ti) { f32x4 a = (f32x4){0.f, 0.f, 0.f, 0.f};
#pragma unroll
                    for (int ks = 0; ks < 4; ++ks) a = __builtin_amdgcn_mfma_f32_16x16x32_bf16(fragr(lds, L_KT, 16 * si + fr, 64 * ks + 16 * fq), qf[ks], a, 0, 0, 0);
                    const int s0 = 16 * si + 4 * fq, t = 16 * ti + fr;
#pragma unroll
                    for (int e = 0; e < 4; ++e) a[e] = (s0 + e <= t) ? a[e] : 0.f;
                    pk.x = cvt_pk_bf16(a[0], a[1]); pk.y = cvt_pk_bf16(a[2], a[3]); }
                *(LAS u32x2*)(lds + L_P + (16 * ti + fr) * RS64 + (16 * si + 4 * fq) * 2) = pk; }
#pragma unroll
            for (int ks = 0; ks < 4; ++ks) qf[ks] = fragr(lds, L_QH, 16 * ti + fr, 64 * ks + 16 * fq);
#pragma unroll
            for (int vj = 0; vj < 4; ++vj) { oacc[vj] = (f32x4){0.f, 0.f, 0.f, 0.f};
#pragma unroll
                for (int ks = 0; ks < 4; ++ks) oacc[vj] = __builtin_amdgcn_mfma_f32_16x16x32_bf16(frag(lds, L_ST, 16 * (4 * vh + vj) + fr, RS, 64 * ks + 16 * fq), qf[ks], oacc[vj], 0, 0, 0); }
        }
        if (c > 0) HG_NORM(c - 1, gt0, gt1);
        HG_SYNC();
        if constexpr (SKH != 1) {
            bf16x8 pf[2];
#pragma unroll
            for (int ks = 0; ks < 2; ++ks) pf[ks] = frag(lds, L_P, 16 * ti + fr, RS64, 64 * ks + 16 * fq);
#pragma unroll
            for (int vj = 0; vj < 4; ++vj)
#pragma unroll
                for (int ks = 0; ks < 2; ++ks) oacc[vj] = __builtin_amdgcn_mfma_f32_16x16x32_bf16(frag(lds, L_VT, 16 * (4 * vh + vj) + fr, RS64, 64 * ks + 16 * fq), pf[ks], oacc[vj], 0, 0, 0);
            const f32x4 dl = *(const LAS f32x4*)(lds + L_DL + (16 * w + 4 * fq) * 4);
            bf16x8 kf[2];
#pragma unroll
            for (int ks = 0; ks < 2; ++ks) kf[ks] = frag(lds, L_KHT, 16 * w + fr, RS64, 64 * ks + 16 * fq);
#pragma unroll
            for (int vt = 0; vt < 8; ++vt) { sacc[vt] = sacc[vt] * dl;
#pragma unroll
                for (int ks = 0; ks < 2; ++ks) sacc[vt] = __builtin_amdgcn_mfma_f32_16x16x32_bf16(kf[ks], frag(lds, L_VT, 16 * vt + fr, RS64, 64 * ks + 16 * fq), sacc[vt], 0, 0, 0);
                u32x2 sk; sk.x = cvt_pk_bf16(sacc[vt][0], sacc[vt][1]); sk.y = cvt_pk_bf16(sacc[vt][2], sacc[vt][3]);
                *(LAS u32x2*)(lds + L_ST + (16 * vt + fr) * RS + (16 * w + 4 * fq) * 2) = sk; }
#pragma unroll
            for (int vj = 0; vj < 4; ++vj) *(LAS u32x2*)(lds + L_OUT + (16 * ti + fr) * RS + (16 * (4 * vh + vj) + 4 * fq) * 2) = (u32x2){cvt_pk_bf16(oacc[vj][0], oacc[vj][1]), cvt_pk_bf16(oacc[vj][2], oacc[vj][3])};
        }
        HG_SYNC();
    }
    { const u32x4 gt0 = *(const u32x4*)(pgate + (size_t)(C * (NCHUNK - 1)) * PW), gt1 = *(const u32x4*)(pgate + (size_t)(C * (NCHUNK - 1)) * PW + 8); HG_NORM(NCHUNK - 1, gt0, gt1); }
    HG_SYNC();
#undef HG_NORM
#undef HG_SYNC
}
}
constexpr int NWAVES = 8;
constexpr size_t MiB = 1u << 20;
constexpr size_t WS_CTL = 0, CTL_ZERO_BYTES = 1 * MiB;
constexpr size_t WS_MOD = 1 * MiB;
constexpr size_t WS_LOGF = 2 * MiB;
constexpr size_t WS_WIN = 4 * MiB;
constexpr size_t WS_WO = 12 * MiB;
constexpr size_t WS_W1 = 14 * MiB;
constexpr size_t WS_WD = 46 * MiB;
constexpr size_t WS_LIST = 62 * MiB;
constexpr size_t WS_LW = 68 * MiB;
constexpr size_t WS_XN = 80 * MiB;
constexpr size_t WS_AO = 208 * MiB;
constexpr size_t WS_PROJ = 336 * MiB;
constexpr size_t WS_X1 = 784 * MiB;
constexpr size_t WS_END = 912 * MiB;
constexpr int CW_BAR = 4096, CW_CNT = 16384;

constexpr int RING_OFF = 0, RING_BYTES = 155648;
constexpr int LDSCTL_OFF = RING_BYTES, MISC_OFF = LDSCTL_OFF + 64, TAB_OFF = LDSCTL_OFF + 256;
constexpr int LDS_BYTES = RING_BYTES + 1024;
static_assert(hgrn::L_BYTES <= RING_BYTES && attn_body::ATTN_LDS_BYTES <= RING_BYTES && pg8::STAGE_BYTES <= RING_BYTES, "LDS map");

typedef GAS unsigned gu32;
#define RLX_AGENT __ATOMIC_RELAXED, __HIP_MEMORY_SCOPE_AGENT
#define LDS_WAIT() asm volatile("s_waitcnt lgkmcnt(0)" ::: "memory")

#define XB_TMO      128
#define XB_XCNT(j)  (256  + 64 * (j))
#define XB_XSUB(j)  (1280 + 64 * (j))
#define XB_XGEN(j)  (2304 + 64 * (j))
#define XB_TOP      3328
#define XB_TOPGEN   3392
#define XCD_BAR_WORDS 3456
#define XB_SPIN_CAP (1u << 20)
__device__ __forceinline__ unsigned xb_ld(unsigned* p)              { return __hip_atomic_load(p, __ATOMIC_RELAXED, __HIP_MEMORY_SCOPE_AGENT); }
__device__ __forceinline__ unsigned xb_add(unsigned* p, unsigned v) { return __hip_atomic_fetch_add(p, v, __ATOMIC_RELAXED, __HIP_MEMORY_SCOPE_AGENT); }
__device__ __forceinline__ unsigned xb_xcc_id() { return (unsigned)__builtin_amdgcn_s_getreg((3 << 11) | 20) & 0xFu; }
#define XB_SPIN(cond, bar) do { unsigned _sp = 0; while (cond) { __builtin_amdgcn_s_sleep(1); \
    if ((++_sp & 255u) == 0u) { if (xb_ld(&(bar)[XB_TMO])) break; if (_sp > XB_SPIN_CAP) { atomicAdd(&(bar)[XB_TMO], 1u); break; } } } } while (0)
struct XcdBarrier { unsigned* bar; unsigned x; volatile LAS unsigned* st; };
__device__ __forceinline__ XcdBarrier xcd_barrier_post(unsigned* bar, volatile LAS unsigned* st) {
    XcdBarrier b; b.bar = bar; b.x = xb_xcc_id(); b.st = st;
    if (threadIdx.x == 0) (void)xb_add(&bar[XB_XCNT(b.x)], 1u);
    return b;
}
__device__ __forceinline__ void xcd_barrier_complete(unsigned* bar, unsigned x, unsigned& nloc, unsigned& nx) {
    const unsigned G = gridDim.x * gridDim.y * gridDim.z;
    unsigned sum, cnt, mine, sp = 0u;
    for (;;) {
        sum = 0u; cnt = 0u; mine = 0u;
#pragma unroll
        for (unsigned j = 0; j < 16; ++j) { const unsigned c = xb_ld(&bar[XB_XCNT(j)]); sum += c; cnt += (c > 0u) ? 1u : 0u; mine = (j == x) ? c : mine; }
        if (sum == G) break;
        __builtin_amdgcn_s_sleep(1);
        if ((++sp & 255u) == 0u) { if (xb_ld(&bar[XB_TMO])) break; if (sp > XB_SPIN_CAP) { atomicAdd(&bar[XB_TMO], 1u); break; } }
    }
    nloc = mine > 0u ? mine : 1u; nx = cnt > 0u ? cnt : 1u;
}
__device__ __forceinline__ void xcd_barrier(const XcdBarrier& b) {
    asm volatile("s_waitcnt vmcnt(0)" ::: "memory");
    __syncthreads();
    if (threadIdx.x == 0) {
        unsigned* bar = b.bar;
        __builtin_amdgcn_s_waitcnt(0);
        unsigned nloc = b.st[0], nx = b.st[1];
        if (nloc == 0u) { xcd_barrier_complete(bar, b.x, nloc, nx); b.st[0] = nloc; b.st[1] = nx; }
        const unsigned old = xb_add(&bar[XB_XSUB(b.x)], 1u);
        const unsigned gen = old / nloc;
        if (old + 1u == (gen + 1u) * nloc) {
            __builtin_amdgcn_fence(__ATOMIC_RELEASE, "agent");
            asm volatile("s_waitcnt vmcnt(0)" ::: "memory");
            const unsigned og = xb_add(&bar[XB_TOP], 1u);
            const unsigned tg = og / nx;
            if (og + 1u == (tg + 1u) * nx) xb_add(&bar[XB_TOPGEN], 1u);
            else XB_SPIN(xb_ld(&bar[XB_TOPGEN]) == tg, bar);
            __builtin_amdgcn_fence(__ATOMIC_ACQUIRE, "agent");
            xb_add(&bar[XB_XGEN(b.x)], 1u);
            asm volatile("s_waitcnt vmcnt(0)" ::: "memory");
        } else {
            XB_SPIN(xb_ld(&bar[XB_XGEN(b.x)]) == gen, bar);
            __builtin_amdgcn_fence(__ATOMIC_ACQUIRE, "agent");
            asm volatile("s_waitcnt vmcnt(0)" ::: "memory");
        }
    }
    __syncthreads();
}

__device__ __forceinline__ f32x2 lo2(f32x4 v) { return __builtin_shufflevector(v, v, 0, 1); }
__device__ __forceinline__ f32x2 hi2(f32x4 v) { return __builtin_shufflevector(v, v, 2, 3); }
__device__ __forceinline__ f32x2 fma2(f32x2 a, f32x2 b, f32x2 c) { return __builtin_elementwise_fma(a, b, c); }
__device__ __forceinline__ float wave_sum(float v) {
#pragma unroll
    for (int o = 1; o < 64; o <<= 1) v += __shfl_xor(v, o);
    return v;
}
template <int CTRL, int RM> __device__ __forceinline__ float dpp_step(float t) { return t + __int_as_float(__builtin_amdgcn_update_dpp(0, __float_as_int(t), CTRL, RM, 0xf, false)); }
#define DPP_TOTAL63(t) do { t = dpp_step<0xB1, 0xf>(t); t = dpp_step<0x4E, 0xf>(t); t = dpp_step<0x141, 0xf>(t); t = dpp_step<0x140, 0xf>(t); t = dpp_step<0x142, 0xa>(t); t = dpp_step<0x143, 0xc>(t); } while (0)
__device__ __forceinline__ float wave_sum_dpp(float v) { DPP_TOTAL63(v); return __int_as_float(__builtin_amdgcn_readlane(__float_as_int(v), 63)); }
__device__ __forceinline__ unsigned f2bf(float f) { unsigned u = __builtin_bit_cast(unsigned, f); return (u + 0x7fffu + ((u >> 16) & 1u)) >> 16; }
__device__ __forceinline__ unsigned pk2(float lo, float hi) { return f2bf(lo) | (f2bf(hi) << 16); }

__device__ __forceinline__ void transpose_item(const float* W, int ldw, bf16_t* WT, int ldt, LAS float* scr, int lane) {
    float tv[32];
#pragma unroll
    for (int i = 0; i < 32; ++i) tv[i] = W[(size_t)(2 * i + (lane >> 5)) * ldw + (lane & 31)];
#pragma unroll
    for (int i = 0; i < 32; ++i) scr[(2 * i + (lane >> 5)) * 33 + (lane & 31)] = tv[i];
    LDS_WAIT(); asm volatile("" ::: "memory");
    const int c = lane & 7;
#pragma unroll
    for (int j = 0; j < 4; ++j) { const int n = (lane >> 3) + 8 * j; const LAS float* s = scr + (8 * c) * 33 + n;
        u32x4 o; o.x = pk2(s[0 * 33], s[1 * 33]); o.y = pk2(s[2 * 33], s[3 * 33]); o.z = pk2(s[4 * 33], s[5 * 33]); o.w = pk2(s[6 * 33], s[7 * 33]);
        *(GAS u32x4*)(WT + (size_t)n * ldt + 8 * c) = o; }
    LDS_WAIT(); asm volatile("" ::: "memory");
}

__device__ __forceinline__ void transpose_item_fp8(const float* W, int ldw, unsigned char* WT, int ldt, LAS float* scr, int lane, float scale) {
    float tv[32];
#pragma unroll
    for (int i = 0; i < 32; ++i) tv[i] = W[(size_t)(2 * i + (lane >> 5)) * ldw + (lane & 31)];
#pragma unroll
    for (int i = 0; i < 32; ++i) scr[(2 * i + (lane >> 5)) * 33 + (lane & 31)] = tv[i] * scale;
    LDS_WAIT(); asm volatile("" ::: "memory");
    const int c = lane & 3;
#pragma unroll
    for (int j = 0; j < 2; ++j) { const int n = (lane >> 2) + 16 * j; const LAS float* s = scr + (16 * c) * 33 + n;
        u32x4 o; o.x = pg8::pk4_fp8(s[0 * 33], s[1 * 33], s[2 * 33], s[3 * 33]); o.y = pg8::pk4_fp8(s[4 * 33], s[5 * 33], s[6 * 33], s[7 * 33]);
        o.z = pg8::pk4_fp8(s[8 * 33], s[9 * 33], s[10 * 33], s[11 * 33]); o.w = pg8::pk4_fp8(s[12 * 33], s[13 * 33], s[14 * 33], s[15 * 33]);
        *(GAS u32x4*)(WT + (size_t)n * ldt + 16 * c) = o; }
    LDS_WAIT(); asm volatile("" ::: "memory");
}

struct Args { const float* in[21]; float* out; unsigned char* ws; int ph_lo, ph_hi; };

__device__ __forceinline__ void p0_phase(const Args& a, LAS unsigned char* lds, int vcu, int G, int tid_, int lane_, int wave) {
    int tid = tid_; asm volatile("" : "+v"(tid)); const int lane = tid & 63;
    const float* c = a.in[1]; const float* w_ada = a.in[2]; const float* b_ada = a.in[3];
    float* mod = (float*)(a.ws + WS_MOD);
    LAS float* sc = (LAS float*)lds;
    for (int cb = vcu; cb < 6144 / 24; cb += G) {
#pragma unroll 1
        for (int i0 = tid; i0 < BATCH * DMODEL; i0 += 512 * 16) { float cv[16];
#pragma unroll
            for (int u = 0; u < 16; ++u) cv[u] = c[i0 + 512 * u];
#pragma unroll
            for (int u = 0; u < 16; ++u) { const int i = i0 + 512 * u, b = i >> 10, k = i & 1023; sc[k * 36 + b] = siluf_(cv[u]); } }
        __syncthreads();
        const int col = tid % 24, kg = tid / 24;
        float acc[32];
#pragma unroll
        for (int b = 0; b < 32; ++b) acc[b] = 0.f;
        if (kg < 16) {
            const float* wp = w_ada + (size_t)(kg * 64) * 6144 + cb * 24 + col;
            float wv[64];
#pragma unroll
            for (int k = 0; k < 64; ++k) wv[k] = wp[(size_t)k * 6144];
#pragma unroll
            for (int k = 0; k < 64; ++k) { const float w = wv[k]; const LAS f32x4* s4 = (const LAS f32x4*)(sc + (kg * 64 + k) * 36);
#pragma unroll
                for (int q = 0; q < 8; ++q) { const f32x4 s = s4[q]; acc[4 * q] += s[0] * w; acc[4 * q + 1] += s[1] * w; acc[4 * q + 2] += s[2] * w; acc[4 * q + 3] += s[3] * w; } }
        }
        __syncthreads();
        LAS float* red = (LAS float*)lds;
        if (kg < 16) {
#pragma unroll
            for (int b = 0; b < 32; ++b) red[(kg * 32 + b) * 24 + col] = acc[b]; }
        __syncthreads();
        for (int o = tid; o < 32 * 24; o += 512) { const int b = o / 24, cc = o % 24; float s = 0.f;
#pragma unroll
            for (int g = 0; g < 16; ++g) s += red[(g * 32 + b) * 24 + cc];
            mod[(size_t)b * 6144 + cb * 24 + cc] = s + b_ada[cb * 24 + cc]; }
        __syncthreads();
    }
}

constexpr int W_I_IN = 16 * 112, W_I_OUT = 16 * 32, W_I_G = 16 * 256, W_I_U = 16 * 256, W_I_D = 16 * 256, W_ITEMS = W_I_IN + W_I_OUT + W_I_G + W_I_U + W_I_D;
__device__ __forceinline__ void weight_item(const Args& a, int it, LAS float* scr, int lane_) {
    int lane = lane_; asm volatile("" : "+v"(lane));
    const float* W; int ldw, ldt; unsigned char* dst; bool f8;
    int r = it;
    if (r < W_I_IN) { const int kb = r / 112, db = r % 112, sc0 = db * 32 + (db >= 48 ? 8 : 0);
        W = a.in[5] + (size_t)(64 * kb) * INW + sc0; ldw = INW; dst = a.ws + WS_WIN + ((size_t)(db * 32) * 1024 + 64 * kb) * 2; ldt = 2048; f8 = false; }
    else if ((r -= W_I_IN) < W_I_OUT) { const int kb = r / 32, nb = r % 32;
        W = a.in[12] + (size_t)(64 * kb) * 1024 + 32 * nb; ldw = 1024; dst = a.ws + WS_WO + ((size_t)(32 * nb) * 1024 + 64 * kb) * 2; ldt = 2048; f8 = false; }
    else if ((r -= W_I_OUT) < W_I_G + W_I_U) { const bool up = r >= W_I_G; if (up) r -= W_I_G; const int e = r / 256, q = r % 256, kb = q / 16, nb = q % 16;
        W = (up ? a.in[19] : a.in[18]) + (size_t)e * 1024 * 512 + (size_t)(64 * kb) * 512 + 32 * nb; ldw = 512; dst = a.ws + WS_W1 + ((size_t)e * 1024 + (up ? 512 : 0) + 32 * nb) * 1024 + 64 * kb; ldt = 1024; f8 = true; }
    else { r -= W_I_G + W_I_U; const int e = r / 256, q = r % 256, kb = q / 32, nb = q % 32;
        W = a.in[20] + (size_t)e * 512 * 1024 + (size_t)(64 * kb) * 1024 + 32 * nb; ldw = 1024; dst = a.ws + WS_WD + ((size_t)e * 1024 + 32 * nb) * 512 + 64 * kb; ldt = 512; f8 = true; }
    const float scale = f8 ? W_SCALE : 1.0f;
    const float* wp = W + (size_t)(lane >> 5) * ldw + (lane & 31);
#pragma unroll
    for (int hh = 0; hh < 2; ++hh) { float tv[16];
#pragma unroll
        for (int i = 0; i < 16; ++i) tv[i] = wp[(size_t)(2 * (16 * hh + i)) * ldw];
#pragma unroll
        for (int i = 0; i < 16; ++i) scr[(2 * (16 * hh + i) + (lane >> 5)) * 33 + (lane & 31)] = tv[i] * scale; }
    LDS_WAIT(); asm volatile("" ::: "memory");
    if (f8) { const int c = lane & 3;
#pragma unroll
        for (int j = 0; j < 2; ++j) { const int n = (lane >> 2) + 16 * j; const LAS float* sp = scr + (16 * c) * 33 + n;
            u32x4 o; o.x = pg8::pk4_fp8(sp[0 * 33], sp[1 * 33], sp[2 * 33], sp[3 * 33]); o.y = pg8::pk4_fp8(sp[4 * 33], sp[5 * 33], sp[6 * 33], sp[7 * 33]);
            o.z = pg8::pk4_fp8(sp[8 * 33], sp[9 * 33], sp[10 * 33], sp[11 * 33]); o.w = pg8::pk4_fp8(sp[12 * 33], sp[13 * 33], sp[14 * 33], sp[15 * 33]);
            *(GAS u32x4*)(dst + (size_t)n * ldt + 16 * c) = o; } }
    else { const int c = lane & 7;
#pragma unroll
        for (int j = 0; j < 4; ++j) { const int n = (lane >> 3) + 8 * j; const LAS float* sp = scr + (8 * c) * 33 + n;
            u32x4 o; o.x = pk2(sp[0 * 33], sp[1 * 33]); o.y = pk2(sp[2 * 33], sp[3 * 33]); o.z = pk2(sp[4 * 33], sp[5 * 33]); o.w = pk2(sp[6 * 33], sp[7 * 33]);
            *(GAS u32x4*)(dst + (size_t)n * ldt + 16 * c) = o; } }
    LDS_WAIT(); asm volatile("" ::: "memory");
}

__device__ __forceinline__ void reduce_scatter16(float (&v)[16], int lane) {
    { const bool hi = lane & 32;
#pragma unroll
      for (int i = 0; i < 8; ++i) { const float snd = hi ? v[i] : v[8 + i], kp = hi ? v[8 + i] : v[i]; v[i] = kp + __shfl_xor(snd, 32); } }
    { const bool hi = lane & 16;
#pragma unroll
      for (int i = 0; i < 4; ++i) { const float snd = hi ? v[i] : v[4 + i], kp = hi ? v[4 + i] : v[i]; v[i] = kp + __shfl_xor(snd, 16); } }
    { const bool hi = lane & 8;
#pragma unroll
      for (int i = 0; i < 2; ++i) { const float snd = hi ? v[i] : v[2 + i], kp = hi ? v[2 + i] : v[i]; v[i] = kp + __shfl_xor(snd, 8); } }
    { const bool hi = lane & 4; const float snd = hi ? v[0] : v[1], kp = hi ? v[1] : v[0]; v[0] = kp + __shfl_xor(snd, 4); }
    v[0] += __shfl_xor(v[0], 2); v[0] += __shfl_xor(v[0], 1);
}
__device__ __forceinline__ void reduce_scatter4(float (&v)[4], int lane) {
    { const bool hi = lane & 32;
#pragma unroll
      for (int i = 0; i < 2; ++i) { const float snd = hi ? v[i] : v[2 + i], kp = hi ? v[2 + i] : v[i]; v[i] = kp + __shfl_xor(snd, 32); } }
    { const bool hi = lane & 16; const float snd = hi ? v[0] : v[1], kp = hi ? v[1] : v[0]; v[0] = kp + __shfl_xor(snd, 16); }
#pragma unroll
    for (int o = 8; o > 0; o >>= 1) v[0] += __shfl_xor(v[0], o);
}
__device__ __forceinline__ void p1_phase(const Args& a, LAS unsigned char* lds, int vcu, int G, int tid_, int lane_, int wave) {
    int tid = tid_; asm volatile("" : "+v"(tid)); const int lane = tid & 63;
    const float* x = a.in[0]; const float* g1 = a.in[4]; const float* w_in = a.in[5]; const float* b_fox = a.in[6];
    const float* mod = (const float*)(a.ws + WS_MOD); float* logf = (float*)(a.ws + WS_LOGF); bf16_t* XN = (bf16_t*)(a.ws + WS_XN);
    LAS float* wf = (LAS float*)lds;
    LAS float* zs = (LAS float*)(lds + 32768) + wave * 256;
    LAS float* scr = (LAS float*)(lds + 40960 + wave * 8448);
    int witem = vcu * NWAVES + wave;
    for (int k = tid; k < 1024; k += 512) { const f32x4 u0 = *(const f32x4*)(w_in + (size_t)k * INW + 1536), u1 = *(const f32x4*)(w_in + (size_t)k * INW + 1540);
#pragma unroll
        for (int h = 0; h < 4; ++h) { wf[h * 1024 + k] = u0[h]; wf[(4 + h) * 1024 + k] = u1[h]; } }
    __syncthreads();
    for (int gw = vcu * NWAVES + wave; gw < MTOK / 32; gw += G * NWAVES) {
        const int row0 = gw * 32, b = row0 >> 11;
        f32x4 A1[4], B1[4];
#pragma unroll
        for (int j = 0; j < 4; ++j) { const int cidx = 4 * lane + 256 * j; const f32x4 g = *(const f32x4*)(g1 + cidx), s = *(const f32x4*)(mod + (size_t)b * 6144 + 1024 + cidx);
            A1[j] = g * (s + 1.0f); B1[j] = *(const f32x4*)(mod + (size_t)b * 6144 + cidx); }
        const float* xp = x + (size_t)row0 * DMODEL + 4 * lane;
        f32x4 va[2][4], vb[2][4];
#define P1_LOAD(buf, rp) do { _Pragma("unroll") for (int q = 0; q < 2; ++q) _Pragma("unroll") for (int j = 0; j < 4; ++j) buf[q][j] = *(const f32x4*)(xp + (size_t)(2 * (rp) + q) * DMODEL + 256 * j); } while (0)
#define P1_BODY(buf, itx) do { const int r0 = row0 + 2 * (itx); float ss[2] = {0.f, 0.f}; f32x4 v[2][4]; \
            _Pragma("unroll") for (int q = 0; q < 2; ++q) { f32x2 s2 = {0.f, 0.f}; _Pragma("unroll") for (int j = 0; j < 4; ++j) { s2 = fma2(lo2(buf[q][j]), lo2(buf[q][j]), s2); s2 = fma2(hi2(buf[q][j]), hi2(buf[q][j]), s2); } ss[q] = s2.x + s2.y; } \
            _Pragma("unroll") for (int q = 0; q < 2; ++q) { const float rstd = __builtin_amdgcn_rsqf(wave_sum_dpp(ss[q]) * (1.0f / DMODEL) + NORM_EPS); \
                _Pragma("unroll") for (int j = 0; j < 4; ++j) { v[q][j] = buf[q][j] * rstd * A1[j] + B1[j]; \
                    *(u32x2*)(XN + (size_t)(r0 + q) * DMODEL + 4 * lane + 256 * j) = (u32x2){cvt_pk_bf16(v[q][j][0], v[q][j][1]), cvt_pk_bf16(v[q][j][2], v[q][j][3])}; } } \
            if ((itx) + 2 < 16) P1_LOAD(buf, (itx) + 2); \
            float af[16]; \
            _Pragma("unroll") for (int h = 0; h < 8; ++h) { f32x2 s0 = {0.f, 0.f}, s1 = {0.f, 0.f}; \
                _Pragma("unroll") for (int j = 0; j < 4; ++j) { const f32x4 w = *(const LAS f32x4*)(wf + h * 1024 + 4 * lane + 256 * j); \
                    s0 = fma2(lo2(v[0][j]), lo2(w), s0); s0 = fma2(hi2(v[0][j]), hi2(w), s0); \
                    s1 = fma2(lo2(v[1][j]), lo2(w), s1); s1 = fma2(hi2(v[1][j]), hi2(w), s1); } \
                af[h] = s0.x + s0.y; af[8 + h] = s1.x + s1.y; } \
            _Pragma("unroll") for (int h = 0; h < 16; ++h) DPP_TOTAL63(af[h]); \
            if (lane == 63) { _Pragma("unroll") for (int h4 = 0; h4 < 4; ++h4) *(LAS f32x4*)(zs + (2 * (itx)) * 8 + 4 * h4) = (f32x4){af[4 * h4], af[4 * h4 + 1], af[4 * h4 + 2], af[4 * h4 + 3]}; } } while (0)
        P1_LOAD(va, 0); P1_LOAD(vb, 1);
#define P1_WITEM() do { if (witem < W_ITEMS) { weight_item(a, witem, scr, lane); witem += G * NWAVES; } } while (0)
#pragma unroll 1
        for (int it = 0; it < 16; it += 2) { P1_BODY(va, it); P1_BODY(vb, it + 1); P1_WITEM(); }
#undef P1_WITEM
#undef P1_LOAD
#undef P1_BODY
#pragma unroll
        for (int e = 0; e < 4; ++e) { const int idx = lane + 64 * e; const float z = zs[idx] + b_fox[idx & 7];
            logf[(size_t)row0 * AH + idx] = fminf(z, 0.f) - __builtin_amdgcn_logf(1.0f + __builtin_amdgcn_exp2f(-fabsf(z) * LOG2E)) * 0.6931471805599453f; }
    }
    for (; witem < W_ITEMS; witem += G * NWAVES) weight_item(a, witem, scr, lane);
}

__device__ __forceinline__ void p5_phase(const Args& a, LAS unsigned char* lds, int vcu, int G, int tid_, int lane_, int wave) {
    int tid = tid_; asm volatile("" : "+v"(tid)); const int lane = tid & 63;
    const bf16_t* x1 = (const bf16_t*)(a.ws + WS_X1); const float* g2 = a.in[13]; const float* w_rg = a.in[14]; const float* b_rg = a.in[15]; const float* w_re = a.in[16]; const float* b_re = a.in[17];
    const float* mod = (const float*)(a.ws + WS_MOD); unsigned char* XN8 = a.ws + WS_XN;
    int* list = (int*)(a.ws + WS_LIST); f32x2* lw = (f32x2*)(a.ws + WS_LW); unsigned* gcnt = (unsigned*)(a.ws + WS_CTL) + CW_CNT;
    LAS float* wr = (LAS float*)lds;
    LAS int* hist = (LAS int*)(lds + 20 * 4096);
    LAS float* bias = (LAS float*)(lds + 20 * 4096 + 512);
    LAS float* zs = (LAS float*)(lds + 20 * 4096 + 1024) + wave * (32 * 20);
    for (int k = tid; k < 1024; k += 512) { const f32x4 g4 = *(const f32x4*)(w_rg + 4 * k);
#pragma unroll
        for (int o = 0; o < 4; ++o) wr[o * 1024 + k] = g4[o];
#pragma unroll
        for (int q4 = 0; q4 < 4; ++q4) { const f32x4 e4 = *(const f32x4*)(w_re + 16 * k + 4 * q4);
#pragma unroll
            for (int o = 0; o < 4; ++o) wr[(4 + 4 * q4 + o) * 1024 + k] = e4[o]; } }
    if (tid < 4) bias[tid] = b_rg[tid]; else if (tid < 20) bias[tid] = b_re[tid - 4];
    for (int gw0 = vcu * NWAVES; gw0 < MTOK / 32; gw0 += G * NWAVES) {
        const int gw = gw0 + wave;
        if (tid < 64) hist[tid] = 0;
        __syncthreads();
        const int row0 = gw * 32, b = row0 >> 11;
        f32x4 A2[4], B2[4];
#pragma unroll
        for (int j = 0; j < 4; ++j) { const int cidx = 4 * lane + 256 * j; const f32x4 g = *(const f32x4*)(g2 + cidx), s = *(const f32x4*)(mod + (size_t)b * 6144 + 4096 + cidx);
            A2[j] = g * (s + 1.0f); B2[j] = *(const f32x4*)(mod + (size_t)b * 6144 + 3072 + cidx); }
        const bf16_t* xp = x1 + (size_t)row0 * DMODEL + 4 * lane;
        u32x2 va[2][4], vb[2][4], vc[2][4], vd[2][4];
#define P5_LOAD(buf, rp) do { _Pragma("unroll") for (int q = 0; q < 2; ++q) _Pragma("unroll") for (int j = 0; j < 4; ++j) buf[q][j] = *(const u32x2*)(xp + (size_t)(2 * (rp) + q) * DMODEL + 256 * j); } while (0)
#define P5_BODY(buf, itx) do { const int r0 = row0 + 2 * (itx); float ss[2] = {0.f, 0.f}; f32x4 v[2][4]; \
            _Pragma("unroll") for (int q = 0; q < 2; ++q) _Pragma("unroll") for (int j = 0; j < 4; ++j) { v[q][j] = (f32x4){bf_lo(buf[q][j].x), bf_hi(buf[q][j].x), bf_lo(buf[q][j].y), bf_hi(buf[q][j].y)}; \
                ss[q] += (v[q][j][0] * v[q][j][0] + v[q][j][1] * v[q][j][1]) + (v[q][j][2] * v[q][j][2] + v[q][j][3] * v[q][j][3]); } \
            if ((itx) + 4 < 16) P5_LOAD(buf, (itx) + 4); \
            _Pragma("unroll") for (int q = 0; q < 2; ++q) { const float rstd = __builtin_amdgcn_rsqf(wave_sum_dpp(ss[q]) * (1.0f / DMODEL) + NORM_EPS); \
                _Pragma("unroll") for (int j = 0; j < 4; ++j) { v[q][j] = v[q][j] * rstd * A2[j] + B2[j]; \
                    *(unsigned*)(XN8 + (size_t)(r0 + q) * DMODEL + 4 * lane + 256 * j) = pg8::pk4_fp8(v[q][j][0] * XN2_SCALE, v[q][j][1] * XN2_SCALE, v[q][j][2] * XN2_SCALE, v[q][j][3] * XN2_SCALE); } } \
            { f32x2 acc2[20];     \
              _Pragma("unroll") for (int o = 0; o < 20; ++o) { f32x2 a2 = {0.f, 0.f}; \
                _Pragma("unroll") for (int j = 0; j < 4; ++j) { const f32x4 w = *(const LAS f32x4*)(wr + o * 1024 + 4 * lane + 256 * j); \
                    _Pragma("unroll") for (int e = 0; e < 4; ++e) a2 = fma2((f32x2){v[0][j][e], v[1][j][e]}, (f32x2){w[e], w[e]}, a2); } \
                acc2[o] = a2; } \
              _Pragma("unroll") for (int o = 0; o < 20; ++o) { float t0 = acc2[o].x, t1 = acc2[o].y; DPP_TOTAL63(t0); DPP_TOTAL63(t1); acc2[o] = (f32x2){t0, t1}; } \
              if (lane == 63) { _Pragma("unroll") for (int o4 = 0; o4 < 5; ++o4) { \
                  *(LAS f32x4*)(zs + (2 * (itx)) * 20 + 4 * o4) = (f32x4){acc2[4 * o4].x, acc2[4 * o4 + 1].x, acc2[4 * o4 + 2].x, acc2[4 * o4 + 3].x}; \
                  *(LAS f32x4*)(zs + (2 * (itx) + 1) * 20 + 4 * o4) = (f32x4){acc2[4 * o4].y, acc2[4 * o4 + 1].y, acc2[4 * o4 + 2].y, acc2[4 * o4 + 3].y}; } } \
              __builtin_amdgcn_sched_barrier(0); } } while (0)
        P5_LOAD(va, 0); P5_LOAD(vb, 1); P5_LOAD(vc, 2); P5_LOAD(vd, 3);
#pragma unroll 1
        for (int it = 0; it < 16; it += 4) { P5_BODY(va, it); P5_BODY(vb, it + 1); P5_BODY(vc, it + 2); P5_BODY(vd, it + 3); }
#undef P5_LOAD
#undef P5_BODY
        int my_cls = 0; float my_wlo = 0.f, my_whi = 0.f;
        if (lane < 32) {
            float lg[20];
#pragma unroll
            for (int o = 0; o < 20; ++o) lg[o] = zs[lane * 20 + o] + bias[o];
            int gi = 0; float gm = lg[0];
#pragma unroll
            for (int o = 1; o < 4; ++o) if (lg[o] > gm) { gm = lg[o]; gi = o; }
            float gs = 0.f;
#pragma unroll
            for (int o = 0; o < 4; ++o) gs += __expf(lg[o] - gm);
            const float gp = 1.0f / gs;
            float el[4];
#pragma unroll
            for (int j = 0; j < 4; ++j) el[j] = gi == 0 ? lg[4 + j] : (gi == 1 ? lg[8 + j] : (gi == 2 ? lg[12 + j] : lg[16 + j]));
            int i1 = 0; float m1 = el[0];
#pragma unroll
            for (int j = 1; j < 4; ++j) if (el[j] > m1) { m1 = el[j]; i1 = j; }
            int i2 = -1; float m2 = -INFINITY;
#pragma unroll
            for (int j = 0; j < 4; ++j) if (j != i1 && el[j] > m2) { m2 = el[j]; i2 = j; }
            const float w1 = gp / (1.0f + __expf(m2 - m1)), w2 = gp - w1;
            const int lo = i1 < i2 ? i1 : i2, hi = i1 < i2 ? i2 : i1;
            my_wlo = i1 < i2 ? w1 : w2; my_whi = i1 < i2 ? w2 : w1;
            my_cls = gi * 6 + (lo == 0 ? hi - 1 : (lo == 1 ? hi + 1 : 5));
        }
        int rank = 0;
        if (lane < 32) rank = __hip_atomic_fetch_add(&hist[my_cls], 1, __ATOMIC_RELAXED, __HIP_MEMORY_SCOPE_WORKGROUP);
        __syncthreads();
        if (tid < NCLS) hist[32 + tid] = (int)__hip_atomic_fetch_add(gcnt + tid, (unsigned)hist[tid], __ATOMIC_RELAXED, __HIP_MEMORY_SCOPE_AGENT);
        __syncthreads();
        if (lane < 32) { const size_t pos = (size_t)my_cls * MTOK + hist[32 + my_cls] + rank; list[pos] = row0 + lane; lw[pos] = (f32x2){my_wlo, my_whi}; }
        __syncthreads();
    }
}
__global__ void __launch_bounds__(NWAVES * 64, 2) layer_fwd(Args args) {
    extern __shared__ __attribute__((aligned(16))) unsigned char lds_raw[];
    LAS unsigned char* lds = (LAS unsigned char*)lds_raw;
    const int tid = threadIdx.x, lane = tid & 63, wave = __builtin_amdgcn_readfirstlane(tid >> 6);
    const int G = gridDim.x, bx = blockIdx.x;
    const int vcu = (G % 8 == 0) ? (bx % 8) * (G / 8) + bx / 8 : bx;
    unsigned char* ws = args.ws;
    gu32* ctl = (gu32*)(ws + WS_CTL);
    for (int u = tid; u < (LDS_BYTES - LDSCTL_OFF) / 4; u += NWAVES * 64) ((LAS unsigned*)(lds + LDSCTL_OFF))[u] = 0u;
    __syncthreads();
    volatile LAS unsigned* MISC = (volatile LAS unsigned*)(lds + MISC_OFF);
    XcdBarrier bar; bar.bar = (unsigned*)(ctl + CW_BAR); bar.x = 0; bar.st = nullptr;
    const int lo = args.ph_lo, hi = args.ph_hi;
    const bool one = (hi - lo) > 1;
    if (one) bar = xcd_barrier_post((unsigned*)(ctl + CW_BAR), MISC + 8);
#ifndef PH_MASK
#define PH_MASK 0xff
#endif
#ifndef REP_HGRN
#define REP_HGRN 1
#endif
#ifndef REP_ATTN
#define REP_ATTN 1
#endif
#ifndef REP_P2
#define REP_P2 1
#endif
#ifndef REP_P4
#define REP_P4 1
#endif
#ifndef REP_P6
#define REP_P6 1
#endif
#ifndef REP_P0
#define REP_P0 1
#endif
#ifndef REP_P1
#define REP_P1 1
#endif
#define IN(k) (((PH_MASK >> (k)) & 1) && lo <= (k) && (k) < hi)
#define SEAM(k) do { if (IN(k) && IN((k) + 1)) xcd_barrier(bar); } while (0)

    const bf16_t* WinT = (const bf16_t*)(ws + WS_WIN); const bf16_t* WoT = (const bf16_t*)(ws + WS_WO); const unsigned char* W1T = ws + WS_W1; const unsigned char* WdT = ws + WS_WD;
    bf16_t* XN = (bf16_t*)(ws + WS_XN); bf16_t* AO = (bf16_t*)(ws + WS_AO); bf16_t* PROJ = (bf16_t*)(ws + WS_PROJ); unsigned char* ACT = ws + WS_PROJ;
    const float* mod = (const float*)(ws + WS_MOD);

    if (IN(0)) { for (int rep = 0; rep < REP_P0; ++rep) { p0_phase(args, lds, vcu, G, tid, lane, wave); __syncthreads(); } }
    SEAM(0);
    if (IN(1)) { for (int rep = 0; rep < REP_P1; ++rep) { p1_phase(args, lds, vcu, G, tid, lane, wave); __syncthreads(); } }
    SEAM(1);
    if (IN(2)) {
        pg8::ProjPol S; S.A = (const char*)XN; S.Bt = (const char*)WinT; S.lda = 2048; S.ldb = 2048; S.hstepB = 32 * 2048; S.ks = 16; S.nN = 14; S.G = G; S.c = bx; S.bt_tile_rows = 256;
        pg8::EpiProj E{PROJ, args.in[7], args.in[8], args.in[10]};
        for (int rep = 0; rep < REP_P2; ++rep) pg8::gemm_phase(lds + RING_OFF, S, E);
    }
    SEAM(2);
    if (IN(3)) {
        const bool part = (G == 256);
        const int pp = bx >> 1, role = bx & 1;
#ifndef NO_HGRN
        for (int rep = 0; rep < REP_HGRN; ++rep) {
            if (part) { if (role == 0) hgrn::hgrn_unit(pp / HH, pp % HH, PROJ, AO, args.in[11], lds + RING_OFF); }
            else for (int u = bx; u < BATCH * HH; u += G) hgrn::hgrn_unit(u / HH, u % HH, PROJ, AO, args.in[11], lds + RING_OFF);
        }
#ifdef SHADOW_HGRN
        if (part && role == 0) hgrn::hgrn_unit<SHADOW_HGRN>(pp / HH, pp % HH, PROJ, (bf16_t*)(ws + WS_LIST), args.in[11], lds + RING_OFF);
#endif
        __syncthreads();
#endif
#ifndef NO_ATTN
        for (int rep = 0; rep < REP_ATTN; ++rep) {
            const int nun = part ? (role ? 12 : 4) : 8 * ((BATCH * AH - vcu + G - 1) / G);
            int cur_bh = -1; float m0l = 0.f;
            for (int i = 0; i < nun; ++i) {
                int bh, qb;
                if (part) { if (role) { bh = i < 8 ? 2 * pp : 2 * pp + 1; qb = i < 8 ? 7 - i : (i == 8 ? 7 : (i == 9 ? 6 : 11 - i)); } else { bh = 2 * pp + 1; qb = 5 - i; } }
                else { bh = vcu + (i >> 3) * G; qb = 7 - (i & 7); }
                bool fresh = false;
                if (bh != cur_bh) { __syncthreads(); m0l = attn_body::attn_prep(bh / AH, bh % AH, (const float*)(ws + WS_LOGF), args.in[7], args.in[8], args.in[9], (char*)lds_raw + RING_OFF); cur_bh = bh; fresh = true; }
                int nbh = -1;
                if (i + 1 < nun) { if (part) nbh = role ? (i + 1 < 8 ? 2 * pp : 2 * pp + 1) : 2 * pp + 1; else nbh = vcu + ((i + 1) >> 3) * G; }
                attn_body::attn_unit(bh / AH, bh % AH, qb, (const attn_body::bf16*)PROJ, (attn_body::bf16*)AO, m0l, (char*)lds_raw + RING_OFF, !fresh, nbh == bh);
            }
            __syncthreads();
        }
#endif
    }
    SEAM(3);
    if (IN(4)) {
        pg8::PlainPol S; S.A = (const char*)AO; S.Bt = (const char*)WoT; S.lda = 2048; S.ldb = 2048; S.hstepB = 128 * 2048; S.ks = 16; S.nN = 4; S.G = G; S.c = bx; S.bt_tile_rows = 256;
        pg8::EpiRes E{args.in[0], (bf16_t*)(ws + WS_X1), mod + 2048};
        for (int rep = 0; rep < REP_P4; ++rep) pg8::gemm_phase(lds + RING_OFF, S, E);
    }
    SEAM(4);
#ifndef REP_P5
#define REP_P5 1
#endif
    if (IN(5)) { for (int rep = 0; rep < REP_P5; ++rep) { if (rep) { xcd_barrier(bar); if (bx == 0 && tid < NCLS) __hip_atomic_store(ctl + CW_CNT + tid, 0u, RLX_AGENT); xcd_barrier(bar); } p5_phase(args, lds, vcu, G, tid, lane, wave); } }
    SEAM(5);
    LAS int* tab = (LAS int*)(lds + TAB_OFF);
    if (IN(6) || IN(7)) {
        if (tid < NCLS) tab[tid] = (int)__hip_atomic_load(ctl + CW_CNT + tid, RLX_AGENT);
        __syncthreads();
        if (tid == 0) { int p = 0; for (int c = 0; c < NCLS; ++c) { tab[32 + c] = p; p += (tab[c] + 255) >> 8; } tab[32 + NCLS] = p; }
        __syncthreads();
    }
    const pg8::MoeTab mt{tab};
    if (IN(6)) {
        pg8::Moe1Pol S; S.A = (const char*)XN; S.W1T = (const char*)W1T; S.list = (const int*)(ws + WS_LIST); S.tab = mt; S.lda = 1024; S.ldb = 1024; S.hstepB = 512 * 1024; S.ks = 8; S.G = G; S.c = bx; S.sclW = SCL_W; S.sclX = SCL_XN2;
        pg8::EpiSwiglu E{ACT, (const float*)(ws + WS_LW), mt};
        for (int rep = 0; rep < REP_P6; ++rep) pg8::gemm_phase(lds + RING_OFF, S, E);
#ifdef SHADOW_P6
        { pg8::EpiSwiglu E2{ws + WS_AO, (const float*)(ws + WS_LW), mt}; pg8::gemm_phase<pg8::Moe1Pol, pg8::EpiSwiglu, SHADOW_P6>(lds + RING_OFF, S, E2); }
#endif
    }
    SEAM(6);
    if (IN(7)) {
        pg8::Moe2Pol S; S.A = (const char*)ACT; S.WdT = (const char*)WdT; S.tab = mt; S.lda = 1024; S.ldb = 512; S.hstepB = 128 * 512; S.ks = 4; S.G = G; S.c = bx; S.sclW = SCL_W; S.sclX = SCL_ACT;
        pg8::EpiMoeOut E{args.out, (const bf16_t*)(ws + WS_X1), mod + 5120, (const int*)(ws + WS_LIST), mt};
#ifndef REP_P7
#define REP_P7 1
#endif
        for (int rep = 0; rep < REP_P7; ++rep) pg8::gemm_phase(lds + RING_OFF, S, E);
    }
#ifdef DIAG
    if (lo <= 8 && 8 < hi) {
        for (size_t i = (size_t)bx * 512 + tid; i < (size_t)MTOK * 1024; i += (size_t)G * 512) {
            const size_t row = i >> 10, c = i & 1023; float v;
            if (DIAG == 1) v = bf_lo((unsigned)XN[i]);
            else if (DIAG == 2) v = bf_lo((unsigned)PROJ[row * PW + c]) + bf_lo((unsigned)PROJ[row * PW + 1024 + c]) + bf_lo((unsigned)PROJ[row * PW + 2048 + c]) + bf_lo((unsigned)PROJ[row * PW + 2560 + c]);
            else if (DIAG == 3) v = bf_lo((unsigned)AO[i]);
            else if (DIAG == 4) v = bf_lo((unsigned)((const bf16_t*)(ws + WS_X1))[i]);
            else v = args.in[0][i];
            args.out[i] = v;
        }
    }
#endif
#undef IN
#undef SEAM
}

#ifndef MK_PER_PHASE
#define MK_PER_PHASE 0
#endif
extern "C" void kernel_launch(void* const* d_in, const int* in_sizes, int n_in, void* d_out, int out_size, void* d_ws, size_t ws_size, hipStream_t stream) {
    static int grid = 0;
    if (grid == 0) {
        if (n_in != 21 || in_sizes[0] != MTOK * DMODEL || out_size != MTOK * DMODEL || ws_size < WS_END) { fprintf(stderr, "kernel_launch: unexpected shapes (n_in %d, in0 %d, out %d, ws %zu); nothing launched\n", n_in, n_in > 0 ? in_sizes[0] : -1, out_size, ws_size); grid = -1; return; }
        int dev = 0, cus = 0, per_cu = 0;
        if (hipGetDevice(&dev) != hipSuccess || hipDeviceGetAttribute(&cus, hipDeviceAttributeMultiprocessorCount, dev) != hipSuccess) { grid = -1; return; }
        if (hipFuncSetAttribute((const void*)layer_fwd, hipFuncAttributeMaxDynamicSharedMemorySize, LDS_BYTES) != hipSuccess) { fprintf(stderr, "kernel_launch: hipFuncSetAttribute failed\n"); grid = -1; return; }
        if (hipOccupancyMaxActiveBlocksPerMultiprocessor(&per_cu, (const void*)layer_fwd, NWAVES * 64, LDS_BYTES) != hipSuccess || per_cu < 1) { fprintf(stderr, "kernel_launch: occupancy query says %d workgroups per CU\n", per_cu); per_cu = 1; }
        (void)hipGetLastError();
        grid = cus;
    }
    if (grid < 0) return;
    (void)hipMemsetAsync((char*)d_ws + WS_CTL, 0, CTL_ZERO_BYTES, stream);
    Args a{};
    for (int i = 0; i < 21; ++i) a.in[i] = (const float*)d_in[i];
    a.out = (float*)d_out; a.ws = (unsigned char*)d_ws;
#if MK_PER_PHASE
    for (int p = 0; p < 9; ++p) { a.ph_lo = p; a.ph_hi = p + 1; hipLaunchKernelGGL(layer_fwd, dim3(grid), dim3(NWAVES * 64), LDS_BYTES, stream, a); }
#else
#ifdef DIAG
    a.ph_lo = 0; a.ph_hi = 9;
#else
    a.ph_lo = 0; a.ph_hi = 8;
#endif
    hipLaunchKernelGGL(layer_fwd, dim3(grid), dim3(NWAVES * 64), LDS_BYTES, stream, a);
#endif
    const hipError_t le = hipPeekAtLastError();
    if (le != hipSuccess) fprintf(stderr, "kernel_launch: launch failed: %s\n", hipGetErrorName(le));
}
```

```cpp
#include <hip/hip_runtime.h>
#include <hip/hip_bf16.h>
#include <cstdio>
#include <cstdint>
#include <cmath>

#define LAS __attribute__((address_space(3)))
#define GAS __attribute__((address_space(1)))
typedef unsigned short bf16_t;
typedef short bf16x8 __attribute__((ext_vector_type(8)));
typedef short s16x4 __attribute__((ext_vector_type(4)));
typedef float f32x4 __attribute__((ext_vector_type(4)));
typedef float f32x2 __attribute__((ext_vector_type(2)));
typedef float f32x16 __attribute__((ext_vector_type(16)));
typedef unsigned u32x4 __attribute__((ext_vector_type(4)));
typedef unsigned u32x2 __attribute__((ext_vector_type(2)));
typedef _Float16 h16x2 __attribute__((ext_vector_type(2)));

constexpr int BATCH = 32, SEQ = 2048, DMODEL = 1024, MTOK = BATCH * SEQ;
constexpr int AH = 8, AD = 64, AW = 512, HH = 4, HK = 128, HW = 512;
constexpr int INW = 3 * AW + AH + 4 * HW;
constexpr int PW = 3584;
constexpr int PC_Q = 0, PC_K = 512, PC_V = 1024, PC_HQ = 1536, PC_HG = 2048, PC_HV = 2560, PC_HO = 3072;
constexpr int NEXP = 16, DEXP = 512, NCLS = 24;
constexpr float NORM_EPS = 1e-6f;
constexpr float LOG2E = 1.4426950408889634f;
constexpr float QSCALE = 0.125f * LOG2E;
constexpr float W_SCALE = 32.0f, XN2_SCALE = 4.0f, ACT_SCALE = 16.0f;
constexpr int SCL_W = 0x7A7A7A7A, SCL_XN2 = 0x7D7D7D7D, SCL_ACT = 0x7B7B7B7B;

typedef __bf16 bf16x2_nat __attribute__((ext_vector_type(2)));
__device__ __forceinline__ unsigned cvt_pk_bf16(float lo, float hi) { f32x2 v = {lo, hi}; bf16x2_nat b = __builtin_convertvector(v, bf16x2_nat); return __builtin_bit_cast(unsigned, b); }
__device__ __forceinline__ float bf_lo(unsigned u) { return __uint_as_float(u << 16); }
__device__ __forceinline__ float bf_hi(unsigned u) { return __uint_as_float(u & 0xffff0000u); }
__device__ __forceinline__ unsigned cvt_pk_f16(float lo, float hi) { h16x2 v = {(_Float16)lo, (_Float16)hi}; return __builtin_bit_cast(unsigned, v); }
__device__ __forceinline__ float sigmoidf_(float v) { return __builtin_amdgcn_rcpf(1.0f + __builtin_amdgcn_exp2f(-v * LOG2E)); }
__device__ __forceinline__ float siluf_(float v) { return v * sigmoidf_(v); }

namespace pg8 {
constexpr int BM = 256, BK = 64, HALF = 128, HTB = HALF * BK * 2, STAGE_BYTES = 8 * HTB, NXCD = 8, WGM = 8;
typedef int v8i32 __attribute__((ext_vector_type(8)));
typedef int v4i32 __attribute__((ext_vector_type(4)));

__host__ __device__ __forceinline__ int lds_byte(int r, int c) { const int st = (r >> 4) * 2 + (c >> 5), rr = r & 15, cc = c & 31, ob = rr * 64 + cc * 2; return st * 1024 + (ob ^ (((ob >> 9) & 1) << 5)); }
__host__ __device__ __forceinline__ void stage_rc(int b, int& R, int& C) { const int st = b / 1024, sb = b % 1024, swz = sb ^ (((sb >> 9) & 1) << 5); R = (st >> 1) * 16 + swz / 64; C = (st & 1) * 32 + (swz % 64) / 2; }
__host__ __device__ __forceinline__ int perm32(int rho) { const int n = rho >> 4, i = rho & 15; return 8 * (i >> 2) + 4 * n + (i & 3); }

struct GUnit { const char* A; const char* B0; const char* B1; int pm, pn, e0, e1, e2; };

__device__ __forceinline__ bool order_id(int i, int G, int c, int nwg, int& wgid) {
    const long L = (long)i * G + c; if (L >= nwg) return false;
    const int q = nwg / NXCD, r = nwg % NXCD, w = (int)L, xcd = w % NXCD, off = w / NXCD;
    wgid = (xcd < r ? xcd * (q + 1) : r * (q + 1) + (xcd - r) * q) + off; return true;
}

template <class Pol, class Epi, int SK = 0>
__device__ __forceinline__ void gemm_phase(LAS unsigned char* lds, const Pol& S, const Epi& E) {
    int tid = threadIdx.x; asm volatile("" : "+v"(tid));
    const int wid = __builtin_amdgcn_readfirstlane(tid >> 6), lane = tid & 63, wr = wid >> 2, wc = wid & 3, fr = lane & 15, fq = lane >> 4;
    const int RR0 = 8 * wid + (lane >> 3), RR1 = RR0 + 64, CC0 = 8 * ((lane & 7) ^ ((RR0 >> 1) & 7)), CC1 = CC0;
    const int Rb0 = Pol::HG ? (64 * (RR0 >> 5) + perm32(RR0 & 31)) : ((RR0 & ~31) + perm32(RR0 & 31)), Rb1 = Pol::HG ? (64 * (RR1 >> 5) + perm32(RR1 & 31)) : ((RR1 & ~31) + perm32(RR1 & 31));
    constexpr int NT = Pol::NT;
    const unsigned voffB00 = (unsigned)(Rb0 * S.ldb + CC0 * 2), voffB01 = (unsigned)(Rb1 * S.ldb + CC1 * 2), voffB10 = voffB00 + (unsigned)S.hstepB, voffB11 = voffB01 + (unsigned)S.hstepB;
    unsigned voffA00 = (unsigned)(RR0 * S.lda + CC0 * 2), voffA01 = (unsigned)(RR1 * S.lda + CC1 * 2), voffA10 = (unsigned)((HALF + RR0) * S.lda + CC0 * 2), voffA11 = (unsigned)((HALF + RR1) * S.lda + CC1 * 2);
    unsigned voffAn00 = voffA00, voffAn01 = voffA01, voffAn10 = voffA10, voffAn11 = voffA11;
    const size_t kstep = (size_t)(BK * 2);
    const unsigned ldsw = (unsigned)wid * 1024u;
    const int swz = (fr >> 1) & 7, aoff0 = (wr * 64 + fr) * 128 + ((fq ^ swz) << 4), aoff1 = (wr * 64 + fr) * 128 + (((4 + fq) ^ swz) << 4), boff0 = (wc * 32 + fr) * 128 + ((fq ^ swz) << 4), boff1 = (wc * 32 + fr) * 128 + (((4 + fq) ^ swz) << 4);
#define PG8_SA(b, h) (((b) * 2 + (h)) * HTB)
#define PG8_SB(b, h) ((4 + (b) * 2 + (h)) * HTB)
#define PG8_STAGE2(bufoff, gbase, v0, v1) do { if constexpr (SK != 3 && SK != 6) { \
        __builtin_amdgcn_global_load_lds((const unsigned*)((const char*)(gbase) + (v0)), (LAS unsigned*)(lds + (bufoff) + ldsw), 16, 0, 0); \
        __builtin_amdgcn_global_load_lds((const unsigned*)((const char*)(gbase) + (v1)), (LAS unsigned*)(lds + (bufoff) + ldsw + 8192), 16, 0, 0); } } while (0)
#define PG8_STAGE(bufoff, gbase, voff, h) PG8_STAGE2(bufoff, gbase, voff##h##0, voff##h##1)
#define PG8_CAT(x0, x1) __builtin_shufflevector(x0, x1, 0, 1, 2, 3, 4, 5, 6, 7)
#define PG8_LO(x) __builtin_bit_cast(bf16x8, __builtin_shufflevector(x, x, 0, 1, 2, 3))
#define PG8_HI(x) __builtin_bit_cast(bf16x8, __builtin_shufflevector(x, x, 4, 5, 6, 7))
#define PG8_LDA(dst, b, h) do { if constexpr (SK != 4 && SK != 6) _Pragma("unroll") for (int m = 0; m < 4; ++m) dst[m] = PG8_CAT(*(const LAS v4i32*)(lds + PG8_SA(b, h) + aoff0 + m * 2048), *(const LAS v4i32*)(lds + PG8_SA(b, h) + aoff1 + m * 2048)); } while (0)
#define PG8_LDB(dst, b, h) do { if constexpr (SK != 4 && SK != 6) _Pragma("unroll") for (int n = 0; n < 2; ++n) dst[n] = PG8_CAT(*(const LAS v4i32*)(lds + PG8_SB(b, h) + boff0 + n * 2048), *(const LAS v4i32*)(lds + PG8_SB(b, h) + boff1 + n * 2048)); } while (0)
#define PG8_MMA(ai, bj, At, Bt) do { __builtin_amdgcn_s_setprio(1); _Pragma("unroll") for (int m = 0; m < ((SK == 2 || SK == 6) ? 0 : (SK == 1 ? 2 : 4)); ++m) _Pragma("unroll") for (int n = 0; n < 2; ++n) { \
        if constexpr (Pol::FP8) asm volatile("v_mfma_scale_f32_16x16x128_f8f6f4 %0, %1, %2, %0, %3, %4 op_sel_hi:[0,0,0]" : "+v"(acc[ai][bj][m][n]) : "v"(Bt[n]), "v"(At[m]), "v"(sclW), "v"(sclX)); \
        else { acc[ai][bj][m][n] = __builtin_amdgcn_mfma_f32_16x16x32_bf16(PG8_LO(Bt[n]), PG8_LO(At[m]), acc[ai][bj][m][n], 0, 0, 0); \
               acc[ai][bj][m][n] = __builtin_amdgcn_mfma_f32_16x16x32_bf16(PG8_HI(Bt[n]), PG8_HI(At[m]), acc[ai][bj][m][n], 0, 0, 0); } } \
        __builtin_amdgcn_s_setprio(0); } while (0)
#define PG8_WAIT_V(n) asm volatile("s_waitcnt vmcnt(" #n ")" ::: "memory")
#define PG8_WAIT_L(n) asm volatile("s_waitcnt lgkmcnt(" #n ")" ::: "memory")
#define PG8_BAR do { if constexpr (SK != 5) __builtin_amdgcn_s_barrier(); } while (0)
#define PG8_SCHED __builtin_amdgcn_sched_barrier(0)
    int sclW = 0, sclX = 0; if constexpr (Pol::FP8) { sclW = S.sclW; sclX = S.sclX; }
    GUnit cur, nxt; int ui = 0;
    if (!S.next(0, cur)) return;
    if constexpr (Pol::GATHER) {
        const u32x4 ix = S.rows(cur, RR0, RR1);
        voffA00 = ix.x * (unsigned)S.lda + (unsigned)CC0 * 2u; voffA01 = ix.y * (unsigned)S.lda + (unsigned)CC1 * 2u;
        voffA10 = ix.z * (unsigned)S.lda + (unsigned)CC0 * 2u; voffA11 = ix.w * (unsigned)S.lda + (unsigned)CC1 * 2u;
    }
    f32x4 acc[2][2][4][2];
#pragma unroll
    for (int a = 0; a < 2; ++a)
#pragma unroll
        for (int b = 0; b < 2; ++b)
#pragma unroll
            for (int m = 0; m < 4; ++m)
#pragma unroll
                for (int n = 0; n < 2; ++n) acc[a][b][m][n] = (f32x4){0.f, 0.f, 0.f, 0.f};
    v8i32 At[4], B0[2], B1[2];
    if constexpr (SK == 4 || SK == 6) { _Pragma("unroll") for (int m = 0; m < 4; ++m) At[m] = (v8i32){1, 2, 3, 4, 5, 6, 7, 8}; B0[0] = B0[1] = B1[0] = B1[1] = (v8i32){1, 2, 3, 4, 5, 6, 7, 8}; }
    const char* cA = cur.A;
    PG8_STAGE(PG8_SB(0, 0), cur.B0, voffB, 0); PG8_STAGE(PG8_SB(0, 1), cur.B0, voffB, 1); PG8_STAGE(PG8_SA(0, 0), cA, voffA, 0); PG8_STAGE(PG8_SA(0, 1), cA, voffA, 1);
    if (wr == 1) PG8_BAR;
    PG8_WAIT_V(2); PG8_BAR;
    PG8_STAGE(PG8_SB(1, 0), cur.B0 + kstep, voffB, 0); PG8_STAGE(PG8_SA(1, 0), cA + kstep, voffA, 0); PG8_STAGE(PG8_SB(1, 1), cur.B0 + kstep, voffB, 1);
    PG8_WAIT_V(6); PG8_BAR;
    for (;;) {
        const bool has_next = S.next(ui + 1, nxt);
        const char* nA = has_next ? nxt.A : cA; const char* nB = has_next ? nxt.B0 : cur.B0;
        if constexpr (Pol::GATHER) {
            if (has_next) { int r0_ = RR0, r1_ = RR1; asm volatile("" : "+v"(r0_), "+v"(r1_)); const u32x4 ix = S.rows(nxt, r0_, r1_);
                voffAn00 = ix.x * (unsigned)S.lda + (unsigned)CC0 * 2u; voffAn01 = ix.y * (unsigned)S.lda + (unsigned)CC1 * 2u;
                voffAn10 = ix.z * (unsigned)S.lda + (unsigned)CC0 * 2u; voffAn11 = ix.w * (unsigned)S.lda + (unsigned)CC1 * 2u; }
            else { voffAn00 = voffA00; voffAn01 = voffA01; voffAn10 = voffA10; voffAn11 = voffA11; }
        }
#pragma unroll 1
        for (int t = 0; t < NT; t += 2) {
            const bool last = (t == NT - 2);
            const char* a1 = cA + (size_t)(t + 1) * kstep;
            const char* a2 = last ? nA : cA + (size_t)(t + 2) * kstep;
            const char* b2 = last ? nB : ((t + 2 < S.ks) ? cur.B0 + (size_t)(t + 2) * kstep : cur.B1 + (size_t)(t + 2 - S.ks) * kstep);
            const char* a3 = a2 + kstep; const char* b3 = b2 + kstep;
            asm volatile("" : "+s"(a1), "+s"(a2), "+s"(a3), "+s"(b2), "+s"(b3));
            const bool gl_ = Pol::GATHER && last;
            const unsigned va00 = gl_ ? voffAn00 : voffA00, va01 = gl_ ? voffAn01 : voffA01, va10 = gl_ ? voffAn10 : voffA10, va11 = gl_ ? voffAn11 : voffA11;
            PG8_LDB(B0, 0, 0); PG8_LDB(B1, 0, 1); PG8_SCHED; PG8_LDA(At, 0, 0); PG8_STAGE(PG8_SA(1, 1), a1, voffA, 1);
            PG8_WAIT_V(8); PG8_WAIT_L(0); PG8_BAR; PG8_MMA(0, 0, At, B0); PG8_MMA(0, 1, At, B1); PG8_BAR; PG8_SCHED;
            PG8_LDA(At, 0, 1); PG8_STAGE(PG8_SB(0, 0), b2, voffB, 0); PG8_STAGE(PG8_SB(0, 1), b2, voffB, 1); PG8_STAGE(PG8_SA(0, 0), a2, va, 0);
            PG8_WAIT_V(8); PG8_WAIT_L(0); PG8_BAR; PG8_MMA(1, 0, At, B0); PG8_MMA(1, 1, At, B1); PG8_BAR; PG8_SCHED;
            PG8_LDB(B0, 1, 0); PG8_LDB(B1, 1, 1); PG8_SCHED; PG8_LDA(At, 1, 0); PG8_STAGE(PG8_SA(0, 1), a2, va, 1);
            PG8_WAIT_V(8); PG8_WAIT_L(0); PG8_BAR; PG8_MMA(0, 0, At, B0); PG8_MMA(0, 1, At, B1); PG8_BAR; PG8_SCHED;
            PG8_LDA(At, 1, 1); PG8_STAGE(PG8_SB(1, 0), b3, voffB, 0); PG8_STAGE(PG8_SB(1, 1), b3, voffB, 1); PG8_STAGE(PG8_SA(1, 0), a3, va, 0);
            PG8_WAIT_V(8); PG8_WAIT_L(0); PG8_BAR; PG8_MMA(1, 0, At, B0); PG8_MMA(1, 1, At, B1); PG8_BAR; PG8_SCHED;
        }
        if (wr == 0) PG8_BAR;
        if constexpr (Pol::FP8) asm volatile("s_nop 15\n\ts_nop 7" ::: "memory");
        { int fr_e = fr, fq_e = fq; asm volatile("" : "+v"(fr_e), "+v"(fq_e));
          E(acc, cur, wr, wc, fr_e, fq_e); }
        if (!has_next) break;
#pragma unroll
        for (int a = 0; a < 2; ++a)
#pragma unroll
            for (int b = 0; b < 2; ++b)
#pragma unroll
                for (int m = 0; m < 4; ++m)
#pragma unroll
                    for (int n = 0; n < 2; ++n) acc[a][b][m][n] = (f32x4){0.f, 0.f, 0.f, 0.f};
        cur = nxt; cA = nA; ++ui;
        if constexpr (Pol::GATHER) { voffA00 = voffAn00; voffA01 = voffAn01; voffA10 = voffAn10; voffA11 = voffAn11; }
        if (wr == 1) PG8_BAR;
    }
    PG8_WAIT_V(0);
    PG8_BAR;
#undef PG8_SA
#undef PG8_SB
#undef PG8_STAGE
#undef PG8_STAGE2
#undef PG8_LDA
#undef PG8_LDB
#undef PG8_MMA
#undef PG8_CAT
#undef PG8_LO
#undef PG8_HI
#undef PG8_WAIT_V
#undef PG8_WAIT_L
#undef PG8_BAR
#undef PG8_SCHED
}
}
namespace pg8 {
struct DensePol {
    static constexpr bool GATHER = false, FP8 = false; static constexpr int NT = 16;
    const char* A; const char* Bt; int lda, ldb, hstepB, ks, nN, G, c, bt_tile_rows  ;
    __device__ __forceinline__ bool next(int i, GUnit& u) const {
        const int nM = MTOK / BM, nwg = nM * nN; int wgid; if (!order_id(i, G, c, nwg, wgid)) return false;
        const int nig = WGM * nN, gid = wgid / nig, fm = gid * WGM, gsz = (nM - fm) < WGM ? (nM - fm) : WGM;
        u.pm = fm + ((wgid % nig) % gsz); u.pn = (wgid % nig) / gsz; u.e0 = 0; u.e1 = 0; u.e2 = 0;
        u.A = A + (size_t)u.pm * BM * lda; u.B0 = Bt + (size_t)u.pn * BM * ldb; u.B1 = u.B0; return true;
    }
};
struct ProjPol : DensePol { static constexpr bool HG = true; };
struct PlainPol : DensePol { static constexpr bool HG = false; };

struct MoeTab { const LAS int* t; __device__ __forceinline__ int cnt(int c) const { return t[c]; } __device__ __forceinline__ int tpre(int c) const { return t[32 + c]; } };
__device__ __forceinline__ void moe_class_experts(int cls, int& elo, int& ehi) {
    const int g = cls / 6, p = cls % 6; const int lo = p < 3 ? 0 : (p < 5 ? 1 : 2); const int hi = p < 3 ? p + 1 : (p < 5 ? p - 1 : 3);
    elo = 4 * g + lo; ehi = 4 * g + hi;
}
struct Moe1Pol {
    static constexpr bool GATHER = true, HG = false, FP8 = true; static constexpr int NT = 8;
    const char* A; const char* W1T; const int* list; MoeTab tab; int lda, ldb, hstepB, ks, G, c, sclW, sclX;
    __device__ __forceinline__ bool next(int i, GUnit& u) const {
        const int ntile = tab.tpre(NCLS), nwg = ntile * 8; int wgid; if (!order_id(i, G, c, nwg, wgid)) return false;
        const int rtg = wgid >> 3, sub = wgid & 7, e01 = sub >> 2, ct = sub & 3;
        int cls = 0;
#pragma unroll 1
        for (int k = 1; k < NCLS; ++k) cls += (tab.tpre(k) <= rtg) ? 1 : 0;
        int elo, ehi; moe_class_experts(cls, elo, ehi); const int ex = e01 ? ehi : elo;
        u.pm = rtg; u.pn = ct; u.e0 = cls; u.e1 = rtg - tab.tpre(cls); u.e2 = e01;
        u.A = A; u.B0 = W1T + ((size_t)ex * 1024 + (size_t)ct * 128) * 1024; u.B1 = u.B0; return true;
    }
    __device__ __forceinline__ u32x4 rows(const GUnit& u, int R0, int R1) const {
        const int base = u.e1 * 256, n = tab.cnt(u.e0) - base; const int* L = list + (size_t)u.e0 * MTOK + base;
        u32x4 r;
        r.x = R0 < n ? (unsigned)L[R0] : 0u; r.y = R1 < n ? (unsigned)L[R1] : 0u;
        r.z = HALF + R0 < n ? (unsigned)L[HALF + R0] : 0u; r.w = HALF + R1 < n ? (unsigned)L[HALF + R1] : 0u;
        return r;
    }
};
struct Moe2Pol {
    static constexpr bool GATHER = false, HG = false, FP8 = true; static constexpr int NT = 8;
    const char* A; const char* WdT; MoeTab tab; int lda, ldb, hstepB, ks, G, c, sclW, sclX;
    __device__ __forceinline__ bool next(int i, GUnit& u) const {
        const int ntile = tab.tpre(NCLS), nwg = ntile * 4; int wgid; if (!order_id(i, G, c, nwg, wgid)) return false;
        const int rtg = wgid >> 2, ct = wgid & 3;
        int cls = 0;
#pragma unroll 1
        for (int k = 1; k < NCLS; ++k) cls += (tab.tpre(k) <= rtg) ? 1 : 0;
        int elo, ehi; moe_class_experts(cls, elo, ehi);
        u.pm = rtg; u.pn = ct; u.e0 = cls; u.e1 = rtg - tab.tpre(cls); u.e2 = 0;
        u.A = A + (size_t)rtg * BM * lda;
        u.B0 = WdT + ((size_t)elo * 1024 + (size_t)ct * 256) * 512; u.B1 = WdT + ((size_t)ehi * 1024 + (size_t)ct * 256) * 512; return true;
    }
};

struct EpiProj {
    bf16_t* P; const float* gq; const float* gk; const float* lbp;
    __device__ __forceinline__ void operator()(const f32x4 (&acc)[2][2][4][2], const GUnit& u, int wr, int wc, int fr, int fq) const {
#ifdef REP_EPIPROJ
        for (int rep_ = 0; rep_ < REP_EPIPROJ - 1; ++rep_) { asm volatile("" ::: "memory"); body(acc, u, wr, wc, fr, fq); }
#endif
        body(acc, u, wr, wc, fr, fq);
    }
    __device__ __forceinline__ void body(const f32x4 (&acc)[2][2][4][2], const GUnit& u, int wr, int wc, int fr, int fq) const {
        const int type = u.pn >> 1;
        const int row0 = u.pm * BM + wr * 64 + fr, lc0 = 64 * wc + 8 * fq;
        bf16_t* base = P + (size_t)row0 * PW + u.pn * BM + lc0;
        if (type <= 1) {
            const float* g = type == 0 ? gq : gk; const float sc = type == 0 ? QSCALE : 1.0f;
            f32x4 gv[2][2];
#pragma unroll
            for (int bj = 0; bj < 2; ++bj)
#pragma unroll
                for (int n = 0; n < 2; ++n) gv[bj][n] = *(const f32x4*)(g + 32 * bj + 8 * fq + 4 * n) * sc;
#pragma unroll
            for (int ai = 0; ai < 2; ++ai)
#pragma unroll
                for (int m = 0; m < 4; ++m) {
                    float ss = 0.f;
#pragma unroll
                    for (int bj = 0; bj < 2; ++bj)
#pragma unroll
                        for (int n = 0; n < 2; ++n) { const f32x4 v = acc[ai][bj][m][n]; ss += (v[0] * v[0] + v[1] * v[1]) + (v[2] * v[2] + v[3] * v[3]); }
                    ss += __shfl_xor(ss, 16); ss += __shfl_xor(ss, 32);
                    const float rstd = __builtin_amdgcn_rsqf(ss * (1.0f / 64.0f) + NORM_EPS);
                    bf16_t* rowp = base + (size_t)(ai * HALF + m * 16) * PW;
#pragma unroll
                    for (int bj = 0; bj < 2; ++bj) { const f32x4 v0 = acc[ai][bj][m][0] * rstd * gv[bj][0], v1 = acc[ai][bj][m][1] * rstd * gv[bj][1];
                        u32x4 w; w.x = cvt_pk_bf16(v0[0], v0[1]); w.y = cvt_pk_bf16(v0[2], v0[3]); w.z = cvt_pk_bf16(v1[0], v1[1]); w.w = cvt_pk_bf16(v1[2], v1[3]);
                        *(u32x4*)(rowp + 32 * bj) = w; }
                }
        } else if (type == 4) {
            const int ch0 = (u.pn - 8) * BM + lc0;
            f32x4 lbv[2][2];
#pragma unroll
            for (int bj = 0; bj < 2; ++bj)
#pragma unroll
                for (int n = 0; n < 2; ++n) { const f32x4 l0 = *(const f32x4*)(lbp + ch0 + 32 * bj + 4 * n), l1 = *(const f32x4*)(lbp + 512 + ch0 + 32 * bj + 4 * n);
#pragma unroll
                    for (int e = 0; e < 4; ++e) lbv[bj][n][e] = sigmoidf_(l0[e] - l1[e]); }
#pragma unroll
            for (int ai = 0; ai < 2; ++ai)
#pragma unroll
                for (int m = 0; m < 4; ++m) { bf16_t* rowp = base + (size_t)(ai * HALF + m * 16) * PW;
#pragma unroll
                    for (int bj = 0; bj < 2; ++bj) { float o[8];
#pragma unroll
                        for (int n = 0; n < 2; ++n)
#pragma unroll
                            for (int e = 0; e < 4; ++e) { const float lb = lbv[bj][n][e]; o[4 * n + e] = lb + (1.0f - lb) * sigmoidf_(acc[ai][bj][m][n][e]); }
                        u32x4 w; w.x = cvt_pk_f16(o[0], o[1]); w.y = cvt_pk_f16(o[2], o[3]); w.z = cvt_pk_f16(o[4], o[5]); w.w = cvt_pk_f16(o[6], o[7]);
                        *(u32x4*)(rowp + 32 * bj) = w; } }
        } else {
            const bool act = (type == 3 || type == 6);
#pragma unroll
            for (int ai = 0; ai < 2; ++ai)
#pragma unroll
                for (int m = 0; m < 4; ++m) { bf16_t* rowp = base + (size_t)(ai * HALF + m * 16) * PW;
#pragma unroll
                    for (int bj = 0; bj < 2; ++bj) { f32x4 v0 = acc[ai][bj][m][0], v1 = acc[ai][bj][m][1];
                        if (act) {
#pragma unroll
                            for (int e = 0; e < 4; ++e) { v0[e] = siluf_(v0[e]); v1[e] = siluf_(v1[e]); } }
                        u32x4 w; w.x = cvt_pk_bf16(v0[0], v0[1]); w.y = cvt_pk_bf16(v0[2], v0[3]); w.z = cvt_pk_bf16(v1[0], v1[1]); w.w = cvt_pk_bf16(v1[2], v1[3]);
                        *(u32x4*)(rowp + 32 * bj) = w; } }
        }
    }
};
struct EpiRes {
    const float* __restrict__ x; bf16_t* __restrict__ x1; const float* __restrict__ gate;
    __device__ __forceinline__ void operator()(const f32x4 (&acc)[2][2][4][2], const GUnit& u, int wr, int wc, int fr, int fq) const {
        const int row0 = u.pm * BM + wr * 64 + fr, col0 = u.pn * BM + 32 * wc + 8 * fq, b = (u.pm * BM) >> 11;
        f32x4 gv[2][2];
#pragma unroll
        for (int bj = 0; bj < 2; ++bj)
#pragma unroll
            for (int n = 0; n < 2; ++n) gv[bj][n] = *(const f32x4*)(gate + (size_t)b * 6144 + col0 + HALF * bj + 4 * n);
#pragma unroll
        for (int ai = 0; ai < 2; ++ai) {
            f32x4 xv[4][2][2];
#pragma unroll
            for (int m = 0; m < 4; ++m) { const size_t off = (size_t)(row0 + ai * HALF + m * 16) * DMODEL + col0;
#pragma unroll
                for (int bj = 0; bj < 2; ++bj) { xv[m][bj][0] = *(const f32x4*)(x + off + HALF * bj); xv[m][bj][1] = *(const f32x4*)(x + off + HALF * bj + 4); } }
#pragma unroll
            for (int m = 0; m < 4; ++m) { const size_t off = (size_t)(row0 + ai * HALF + m * 16) * DMODEL + col0;
#pragma unroll
                for (int bj = 0; bj < 2; ++bj) { const f32x4 o0 = xv[m][bj][0] + gv[bj][0] * acc[ai][bj][m][0], o1 = xv[m][bj][1] + gv[bj][1] * acc[ai][bj][m][1];
                    u32x4 w; w.x = cvt_pk_bf16(o0[0], o0[1]); w.y = cvt_pk_bf16(o0[2], o0[3]); w.z = cvt_pk_bf16(o1[0], o1[1]); w.w = cvt_pk_bf16(o1[2], o1[3]);
                    *(u32x4*)(x1 + off + HALF * bj) = w; } }
        }
    }
};
__device__ __forceinline__ float clamp448(float v) { return __builtin_amdgcn_fmed3f(v, -448.0f, 448.0f); }
__device__ __forceinline__ unsigned pk4_fp8(float a, float b, float c, float d) { int r = 0; r = __builtin_amdgcn_cvt_pk_fp8_f32(clamp448(a), clamp448(b), r, false); r = __builtin_amdgcn_cvt_pk_fp8_f32(clamp448(c), clamp448(d), r, true); return (unsigned)r; }
struct EpiSwiglu {
    unsigned char* __restrict__ act; const float* __restrict__ lw; MoeTab tab;
    __device__ __forceinline__ void operator()(const f32x4 (&acc)[2][2][4][2], const GUnit& u, int wr, int wc, int fr, int fq) const {
        const int r0 = wr * 64 + fr, n = tab.cnt(u.e0) - u.e1 * 256;
        const float* lwp = lw + ((size_t)u.e0 * MTOK + (size_t)u.e1 * 256) * 2 + u.e2;
        unsigned char* base = act + (size_t)(u.pm * BM + r0) * DMODEL + u.e2 * 512 + u.pn * 128 + 32 * wc + 8 * fq;
        float wrow[2][4];
#pragma unroll
        for (int ai = 0; ai < 2; ++ai)
#pragma unroll
            for (int m = 0; m < 4; ++m) { const int r = r0 + ai * HALF + m * 16; wrow[ai][m] = (r < n ? lwp[(size_t)r * 2] : 0.f) * ACT_SCALE; }
#pragma unroll
        for (int ai = 0; ai < 2; ++ai)
#pragma unroll
            for (int m = 0; m < 4; ++m) { const float w = wrow[ai][m];
                float o[8];
#pragma unroll
                for (int nn = 0; nn < 2; ++nn)
#pragma unroll
                    for (int e = 0; e < 4; ++e) o[4 * nn + e] = w * siluf_(acc[ai][0][m][nn][e]) * acc[ai][1][m][nn][e];
                *(u32x2*)(base + (size_t)(ai * HALF + m * 16) * DMODEL) = (u32x2){pk4_fp8(o[0], o[1], o[2], o[3]), pk4_fp8(o[4], o[5], o[6], o[7])}; }
    }
};
struct EpiMoeOut {
    float* __restrict__ out; const bf16_t* __restrict__ x1; const float* __restrict__ gate; const int* __restrict__ list; MoeTab tab;
    __device__ __forceinline__ void operator()(const f32x4 (&acc)[2][2][4][2], const GUnit& u, int wr, int wc, int fr, int fq) const {
        const int r0 = wr * 64 + fr, n = tab.cnt(u.e0) - u.e1 * 256, col0 = u.pn * BM + 32 * wc + 8 * fq;
        const int* L = list + (size_t)u.e0 * MTOK + (size_t)u.e1 * 256;
        int tok[2][4];
#pragma unroll
        for (int ai = 0; ai < 2; ++ai)
#pragma unroll
            for (int m = 0; m < 4; ++m) { const int r = r0 + ai * HALF + m * 16; tok[ai][m] = r < n ? L[r] : 0; }
#pragma unroll
        for (int ai = 0; ai < 2; ++ai)
#pragma unroll
            for (int m = 0; m < 4; ++m) { const int r = r0 + ai * HALF + m * 16, tk = tok[ai][m];
                const float* gp = gate + (size_t)(tk >> 11) * 6144 + col0; float* op = out + (size_t)tk * DMODEL + col0; const bf16_t* xp = x1 + (size_t)tk * DMODEL + col0;
                const u32x4 xa = *(const u32x4*)(xp), xb = *(const u32x4*)(xp + HALF);
                const f32x4 ga0 = *(const f32x4*)(gp), ga1 = *(const f32x4*)(gp + 4), gb0 = *(const f32x4*)(gp + HALF), gb1 = *(const f32x4*)(gp + HALF + 4);
                const f32x4 o0 = (f32x4){bf_lo(xa.x), bf_hi(xa.x), bf_lo(xa.y), bf_hi(xa.y)} + ga0 * acc[ai][0][m][0], o1 = (f32x4){bf_lo(xa.z), bf_hi(xa.z), bf_lo(xa.w), bf_hi(xa.w)} + ga1 * acc[ai][0][m][1];
                const f32x4 o2 = (f32x4){bf_lo(xb.x), bf_hi(xb.x), bf_lo(xb.y), bf_hi(xb.y)} + gb0 * acc[ai][1][m][0], o3 = (f32x4){bf_lo(xb.z), bf_hi(xb.z), bf_lo(xb.w), bf_hi(xb.w)} + gb1 * acc[ai][1][m][1];
                if (r < n) { *(f32x4*)(op) = o0; *(f32x4*)(op + 4) = o1; *(f32x4*)(op + HALF) = o2; *(f32x4*)(op + HALF + 4) = o3; } }
    }
};
}
namespace attn_body {
using bf16 = __hip_bfloat16;
constexpr int D = 64, DM = PW;
constexpr int NW = 8, QBLK = 32, QB = QBLK * NW, KVBLK = 64, NQB = SEQ / QB;
__device__ __forceinline__ int crow(int r, int hi) { return (r & 3) + 8 * (r >> 2) + 4 * hi; }
#define SBAR() __builtin_amdgcn_sched_barrier(0)
__device__ __forceinline__ void cmask(f32x16& p0, f32x16& p1, int jb, int qrel, int hi) {
    const float NEG = -INFINITY; int kb = 64 * jb + 4 * hi;
#pragma unroll
    for (int r = 0; r < 16; ++r) { int kv = kb + (r & 3) + 8 * (r >> 2); if (kv > qrel) p0[r] = NEG; if (kv + 32 > qrel) p1[r] = NEG; }
}
constexpr int NSLOT = 3, SLOTB = 8192;
constexpr int LDS_K = 0, LDS_V = NSLOT * SLOTB, LDS_WS = 2 * NSLOT * SLOTB, LDS_OST = LDS_WS + NW * 64 * 4, LDS_CUM = LDS_OST + NW * 4096, LDS_OG = LDS_CUM + SEQ * 4, LDS_BYTES = LDS_OG + 256;
__device__ __forceinline__ void glds16(const void* gsrc, unsigned lds_dst) { unsigned keep;
    asm volatile("s_mov_b32 %0, m0\n\ts_mov_b32 m0, %2\n\ts_nop 0\n\tglobal_load_lds_dwordx4 %1, off\n\ts_mov_b32 m0, %0" : "=&s"(keep) : "v"(gsrc), "s"(lds_dst) : "memory"); }
typedef float f32x2_t __attribute__((ext_vector_type(2))); typedef __bf16 bf16x2_t __attribute__((ext_vector_type(2)));
__device__ __forceinline__ unsigned cvtpk_s(float lo, float hi) { f32x2_t v = {lo, hi}; bf16x2_t b = __builtin_convertvector(v, bf16x2_t); return __builtin_bit_cast(unsigned, b); }
#define WAIT_BAR(N) asm volatile("s_waitcnt vmcnt(" #N ") lgkmcnt(0)\n\ts_barrier" ::: "memory")
typedef LAS const char* lds_cptr;
typedef short v4i16_t __attribute__((ext_vector_type(4)));
__device__ __forceinline__ void split3(float x, unsigned& w0, unsigned& w1) {
    const unsigned xb = __float_as_uint(x), hb = xb & 0xffff0000u; const float r1 = x - __uint_as_float(hb);
    const unsigned mb = __float_as_uint(r1) & 0xffff0000u; const float r2 = r1 - __uint_as_float(mb);
    w0 = (hb >> 16) | mb; w1 = __float_as_uint(r2) >> 16;
}
__device__ __forceinline__ bf16x8 kbias_frag(float nk, int hi) {
    unsigned w0, w1; split3(nk, w0, w1);
    const u32x4 v = (u32x4){hi ? w0 : 0x3F803F80u, hi ? w1 : 0x00003F80u, 0u, 0u};
    return __builtin_bit_cast(bf16x8, v);
}
__device__ __forceinline__ bf16x8 qbias_frag(float cq, int hi) {
    unsigned w0, w1; split3(cq, w0, w1);
    const u32x4 v = (u32x4){hi ? 0x3F803F80u : w0, hi ? 0x00003F80u : w1, 0u, 0u};
    return __builtin_bit_cast(bf16x8, v);
}
#define Z16 (f32x16){0.f, 0.f, 0.f, 0.f, 0.f, 0.f, 0.f, 0.f, 0.f, 0.f, 0.f, 0.f, 0.f, 0.f, 0.f, 0.f}
__device__ __forceinline__ void qkt(f32x16& p0, f32x16& p1, const char* Kslot, const bf16x8* qr, bf16x8 kb0, bf16x8 kb1, bf16x8 qb, int r32, int hi) {
    const char* kb = Kslot + hi * 1024 + r32 * 16;
    p0 = __builtin_amdgcn_mfma_f32_32x32x16_bf16(kb0, qb, Z16, 0, 0, 0); p1 = __builtin_amdgcn_mfma_f32_32x32x16_bf16(kb1, qb, Z16, 0, 0, 0);
#pragma unroll
    for (int d0 = 0; d0 < 4; ++d0) {
        const bf16x8 b0 = *reinterpret_cast<const bf16x8*>(kb + d0 * 2048);
        const bf16x8 b1 = *reinterpret_cast<const bf16x8*>(kb + d0 * 2048 + 512);
        p0 = __builtin_amdgcn_mfma_f32_32x32x16_bf16(b0, qr[d0], p0, 0, 0, 0); p1 = __builtin_amdgcn_mfma_f32_32x32x16_bf16(b1, qr[d0], p1, 0, 0, 0); }
}
__device__ __forceinline__ void kload8(bf16x8* kf, lds_cptr kp) {
    kf[0] = *(const LAS bf16x8*)(kp);        kf[1] = *(const LAS bf16x8*)(kp + 512);
    kf[2] = *(const LAS bf16x8*)(kp + 2048); kf[3] = *(const LAS bf16x8*)(kp + 2560);
    kf[4] = *(const LAS bf16x8*)(kp + 4096); kf[5] = *(const LAS bf16x8*)(kp + 4608);
    kf[6] = *(const LAS bf16x8*)(kp + 6144); kf[7] = *(const LAS bf16x8*)(kp + 6656);
}
__device__ __forceinline__ void kload2(bf16x8* kf, lds_cptr kp, int j) { kf[2 * j] = *(const LAS bf16x8*)(kp + j * 2048); kf[2 * j + 1] = *(const LAS bf16x8*)(kp + j * 2048 + 512); }
__device__ __forceinline__ s16x4 vtr(lds_cptr p) { return __builtin_bit_cast(s16x4, __builtin_amdgcn_ds_read_tr16_b64_v4i16((LAS v4i16_t*)p)); }
__device__ __forceinline__ void pv(f32x16* o, int vb, bf16x8 pa0, bf16x8 pa1, bf16x8 pa2, bf16x8 pa3) {
#pragma unroll
    for (int d0 = 0; d0 < 2; ++d0) { s16x4 lo[4], hi[4];
#pragma unroll
        for (int ks = 0; ks < 4; ++ks) {
            asm volatile("ds_read_b64_tr_b16 %0,%1 offset:%c2" : "=&v"(lo[ks]) : "v"(vb), "i"(d0 * 4096 + ks * 1024) : "memory");
            asm volatile("ds_read_b64_tr_b16 %0,%1 offset:%c2" : "=&v"(hi[ks]) : "v"(vb), "i"(d0 * 4096 + ks * 1024 + 512) : "memory"); }
        asm volatile("s_waitcnt lgkmcnt(0)" ::: "memory"); SBAR();
#define PK(k) (bf16x8){lo[k][0], lo[k][1], lo[k][2], lo[k][3], hi[k][0], hi[k][1], hi[k][2], hi[k][3]}
        o[d0] = __builtin_amdgcn_mfma_f32_32x32x16_bf16(pa0, PK(0), o[d0], 0, 0, 0);
        o[d0] = __builtin_amdgcn_mfma_f32_32x32x16_bf16(pa1, PK(1), o[d0], 0, 0, 0);
        o[d0] = __builtin_amdgcn_mfma_f32_32x32x16_bf16(pa2, PK(2), o[d0], 0, 0, 0);
        o[d0] = __builtin_amdgcn_mfma_f32_32x32x16_bf16(pa3, PK(3), o[d0], 0, 0, 0);
#undef PK
    }
}

__device__ __forceinline__ void attn_unit(int b, int h, int qb, const bf16* P, bf16* O, float m0l, char* shm, bool pre, bool nxt) {
    int tid = threadIdx.x; asm volatile("" : "+v"(tid));
    const int lane = tid & 63, r32 = lane & 31, hi = lane >> 5; const int wid = __builtin_amdgcn_readfirstlane(tid >> 6);
    const long rowbase = (long)b * SEQ; const int q0 = qb * QB;
    const bf16* Qw = P + (rowbase + q0 + wid * QBLK) * DM + PC_Q + h * D;
    const bf16* Kh = P + rowbase * DM + PC_K + h * D, *Vh = P + rowbase * DM + PC_V + h * D;
    const unsigned lds0 = (unsigned)(uintptr_t)shm;
    float* wsf = (float*)(shm + LDS_WS) + wid * 64;
    const bf16* ksrc = Kh + (long)lane * DM + wid * 8;
    const bf16* vsrc = Vh + (long)(16 * (wid & 3) + (lane >> 2)) * DM + (wid >> 2) * 32 + (lane & 3) * 8;
    const unsigned kdst = lds0 + LDS_K + wid * 1024, vdst = lds0 + LDS_V + wid * 1024;
#define DMA_K(t, slot) glds16(ksrc + (long)(t) * KVBLK * DM, (unsigned)__builtin_amdgcn_readfirstlane(kdst + (slot)))
#define DMA_V(t, slot) glds16(vsrc + (long)(t) * KVBLK * DM, (unsigned)__builtin_amdgcn_readfirstlane(vdst + (slot)))
    const int vb0 = (int)(lds0 + LDS_V) + ((lane >> 4) & 1) * 32 + (lane & 3) * 8 + (4 * hi + ((lane & 15) >> 2)) * 64;
    const char* Kbase = shm + LDS_K; bf16x8 kf[8];
    const lds_cptr shm3 = (lds_cptr)shm; const lds_cptr kp0 = shm3 + LDS_K + hi * 1024 + r32 * 16; const lds_cptr vp0 = shm3 + LDS_V + ((lane >> 4) & 1) * 32 + (lane & 3) * 8 + (4 * hi + ((lane & 15) >> 2)) * 64;
    const lds_cptr cump = shm3 + LDS_CUM + r32 * 4;
    const int NT = (q0 + QB) / KVBLK;
    if (!pre) { DMA_K(0, 0); DMA_V(0, 0); DMA_K(1, SLOTB); }
    bf16x8 qr[4];
#pragma unroll
    for (int d0 = 0; d0 < 4; ++d0) qr[d0] = *reinterpret_cast<const bf16x8*>(&Qw[(long)r32 * DM + d0 * 16 + hi * 8]);
    float l_reg = 0.f; f32x16 o[2]; o[0] = f32x16{}; o[1] = f32x16{};
    const int qrel = wid * QBLK + r32;
    const bf16x8 qbf = qbias_frag(-*(const LAS float*)(shm3 + LDS_CUM + (q0 + qrel) * 4) - m0l, hi);
#define CMASK(P0, P1, t) do { int jb_ = (t) - (NT - 4); if (jb_ >= 0) cmask(P0, P1, jb_, qrel, hi); } while (0)
#define CKL(t, off) (*(const LAS float*)(cump + (t) * 256 + (off)))
    f32x16 pA0, pA1, pB0, pB1;
    int sl_prev = 0, sl_cur = 0, sl_next = SLOTB;
#define ROT() do { sl_prev = sl_cur; sl_cur = sl_next; sl_next = (sl_next == (NSLOT - 1) * SLOTB) ? 0 : sl_next + SLOTB; } while (0)
    DMA_K(2, 2 * SLOTB);
    bf16x8 kb0 = kbias_frag(CKL(0, 0), hi), kb1 = kbias_frag(CKL(0, 128), hi);
    WAIT_BAR(3);
    qkt(pA0, pA1, Kbase, qr, kb0, kb1, qbf, r32, hi); asm volatile("s_nop 15\n\ts_nop 7" : "+v"(pA0), "+v"(pA1)); CMASK(pA0, pA1, 0);
#pragma unroll
    for (int r = 0; r < 16; ++r) { pA0[r] = __builtin_amdgcn_exp2f(pA0[r]); pA1[r] = __builtin_amdgcn_exp2f(pA1[r]); }
    kb0 = kbias_frag(CKL(1, 0), hi); kb1 = kbias_frag(CKL(1, 128), hi);
    WAIT_BAR(0);
    DMA_K(3, 0); DMA_V(1, SLOTB);
    ROT();
    kload8(kf, kp0 + sl_cur);
    WAIT_BAR(2);
    s16x4 vlo[8], vhi[8]; u32x4 pw0, pw1, pw2, pw3; float nk0 = 0.f, nk1 = 0.f;
#define PKW(P, B) cvtpk_s(P[B], P[B + 1])
#define PAF(k) __builtin_bit_cast(bf16x8, pw##k)
#define VFR(i) (bf16x8){vlo[i][0], vlo[i][1], vlo[i][2], vlo[i][3], vhi[i][0], vhi[i][1], vhi[i][2], vhi[i][3]}
#define PIN(x) asm volatile("" : "+v"(x))
#define GAPA(MF, A0, A1, A2, A3, W0, W1, PW_) do { MF; sacc += A0; sacc += A1; sacc += A2; sacc += A3; PIN(sacc); W0; W1; PIN(PW_); SBAR(); } while (0)
#define EX(v) __builtin_amdgcn_exp2f(v)
#define GAPB(MF, X, B) do { MF; X[B] = EX(X[B]); X[B + 1] = EX(X[B + 1]); X[B + 2] = EX(X[B + 2]); X[B + 3] = EX(X[B + 3]); PIN(X); SBAR(); } while (0)
#define VRD(i) do { vlo[i] = vtr(vp_ + (((i) >> 2) * 4096 + ((i) & 3) * 1024)); vhi[i] = vtr(vp_ + (((i) >> 2) * 4096 + ((i) & 3) * 1024 + 512)); } while (0)
#define KRD(G, j) do { if (G) { kload2(kf, kp0 + sl_next, j); SBAR(); } } while (0)
#define STEP(C0, C1, P0, P1, t, GK, GV, GL, GI) do { SBAR(); \
    const lds_cptr vp_ = vp0 + sl_prev; \
    C0 = __builtin_amdgcn_mfma_f32_32x32x16_bf16(kb0, qbf, Z16, 0, 0, 0); C1 = __builtin_amdgcn_mfma_f32_32x32x16_bf16(kb1, qbf, Z16, 0, 0, 0); \
    if (GI) { nk0 = CKL((t) + 1, 0); nk1 = CKL((t) + 1, 128); } \
    SBAR(); \
    VRD(0); SBAR(); float sacc = (P0[0] + P0[1]); \
    GAPA(C0 = __builtin_amdgcn_mfma_f32_32x32x16_bf16(kf[0], qr[0], C0, 0, 0, 0), P0[2], P0[3], P0[4], P0[5],     pw0[0] = PKW(P0, 0), pw0[1] = PKW(P0, 2), pw0); \
    VRD(4); SBAR(); GAPA(C1 = __builtin_amdgcn_mfma_f32_32x32x16_bf16(kf[1], qr[0], C1, 0, 0, 0), P0[6], P0[7], P0[8], P0[9],     pw0[2] = PKW(P0, 4), pw0[3] = PKW(P0, 6), pw0); \
    VRD(1); SBAR(); GAPA(C0 = __builtin_amdgcn_mfma_f32_32x32x16_bf16(kf[2], qr[1], C0, 0, 0, 0), P0[10], P0[11], P0[12], P0[13], pw1[0] = PKW(P0, 8), pw1[1] = PKW(P0, 10), pw1); \
    VRD(5); SBAR(); GAPA(C1 = __builtin_amdgcn_mfma_f32_32x32x16_bf16(kf[3], qr[1], C1, 0, 0, 0), P0[14], P0[15], P1[0], P1[1],   pw1[2] = PKW(P0, 12), pw1[3] = PKW(P0, 14), pw1); \
    VRD(2); SBAR(); GAPA(C0 = __builtin_amdgcn_mfma_f32_32x32x16_bf16(kf[4], qr[2], C0, 0, 0, 0), P1[2], P1[3], P1[4], P1[5],     pw2[0] = PKW(P1, 0), pw2[1] = PKW(P1, 2), pw2); \
    VRD(6); SBAR(); GAPA(C1 = __builtin_amdgcn_mfma_f32_32x32x16_bf16(kf[5], qr[2], C1, 0, 0, 0), P1[6], P1[7], P1[8], P1[9],     pw2[2] = PKW(P1, 4), pw2[3] = PKW(P1, 6), pw2); \
    VRD(3); SBAR(); GAPA(C0 = __builtin_amdgcn_mfma_f32_32x32x16_bf16(kf[6], qr[3], C0, 0, 0, 0), P1[10], P1[11], P1[12], P1[13], pw3[0] = PKW(P1, 8), pw3[1] = PKW(P1, 10), pw3); \
    VRD(7); SBAR(); GAPA(C1 = __builtin_amdgcn_mfma_f32_32x32x16_bf16(kf[7], qr[3], C1, 0, 0, 0), P1[14], P1[15], 0.f, 0.f,       pw3[2] = PKW(P1, 12), pw3[3] = PKW(P1, 14), pw3); \
    l_reg += sacc; \
    if (GI) { kb0 = kbias_frag(nk0, hi); kb1 = kbias_frag(nk1, hi); } \
    if (GK) { DMA_K((t) + 3, sl_cur); } if (GV) { DMA_V((t) + 1, sl_next); } \
    CMASK(C0, C1, t); \
    SBAR(); \
    GAPB(o[0] = __builtin_amdgcn_mfma_f32_32x32x16_bf16(PAF(0), VFR(0), o[0], 0, 0, 0), C0, 0); \
    GAPB(o[1] = __builtin_amdgcn_mfma_f32_32x32x16_bf16(PAF(0), VFR(4), o[1], 0, 0, 0), C0, 4); \
    KRD(GL, 0); GAPB(o[0] = __builtin_amdgcn_mfma_f32_32x32x16_bf16(PAF(1), VFR(1), o[0], 0, 0, 0), C0, 8); \
    KRD(GL, 1); GAPB(o[1] = __builtin_amdgcn_mfma_f32_32x32x16_bf16(PAF(1), VFR(5), o[1], 0, 0, 0), C0, 12); \
    KRD(GL, 2); GAPB(o[0] = __builtin_amdgcn_mfma_f32_32x32x16_bf16(PAF(2), VFR(2), o[0], 0, 0, 0), C1, 0); \
    KRD(GL, 3); GAPB(o[1] = __builtin_amdgcn_mfma_f32_32x32x16_bf16(PAF(2), VFR(6), o[1], 0, 0, 0), C1, 4); \
    GAPB(o[0] = __builtin_amdgcn_mfma_f32_32x32x16_bf16(PAF(3), VFR(3), o[0], 0, 0, 0), C1, 8); \
    GAPB(o[1] = __builtin_amdgcn_mfma_f32_32x32x16_bf16(PAF(3), VFR(7), o[1], 0, 0, 0), C1, 12); \
    } while (0)
    int t = 1;
#undef CMASK
#define CMASK(P0, P1, t) do {} while (0)
    for (; t + 5 < NT; t += 2) {
        STEP(pB0, pB1, pA0, pA1, t, true, true, true, true);     WAIT_BAR(2); ROT();
        STEP(pA0, pA1, pB0, pB1, t + 1, true, true, true, true); WAIT_BAR(2); ROT();
    }
#undef CMASK
#define CMASK(P0, P1, t) do { int jb_ = (t) - (NT - 4); if (jb_ >= 0) cmask(P0, P1, jb_, qrel, hi); } while (0)
#define ENDW(tt) do { if ((tt) + 3 < NT) { WAIT_BAR(2); } else if ((tt) + 2 < NT) { WAIT_BAR(1); } else { WAIT_BAR(0); } } while (0)
    for (; t + 1 < NT; t += 2) {
        STEP(pB0, pB1, pA0, pA1, t, (t + 3 < NT), (t + 1 < NT), (t + 1 < NT), (t + 1 < NT));     ENDW(t);     ROT();
        STEP(pA0, pA1, pB0, pB1, t + 1, (t + 4 < NT), (t + 2 < NT), (t + 2 < NT), (t + 2 < NT)); ENDW(t + 1); ROT();
    }
    STEP(pB0, pB1, pA0, pA1, NT - 1, false, false, false, false);
    { float sacc = pB0[0] + pB0[1];
#pragma unroll
      for (int r = 2; r < 16; ++r) sacc += pB0[r];
#pragma unroll
      for (int r = 0; r < 16; ++r) sacc += pB1[r];
      l_reg += sacc;
      pw0 = (u32x4){PKW(pB0, 0), PKW(pB0, 2), PKW(pB0, 4), PKW(pB0, 6)}; pw1 = (u32x4){PKW(pB0, 8), PKW(pB0, 10), PKW(pB0, 12), PKW(pB0, 14)}; pw2 = (u32x4){PKW(pB1, 0), PKW(pB1, 2), PKW(pB1, 4), PKW(pB1, 6)}; pw3 = (u32x4){PKW(pB1, 8), PKW(pB1, 10), PKW(pB1, 12), PKW(pB1, 14)};
      SBAR(); pv(o, vb0 + sl_cur, PAF(0), PAF(1), PAF(2), PAF(3)); }
#undef PKW
#undef PAF
#undef VFR
#undef PIN
#undef GAPA
#undef GAPB
#undef EX
#undef VRD
#undef KRD
#undef STEP
#undef ENDW
    if (nxt) { asm volatile("s_waitcnt lgkmcnt(0)\n\ts_barrier" ::: "memory");
        DMA_K(0, 0); DMA_V(0, 0); DMA_K(1, SLOTB); }
    { auto rr = __builtin_amdgcn_permlane32_swap(__float_as_uint(l_reg), __float_as_uint(l_reg), false, false); l_reg = __uint_as_float(rr[0]) + __uint_as_float(rr[1]); }
    if (hi == 0) wsf[32 + r32] = l_reg; asm volatile("s_waitcnt lgkmcnt(0)" ::: "memory");
    float rli[16];
#pragma unroll
    for (int r = 0; r < 16; ++r) rli[r] = __builtin_amdgcn_rcpf(wsf[32 + crow(r, hi)]);
    bf16* Ow = O + (rowbase + q0 + wid * QBLK) * DMODEL + h * D;
    { bf16* stg = (bf16*)(shm + LDS_OST) + wid * 2048;
#pragma unroll
      for (int r = 0; r < 16; ++r) { const int orow = crow(r, hi);
#pragma unroll
          for (int d0 = 0; d0 < 2; ++d0) stg[orow * 64 + d0 * 32 + r32] = __float2bfloat16(o[d0][r] * rli[r]); }
      asm volatile("s_waitcnt lgkmcnt(0)" ::: "memory");
      const int ch = lane & 7; const f32x4 g0 = *(const LAS f32x4*)(shm3 + LDS_OG + ch * 32), g1 = *(const LAS f32x4*)(shm3 + LDS_OG + ch * 32 + 16);
#pragma unroll
      for (int i = 0; i < 4; ++i) { const int row = i * 8 + (lane >> 3); const u32x4 v = *(const u32x4*)(stg + row * 64 + ch * 8);
          float f[8]; f[0] = bf_lo(v.x); f[1] = bf_hi(v.x); f[2] = bf_lo(v.y); f[3] = bf_hi(v.y); f[4] = bf_lo(v.z); f[5] = bf_hi(v.z); f[6] = bf_lo(v.w); f[7] = bf_hi(v.w);
          float ss = 0.f;
#pragma unroll
          for (int j = 0; j < 8; ++j) ss += f[j] * f[j];
          ss += __shfl_xor(ss, 1); ss += __shfl_xor(ss, 2); ss += __shfl_xor(ss, 4);
          const float rs = __builtin_amdgcn_rsqf(ss * (1.0f / 64.0f) + NORM_EPS);
          u32x4 w; w.x = cvtpk_s(f[0] * rs * g0[0], f[1] * rs * g0[1]); w.y = cvtpk_s(f[2] * rs * g0[2], f[3] * rs * g0[3]); w.z = cvtpk_s(f[4] * rs * g1[0], f[5] * rs * g1[1]); w.w = cvtpk_s(f[6] * rs * g1[2], f[7] * rs * g1[3]);
          *(u32x4*)(Ow + (long)row * DMODEL + ch * 8) = w; } }
    asm volatile("s_waitcnt lgkmcnt(0)\n\ts_barrier" ::: "memory");
#undef DMA_K
#undef DMA_V
#undef CMASK
#undef CKL
#undef ROT
}
constexpr int ATTN_LDS_BYTES = LDS_BYTES;

__device__ __forceinline__ float attn_prep(int b, int h, const float* logf, const float* gq, const float* gk, const float* og, char* shm) {
    int tid = threadIdx.x; asm volatile("" : "+v"(tid));
    const int lane = tid & 63, wid = tid >> 6;
    LAS float* cum = (LAS float*)((lds_cptr)shm + LDS_CUM);
    LAS float* wtot = (LAS float*)((lds_cptr)shm + LDS_WS);
    const float* src = logf + ((size_t)b * SEQ + 4 * tid) * AH + h;
    float v0 = src[0], v1 = src[AH], v2 = src[2 * AH], v3 = src[3 * AH];
    v1 += v0; v2 += v1; v3 += v2;
    float inc = v3;
#pragma unroll
    for (int o = 1; o < 64; o <<= 1) { const float y = __shfl_up(inc, o); if (lane >= o) inc += y; }
    if (lane == 63) wtot[wid] = inc;
    if (tid < D) *(LAS float*)((lds_cptr)shm + LDS_OG + tid * 4) = og[h * D + tid];
    float mq = fabsf(gq[lane]), mk = fabsf(gk[lane]);
#pragma unroll
    for (int o = 1; o < 64; o <<= 1) { mq = fmaxf(mq, __shfl_xor(mq, o)); mk = fmaxf(mk, __shfl_xor(mk, o)); }
    __syncthreads();
    float off = inc - v3;
    for (int w = 0; w < wid; ++w) off += wtot[w];
    *(LAS f32x4*)(cum + 4 * tid) = (f32x4){-(off + v0) * LOG2E, -(off + v1) * LOG2E, -(off + v2) * LOG2E, -(off + v3) * LOG2E};
    __syncthreads();
    return 8.0f * mq * mk * LOG2E;
}
#undef SBAR
#undef WAIT_BAR
}
namespace hgrn {
constexpr int C = 64, NCHUNK = SEQ / C;
constexpr int RS = 272, RS64 = 144;
constexpr int L_QT = 0, L_KT = 17408, L_QH = 34816, L_KHT = 52224, L_VT = 70656, L_ST = 89088, L_P = 123904, L_DL = 133120, L_OG = 133632, L_OUT = 134144, L_BYTES = 151552;
__device__ __forceinline__ bf16x8 frag(LAS unsigned char* lds, int base, int row, int rs, int kb) { return *(const LAS bf16x8*)(lds + base + row * rs + kb); }
__device__ __forceinline__ bf16x8 fragr(LAS unsigned char* lds, int base, int row, int kb) { return *(const LAS bf16x8*)(lds + base + row * RS + ((kb + ((row >> 3) << 5)) & 255)); }
__device__ __forceinline__ float h_lo(unsigned u) { h16x2 v = __builtin_bit_cast(h16x2, u); return (float)v.x; }
__device__ __forceinline__ float h_hi(unsigned u) { h16x2 v = __builtin_bit_cast(h16x2, u); return (float)v.y; }

template <int SKH = 0>
__device__ __forceinline__ void hgrn_unit(int b, int h, const bf16_t* P, bf16_t* AO, const float* og, LAS unsigned char* lds) {
#define HG_SYNC() do { if constexpr (SKH != 4) __syncthreads(); } while (0)
    int tid = threadIdx.x; asm volatile("" : "+v"(tid));
    const int lane = tid & 63, w = __builtin_amdgcn_readfirstlane(tid >> 6);
    const int cp = lane & 7, oct = lane >> 3, fr = lane & 15, fq = lane >> 4;
    const int k0 = 16 * w + 2 * cp;
    const size_t rowbase = (size_t)b * SEQ;
    const bf16_t* pq = P + (rowbase + 8 * oct) * PW + PC_HQ + h * HK + k0;
    const bf16_t* pg = P + (rowbase + 8 * oct) * PW + PC_HG + h * HK + k0;
    const bf16_t* pv = P + (rowbase + 8 * oct) * PW + PC_HV + h * HK + k0;
    const int tn = tid >> 3, seg = tid & 7;
    const bf16_t* pgate = P + (rowbase + tn) * PW + PC_HO + h * HK + 16 * seg;
    bf16_t* pout = AO + (rowbase + tn) * DMODEL + AW + h * HK + 16 * seg;
    if (tid < HK) *(LAS float*)(lds + L_OG + tid * 4) = og[h * HK + tid];
    for (int i = tid; i < (128 * RS) / 16; i += 512) *(LAS u32x4*)(lds + L_ST + i * 16) = (u32x4){0u, 0u, 0u, 0u};
    f32x4 sacc[8];
#pragma unroll
    for (int i = 0; i < 8; ++i) sacc[i] = (f32x4){0.f, 0.f, 0.f, 0.f};
    unsigned rq[8], rg[8], rv[8];
#pragma unroll
    for (int i = 0; i < 8; ++i) { rq[i] = *(const unsigned*)(pq + (size_t)i * PW); rg[i] = *(const unsigned*)(pg + (size_t)i * PW); rv[i] = *(const unsigned*)(pv + (size_t)i * PW); }
    const int ti = w >> 1, vh = w & 1;
#define HG_NORM(cc, G0, G1) do { if constexpr (SKH != 3) { \
        const u32x4 oa = *(const LAS u32x4*)(lds + L_OUT + tn * RS + 32 * seg), ob = *(const LAS u32x4*)(lds + L_OUT + tn * RS + 32 * seg + 16); \
        const unsigned ou[8] = {oa.x, oa.y, oa.z, oa.w, ob.x, ob.y, ob.z, ob.w}; float ss = 0.f; \
        _Pragma("unroll") for (int j = 0; j < 8; ++j) ss += bf_lo(ou[j]) * bf_lo(ou[j]) + bf_hi(ou[j]) * bf_hi(ou[j]); \
        ss += __shfl_xor(ss, 1); ss += __shfl_xor(ss, 2); ss += __shfl_xor(ss, 4); \
        const float rs = __builtin_amdgcn_rsqf(ss * (1.0f / 128.0f) + NORM_EPS); \
        const unsigned gw[8] = {G0.x, G0.y, G0.z, G0.w, G1.x, G1.y, G1.z, G1.w}; unsigned ow[8]; \
        _Pragma("unroll") for (int j = 0; j < 4; ++j) { const f32x4 g = *(const LAS f32x4*)(lds + L_OG + (16 * seg + 4 * j) * 4); \
            ow[2 * j] = cvt_pk_bf16(bf_lo(ou[2 * j]) * rs * g[0] * bf_lo(gw[2 * j]), bf_hi(ou[2 * j]) * rs * g[1] * bf_hi(gw[2 * j])); \
            ow[2 * j + 1] = cvt_pk_bf16(bf_lo(ou[2 * j + 1]) * rs * g[2] * bf_lo(gw[2 * j + 1]), bf_hi(ou[2 * j + 1]) * rs * g[3] * bf_hi(gw[2 * j + 1])); } \
        bf16_t* po = pout + (size_t)(C * (cc)) * DMODEL; \
        *(u32x4*)po = (u32x4){ow[0], ow[1], ow[2], ow[3]}; *(u32x4*)(po + 8) = (u32x4){ow[4], ow[5], ow[6], ow[7]}; } } while (0)
#pragma unroll 1
    for (int c = 0; c < NCHUNK; ++c) {
        const int cprev = c > 0 ? c - 1 : 0;
        const u32x4 gt0 = *(const u32x4*)(pgate + (size_t)(C * cprev) * PW), gt1 = *(const u32x4*)(pgate + (size_t)(C * cprev) * PW + 8);
        if constexpr (SKH != 2) {
            float f0[8], f1[8], p0[8], p1[8], s0[8], s1[8];
#pragma unroll
            for (int i = 0; i < 8; ++i) { f0[i] = h_lo(rg[i]); f1[i] = h_hi(rg[i]); }
            p0[0] = f0[0]; p1[0] = f1[0];
#pragma unroll
            for (int i = 1; i < 8; ++i) { p0[i] = p0[i - 1] * f0[i]; p1[i] = p1[i - 1] * f1[i]; }
            s0[7] = 1.0f; s1[7] = 1.0f;
#pragma unroll
            for (int i = 6; i >= 0; --i) { s0[i] = s0[i + 1] * f0[i + 1]; s1[i] = s1[i + 1] * f1[i + 1]; }
            const float lt0 = __builtin_amdgcn_logf(p0[7]), lt1 = __builtin_amdgcn_logf(p1[7]);
            float x0 = lt0, x1 = lt1;
#pragma unroll
            for (int o = 8; o < 64; o <<= 1) { const float y0 = __shfl_up(x0, o), y1 = __shfl_up(x1, o); if (lane >= o) { x0 += y0; x1 += y1; } }
            const float off0 = x0 - lt0, off1 = x1 - lt1;
            const float a0 = __shfl(x0, cp + 24), a1 = __shfl(x1, cp + 24), e0 = __shfl(x0, cp + 56), e1 = __shfl(x1, cp + 56);
            const float Eq0 = __builtin_amdgcn_exp2f(fminf(off0 - a0, 120.f)), Eq1 = __builtin_amdgcn_exp2f(fminf(off1 - a1, 120.f));
            const float Ek0 = __builtin_amdgcn_exp2f(fminf(a0 - x0, 120.f)), Ek1 = __builtin_amdgcn_exp2f(fminf(a1 - x1, 120.f));
            const float Eh0 = __builtin_amdgcn_exp2f(off0), Eh1 = __builtin_amdgcn_exp2f(off1);
            const float El0 = __builtin_amdgcn_exp2f(e0 - x0), El1 = __builtin_amdgcn_exp2f(e1 - x1);
            unsigned kh0[4], kh1[4], vt0[4], vt1[4];
            float pkh0 = 0.f, pkh1 = 0.f;
            const int rotw = (32 * (w + oct)) & 255;
#pragma unroll
            for (int i = 0; i < 8; ++i) {
                const int t = 8 * oct + i;
                const float qp0 = bf_lo(rq[i]) * p0[i], qp1 = bf_hi(rq[i]) * p1[i];
                const float ks0 = (1.0f - f0[i]) * s0[i], ks1 = (1.0f - f1[i]) * s1[i];
                *(LAS unsigned*)(lds + L_QT + t * RS + rotw + 4 * cp) = cvt_pk_bf16(qp0 * Eq0, qp1 * Eq1);
                *(LAS unsigned*)(lds + L_KT + t * RS + rotw + 4 * cp) = cvt_pk_bf16(ks0 * Ek0, ks1 * Ek1);
                *(LAS unsigned*)(lds + L_QH + t * RS + rotw + 4 * cp) = cvt_pk_bf16(qp0 * Eh0, qp1 * Eh1);
                const float kha = ks0 * El0, khb = ks1 * El1;
                if (i & 1) { kh0[i >> 1] = cvt_pk_bf16(pkh0, kha); kh1[i >> 1] = cvt_pk_bf16(pkh1, khb); vt0[i >> 1] = (rv[i - 1] & 0xffffu) | (rv[i] << 16); vt1[i >> 1] = (rv[i - 1] >> 16) | (rv[i] & 0xffff0000u); }
                else { pkh0 = kha; pkh1 = khb; }
            }
            *(LAS u32x4*)(lds + L_KHT + k0 * RS64 + 16 * oct) = (u32x4){kh0[0], kh0[1], kh0[2], kh0[3]};
            *(LAS u32x4*)(lds + L_KHT + (k0 + 1) * RS64 + 16 * oct) = (u32x4){kh1[0], kh1[1], kh1[2], kh1[3]};
            *(LAS u32x4*)(lds + L_VT + k0 * RS64 + 16 * oct) = (u32x4){vt0[0], vt0[1], vt0[2], vt0[3]};
            *(LAS u32x4*)(lds + L_VT + (k0 + 1) * RS64 + 16 * oct) = (u32x4){vt1[0], vt1[1], vt1[2], vt1[3]};
            if (oct == 0) *(LAS f32x2*)(lds + L_DL + k0 * 4) = (f32x2){__builtin_amdgcn_exp2f(e0), __builtin_amdgcn_exp2f(e1)};
        }
        if (c + 1 < NCHUNK) {
#pragma unroll
            for (int i = 0; i < 8; ++i) { const size_t o = (size_t)(C * (c + 1) + i) * PW; rq[i] = *(const unsigned*)(pq + o); rg[i] = *(const unsigned*)(pg + o); rv[i] = *(const unsigned*)(pv + o); }
        }
        HG_SYNC();
        f32x4 oacc[4] = {(f32x4){0.f, 0.f, 0.f, 0.f}, (f32x4){0.f, 0.f, 0.f, 0.f}, (f32x4){0.f, 0.f, 0.f, 0.f}, (f32x4){0.f, 0.f, 0.f, 0.f}};
        if constexpr (SKH != 1) {
            bf16x8 qf[4];
#pragma unroll
            for (int ks = 0; ks < 4; ++ks) qf[ks] = fragr(lds, L_QT, 16 * ti + fr, 64 * ks + 16 * fq);
#pragma unroll
            for (int sj = 0; sj < 2; ++sj) { const int si = 2 * vh + sj; u32x2 pk = (u32x2){0u, 0u};
                if (si <= ti) { f32x4 a = (f32x4){0.f, 0.f, 0.f, 0.f};
#pragma unroll
                    for (int ks = 0; ks < 4; ++ks) a = __builtin_amdgcn_mfma_f32_16x16x32_bf16(fragr(lds, L_KT, 16 * si + fr, 64 * ks + 16 * fq), qf[ks], a, 0, 0, 0);
                    const int s0 = 16 * si + 4 * fq, t = 16 * ti + fr;
#pragma unroll
                    for (int e = 0; e < 4; ++e) a[e] = (s0 + e <= t) ? a[e] : 0.f;
                    pk.x = cvt_pk_bf16(a[0], a[1]); pk.y = cvt_pk_bf16(a[2], a[3]); }
                *(LAS u32x2*)(lds + L_P + (16 * ti + fr) * RS64 + (16 * si + 4 * fq) * 2) = pk; }
#pragma unroll
            for (int ks = 0; ks < 4; ++ks) qf[ks] = fragr(lds, L_QH, 16 * ti + fr, 64 * ks + 16 * fq);
#pragma unroll
            for (int vj = 0; vj < 4; ++vj) { oacc[vj] = (f32x4){0.f, 0.f, 0.f, 0.f};
#pragma unroll
                for (int ks = 0; ks < 4; ++ks) oacc[vj] = __builtin_amdgcn_mfma_f32_16x16x32_bf16(frag(lds, L_ST, 16 * (4 * vh + vj) + fr, RS, 64 * ks + 16 * fq), qf[ks], oacc[vj], 0, 0, 0); }
        }
        if (c > 0) HG_NORM(c - 1, gt0, gt1);
        HG_SYNC();
        if constexpr (SKH != 1) {
            bf16x8 pf[2];
#pragma unroll
            for (int ks = 0; ks < 2; ++ks) pf[ks] = frag(lds, L_P, 16 * ti + fr, RS64, 64 * ks + 16 * fq);
#pragma unroll
            for (int vj = 0; vj < 4; ++vj)
#pragma unroll
                for (int ks = 0; ks < 2; ++ks) oacc[vj] = __builtin_amdgcn_mfma_f32_16x16x32_bf16(frag(lds, L_VT, 16 * (4 * vh + vj) + fr, RS64, 64 * ks + 16 * fq), pf[ks], oacc[vj], 0, 0, 0);
            const f32x4 dl = *(const LAS f32x4*)(lds + L_DL + (16 * w + 4 * fq) * 4);
            bf16x8 kf[2];
#pragma unroll
            for (int ks = 0; ks < 2; ++ks) kf[ks] = frag(lds, L_KHT, 16 * w + fr, RS64, 64 * ks + 16 * fq);
#pragma unroll
            for (int vt = 0; vt < 8; ++vt) { sacc[vt] = sacc[vt] * dl;
#pragma unroll
                for (int ks = 0; ks < 2; ++ks) sacc[vt] = __builtin_amdgcn_mfma_f32_16x16x32_bf16(kf[ks], frag(lds, L_VT, 16 * vt + fr, RS64, 64 * ks + 16 * fq), sacc[vt], 0, 0, 0);
                u32x2 sk; sk.x = cvt_pk_bf16(sacc[vt][0], sacc[vt][1]); sk.y = cvt_pk_bf16(sacc[vt][2], sacc[vt][3]);
                *(LAS u32x2*)(lds + L_ST + (16 * vt + fr) * RS + (16 * w + 4 * fq) * 2) = sk; }
#pragma unroll
            for (int vj = 0; vj < 4; ++vj) *(LAS u32x2*)(lds + L_OUT + (16 * ti + fr) * RS + (16 * (4 * vh + vj) + 4 * fq) * 2) = (u32x2){cvt_pk_bf16(oacc[vj][0], oacc[vj][1]), cvt_pk_bf16(oacc[vj][2], oacc[vj][3])};
        }
        HG_SYNC();
    }
    { const u32x4 gt0 = *(const u32x4*)(pgate + (size_t)(C * (NCHUNK - 1)) * PW), gt1 = *(const u32x4*)(pgate + (size_t)(C * (NCHUNK - 1)) * PW + 8); HG_NORM(NCHUNK - 1, gt0, gt1); }
    HG_SYNC();
#undef HG_NORM
#undef HG_SYNC
}
}
constexpr int NWAVES = 8;
constexpr size_t MiB = 1u << 20;
constexpr size_t WS_CTL = 0, CTL_ZERO_BYTES = 1 * MiB;
constexpr size_t WS_MOD = 1 * MiB;
constexpr size_t WS_LOGF = 2 * MiB;
constexpr size_t WS_WIN = 4 * MiB;
constexpr size_t WS_WO = 12 * MiB;
constexpr size_t WS_W1 = 14 * MiB;
constexpr size_t WS_WD = 46 * MiB;
constexpr size_t WS_LIST = 62 * MiB;
constexpr size_t WS_LW = 68 * MiB;
constexpr size_t WS_XN = 80 * MiB;
constexpr size_t WS_AO = 208 * MiB;
constexpr size_t WS_PROJ = 336 * MiB;
constexpr size_t WS_X1 = 784 * MiB;
constexpr size_t WS_END = 912 * MiB;
constexpr int CW_BAR = 4096, CW_CNT = 16384;

constexpr int RING_OFF = 0, RING_BYTES = 155648;
constexpr int LDSCTL_OFF = RING_BYTES, MISC_OFF = LDSCTL_OFF + 64, TAB_OFF = LDSCTL_OFF + 256;
constexpr int LDS_BYTES = RING_BYTES + 1024;
static_assert(hgrn::L_BYTES <= RING_BYTES && attn_body::ATTN_LDS_BYTES <= RING_BYTES && pg8::STAGE_BYTES <= RING_BYTES, "LDS map");

typedef GAS unsigned gu32;
#define RLX_AGENT __ATOMIC_RELAXED, __HIP_MEMORY_SCOPE_AGENT
#define LDS_WAIT() asm volatile("s_waitcnt lgkmcnt(0)" ::: "memory")

#define XB_TMO      128
#define XB_XCNT(j)  (256  + 64 * (j))
#define XB_XSUB(j)  (1280 + 64 * (j))
#define XB_XGEN(j)  (2304 + 64 * (j))
#define XB_TOP      3328
#define XB_TOPGEN   3392
#define XCD_BAR_WORDS 3456
#define XB_SPIN_CAP (1u << 20)
__device__ __forceinline__ unsigned xb_ld(unsigned* p)              { return __hip_atomic_load(p, __ATOMIC_RELAXED, __HIP_MEMORY_SCOPE_AGENT); }
__device__ __forceinline__ unsigned xb_add(unsigned* p, unsigned v) { return __hip_atomic_fetch_add(p, v, __ATOMIC_RELAXED, __HIP_MEMORY_SCOPE_AGENT); }
__device__ __forceinline__ unsigned xb_xcc_id() { return (unsigned)__builtin_amdgcn_s_getreg((3 << 11) | 20) & 0xFu; }
#define XB_SPIN(cond, bar) do { unsigned _sp = 0; while (cond) { __builtin_amdgcn_s_sleep(1); \
    if ((++_sp & 255u) == 0u) { if (xb_ld(&(bar)[XB_TMO])) break; if (_sp > XB_SPIN_CAP) { atomicAdd(&(bar)[XB_TMO], 1u); break; } } } } while (0)
struct XcdBarrier { unsigned* bar; unsigned x; volatile LAS unsigned* st; };
__device__ __forceinline__ XcdBarrier xcd_barrier_post(unsigned* bar, volatile LAS unsigned* st) {
    XcdBarrier b; b.bar = bar; b.x = xb_xcc_id(); b.st = st;
    if (threadIdx.x == 0) (void)xb_add(&bar[XB_XCNT(b.x)], 1u);
    return b;
}
__device__ __forceinline__ void xcd_barrier_complete(unsigned* bar, unsigned x, unsigned& nloc, unsigned& nx) {
    const unsigned G = gridDim.x * gridDim.y * gridDim.z;
    unsigned sum, cnt, mine, sp = 0u;
    for (;;) {
        sum = 0u; cnt = 0u; mine = 0u;
#pragma unroll
        for (unsigned j = 0; j < 16; ++j) { const unsigned c = xb_ld(&bar[XB_XCNT(j)]); sum += c; cnt += (c > 0u) ? 1u : 0u; mine = (j == x) ? c : mine; }
        if (sum == G) break;
        __builtin_amdgcn_s_sleep(1);
        if ((++sp & 255u) == 0u) { if (xb_ld(&bar[XB_TMO])) break; if (sp > XB_SPIN_CAP) { atomicAdd(&bar[XB_TMO], 1u); break; } }
    }
    nloc = mine > 0u ? mine : 1u; nx = cnt > 0u ? cnt : 1u;
}
__device__ __forceinline__ void xcd_barrier(const XcdBarrier& b) {
    asm volatile("s_waitcnt vmcnt(0)" ::: "memory");
    __syncthreads();
    if (threadIdx.x == 0) {
        unsigned* bar = b.bar;
        __builtin_amdgcn_s_waitcnt(0);
        unsigned nloc = b.st[0], nx = b.st[1];
        if (nloc == 0u) { xcd_barrier_complete(bar, b.x, nloc, nx); b.st[0] = nloc; b.st[1] = nx; }
        const unsigned old = xb_add(&bar[XB_XSUB(b.x)], 1u);
        const unsigned gen = old / nloc;
        if (old + 1u == (gen + 1u) * nloc) {
            __builtin_amdgcn_fence(__ATOMIC_RELEASE, "agent");
            asm volatile("s_waitcnt vmcnt(0)" ::: "memory");
            const unsigned og = xb_add(&bar[XB_TOP], 1u);
            const unsigned tg = og / nx;
            if (og + 1u == (tg + 1u) * nx) xb_add(&bar[XB_TOPGEN], 1u);
            else XB_SPIN(xb_ld(&bar[XB_TOPGEN]) == tg, bar);
            __builtin_amdgcn_fence(__ATOMIC_ACQUIRE, "agent");
            xb_add(&bar[XB_XGEN(b.x)], 1u);
            asm volatile("s_waitcnt vmcnt(0)" ::: "memory");
        } else {
            XB_SPIN(xb_ld(&bar[XB_XGEN(b.x)]) == gen, bar);
            __builtin_amdgcn_fence(__ATOMIC_ACQUIRE, "agent");
            asm volatile("s_waitcnt vmcnt(0)" ::: "memory");
        }
    }
    __syncthreads();
}

__device__ __forceinline__ f32x2 lo2(f32x4 v) { return __builtin_shufflevector(v, v, 0, 1); }
__device__ __forceinline__ f32x2 hi2(f32x4 v) { return __builtin_shufflevector(v, v, 2, 3); }
__device__ __forceinline__ f32x2 fma2(f32x2 a, f32x2 b, f32x2 c) { return __builtin_elementwise_fma(a, b, c); }
__device__ __forceinline__ float wave_sum(float v) {
#pragma unroll
    for (int o = 1; o < 64; o <<= 1) v += __shfl_xor(v, o);
    return v;
}
__device__ __forceinline__ unsigned f2bf(float f) { unsigned u = __builtin_bit_cast(unsigned, f); return (u + 0x7fffu + ((u >> 16) & 1u)) >> 16; }
__device__ __forceinline__ unsigned pk2(float lo, float hi) { return f2bf(lo) | (f2bf(hi) << 16); }

__device__ __forceinline__ void transpose_item(const float* W, int ldw, bf16_t* WT, int ldt, LAS float* scr, int lane) {
    float tv[32];
#pragma unroll
    for (int i = 0; i < 32; ++i) tv[i] = W[(size_t)(2 * i + (lane >> 5)) * ldw + (lane & 31)];
#pragma unroll
    for (int i = 0; i < 32; ++i) scr[(2 * i + (lane >> 5)) * 33 + (lane & 31)] = tv[i];
    LDS_WAIT(); asm volatile("" ::: "memory");
    const int c = lane & 7;
#pragma unroll
    for (int j = 0; j < 4; ++j) { const int n = (lane >> 3) + 8 * j; const LAS float* s = scr + (8 * c) * 33 + n;
        u32x4 o; o.x = pk2(s[0 * 33], s[1 * 33]); o.y = pk2(s[2 * 33], s[3 * 33]); o.z = pk2(s[4 * 33], s[5 * 33]); o.w = pk2(s[6 * 33], s[7 * 33]);
        *(GAS u32x4*)(WT + (size_t)n * ldt + 8 * c) = o; }
    LDS_WAIT(); asm volatile("" ::: "memory");
}

__device__ __forceinline__ void transpose_item_fp8(const float* W, int ldw, unsigned char* WT, int ldt, LAS float* scr, int lane, float scale) {
    float tv[32];
#pragma unroll
    for (int i = 0; i < 32; ++i) tv[i] = W[(size_t)(2 * i + (lane >> 5)) * ldw + (lane & 31)];
#pragma unroll
    for (int i = 0; i < 32; ++i) scr[(2 * i + (lane >> 5)) * 33 + (lane & 31)] = tv[i] * scale;
    LDS_WAIT(); asm volatile("" ::: "memory");
    const int c = lane & 3;
#pragma unroll
    for (int j = 0; j < 2; ++j) { const int n = (lane >> 2) + 16 * j; const LAS float* s = scr + (16 * c) * 33 + n;
        u32x4 o; o.x = pg8::pk4_fp8(s[0 * 33], s[1 * 33], s[2 * 33], s[3 * 33]); o.y = pg8::pk4_fp8(s[4 * 33], s[5 * 33], s[6 * 33], s[7 * 33]);
        o.z = pg8::pk4_fp8(s[8 * 33], s[9 * 33], s[10 * 33], s[11 * 33]); o.w = pg8::pk4_fp8(s[12 * 33], s[13 * 33], s[14 * 33], s[15 * 33]);
        *(GAS u32x4*)(WT + (size_t)n * ldt + 16 * c) = o; }
    LDS_WAIT(); asm volatile("" ::: "memory");
}

struct Args { const float* in[21]; float* out; unsigned char* ws; int ph_lo, ph_hi; };

__device__ __forceinline__ void p0_phase(const Args& a, LAS unsigned char* lds, int vcu, int G, int tid_, int lane_, int wave) {
    int tid = tid_; asm volatile("" : "+v"(tid)); const int lane = tid & 63;
    const float* c = a.in[1]; const float* w_ada = a.in[2]; const float* b_ada = a.in[3];
    float* mod = (float*)(a.ws + WS_MOD);
    LAS float* sc = (LAS float*)lds;
    for (int cb = vcu; cb < 6144 / 24; cb += G) {
#pragma unroll 1
        for (int i0 = tid; i0 < BATCH * DMODEL; i0 += 512 * 16) { float cv[16];
#pragma unroll
            for (int u = 0; u < 16; ++u) cv[u] = c[i0 + 512 * u];
#pragma unroll
            for (int u = 0; u < 16; ++u) { const int i = i0 + 512 * u, b = i >> 10, k = i & 1023; sc[k * 36 + b] = siluf_(cv[u]); } }
        __syncthreads();
        const int col = tid % 24, kg = tid / 24;
        float acc[32];
#pragma unroll
        for (int b = 0; b < 32; ++b) acc[b] = 0.f;
        if (kg < 16) {
            const float* wp = w_ada + (size_t)(kg * 64) * 6144 + cb * 24 + col;
            float wv[64];
#pragma unroll
            for (int k = 0; k < 64; ++k) wv[k] = wp[(size_t)k * 6144];
#pragma unroll
            for (int k = 0; k < 64; ++k) { const float w = wv[k]; const LAS f32x4* s4 = (const LAS f32x4*)(sc + (kg * 64 + k) * 36);
#pragma unroll
                for (int q = 0; q < 8; ++q) { const f32x4 s = s4[q]; acc[4 * q] += s[0] * w; acc[4 * q + 1] += s[1] * w; acc[4 * q + 2] += s[2] * w; acc[4 * q + 3] += s[3] * w; } }
        }
        __syncthreads();
        LAS float* red = (LAS float*)lds;
        if (kg < 16) {
#pragma unroll
            for (int b = 0; b < 32; ++b) red[(kg * 32 + b) * 24 + col] = acc[b]; }
        __syncthreads();
        for (int o = tid; o < 32 * 24; o += 512) { const int b = o / 24, cc = o % 24; float s = 0.f;
#pragma unroll
            for (int g = 0; g < 16; ++g) s += red[(g * 32 + b) * 24 + cc];
            mod[(size_t)b * 6144 + cb * 24 + cc] = s + b_ada[cb * 24 + cc]; }
        __syncthreads();
    }
}

constexpr int W_I_IN = 16 * 112, W_I_OUT = 16 * 32, W_I_G = 16 * 256, W_I_U = 16 * 256, W_I_D = 16 * 256, W_ITEMS = W_I_IN + W_I_OUT + W_I_G + W_I_U + W_I_D;
__device__ __forceinline__ void weight_item(const Args& a, int it, LAS float* scr, int lane_) {
    int lane = lane_; asm volatile("" : "+v"(lane));
    const float* W; int ldw, ldt; unsigned char* dst; bool f8;
    int r = it;
    if (r < W_I_IN) { const int kb = r / 112, db = r % 112, sc0 = db * 32 + (db >= 48 ? 8 : 0);
        W = a.in[5] + (size_t)(64 * kb) * INW + sc0; ldw = INW; dst = a.ws + WS_WIN + ((size_t)(db * 32) * 1024 + 64 * kb) * 2; ldt = 2048; f8 = false; }
    else if ((r -= W_I_IN) < W_I_OUT) { const int kb = r / 32, nb = r % 32;
        W = a.in[12] + (size_t)(64 * kb) * 1024 + 32 * nb; ldw = 1024; dst = a.ws + WS_WO + ((size_t)(32 * nb) * 1024 + 64 * kb) * 2; ldt = 2048; f8 = false; }
    else if ((r -= W_I_OUT) < W_I_G + W_I_U) { const bool up = r >= W_I_G; if (up) r -= W_I_G; const int e = r / 256, q = r % 256, kb = q / 16, nb = q % 16;
        W = (up ? a.in[19] : a.in[18]) + (size_t)e * 1024 * 512 + (size_t)(64 * kb) * 512 + 32 * nb; ldw = 512; dst = a.ws + WS_W1 + ((size_t)e * 1024 + (up ? 512 : 0) + 32 * nb) * 1024 + 64 * kb; ldt = 1024; f8 = true; }
    else { r -= W_I_G + W_I_U; const int e = r / 256, q = r % 256, kb = q / 32, nb = q % 32;
        W = a.in[20] + (size_t)e * 512 * 1024 + (size_t)(64 * kb) * 1024 + 32 * nb; ldw = 1024; dst = a.ws + WS_WD + ((size_t)e * 1024 + 32 * nb) * 512 + 64 * kb; ldt = 512; f8 = true; }
    const float scale = f8 ? W_SCALE : 1.0f;
    const float* wp = W + (size_t)(lane >> 5) * ldw + (lane & 31);
#pragma unroll
    for (int hh = 0; hh < 2; ++hh) { float tv[16];
#pragma unroll
        for (int i = 0; i < 16; ++i) tv[i] = wp[(size_t)(2 * (16 * hh + i)) * ldw];
#pragma unroll
        for (int i = 0; i < 16; ++i) scr[(2 * (16 * hh + i) + (lane >> 5)) * 33 + (lane & 31)] = tv[i] * scale; }
    LDS_WAIT(); asm volatile("" ::: "memory");
    if (f8) { const int c = lane & 3;
#pragma unroll
        for (int j = 0; j < 2; ++j) { const int n = (lane >> 2) + 16 * j; const LAS float* sp = scr + (16 * c) * 33 + n;
            u32x4 o; o.x = pg8::pk4_fp8(sp[0 * 33], sp[1 * 33], sp[2 * 33], sp[3 * 33]); o.y = pg8::pk4_fp8(sp[4 * 33], sp[5 * 33], sp[6 * 33], sp[7 * 33]);
            o.z = pg8::pk4_fp8(sp[8 * 33], sp[9 * 33], sp[10 * 33], sp[11 * 33]); o.w = pg8::pk4_fp8(sp[12 * 33], sp[13 * 33], sp[14 * 33], sp[15 * 33]);
            *(GAS u32x4*)(dst + (size_t)n * ldt + 16 * c) = o; } }
    else { const int c = lane & 7;
#pragma unroll
        for (int j = 0; j < 4; ++j) { const int n = (lane >> 3) + 8 * j; const LAS float* sp = scr + (8 * c) * 33 + n;
            u32x4 o; o.x = pk2(sp[0 * 33], sp[1 * 33]); o.y = pk2(sp[2 * 33], sp[3 * 33]); o.z = pk2(sp[4 * 33], sp[5 * 33]); o.w = pk2(sp[6 * 33], sp[7 * 33]);
            *(GAS u32x4*)(dst + (size_t)n * ldt + 16 * c) = o; } }
    LDS_WAIT(); asm volatile("" ::: "memory");
}

__device__ __forceinline__ void reduce_scatter16(float (&v)[16], int lane) {
    { const bool hi = lane & 32;
#pragma unroll
      for (int i = 0; i < 8; ++i) { const float snd = hi ? v[i] : v[8 + i], kp = hi ? v[8 + i] : v[i]; v[i] = kp + __shfl_xor(snd, 32); } }
    { const bool hi = lane & 16;
#pragma unroll
      for (int i = 0; i < 4; ++i) { const float snd = hi ? v[i] : v[4 + i], kp = hi ? v[4 + i] : v[i]; v[i] = kp + __shfl_xor(snd, 16); } }
    { const bool hi = lane & 8;
#pragma unroll
      for (int i = 0; i < 2; ++i) { const float snd = hi ? v[i] : v[2 + i], kp = hi ? v[2 + i] : v[i]; v[i] = kp + __shfl_xor(snd, 8); } }
    { const bool hi = lane & 4; const float snd = hi ? v[0] : v[1], kp = hi ? v[1] : v[0]; v[0] = kp + __shfl_xor(snd, 4); }
    v[0] += __shfl_xor(v[0], 2); v[0] += __shfl_xor(v[0], 1);
}
__device__ __forceinline__ void reduce_scatter4(float (&v)[4], int lane) {
    { const bool hi = lane & 32;
#pragma unroll
      for (int i = 0; i < 2; ++i) { const float snd = hi ? v[i] : v[2 + i], kp = hi ? v[2 + i] : v[i]; v[i] = kp + __shfl_xor(snd, 32); } }
    { const bool hi = lane & 16; const float snd = hi ? v[0] : v[1], kp = hi ? v[1] : v[0]; v[0] = kp + __shfl_xor(snd, 16); }
#pragma unroll
    for (int o = 8; o > 0; o >>= 1) v[0] += __shfl_xor(v[0], o);
}
__device__ __forceinline__ void p1_phase(const Args& a, LAS unsigned char* lds, int vcu, int G, int tid_, int lane_, int wave) {
    int tid = tid_; asm volatile("" : "+v"(tid)); const int lane = tid & 63;
    const float* x = a.in[0]; const float* g1 = a.in[4]; const float* w_in = a.in[5]; const float* b_fox = a.in[6];
    const float* mod = (const float*)(a.ws + WS_MOD); float* logf = (float*)(a.ws + WS_LOGF); bf16_t* XN = (bf16_t*)(a.ws + WS_XN);
    LAS float* wf = (LAS float*)lds;
    LAS float* zs = (LAS float*)(lds + 32768) + wave * 256;
    LAS float* scr = (LAS float*)(lds + 40960 + wave * 8448);
    int witem = vcu * NWAVES + wave;
    for (int k = tid; k < 1024; k += 512) { const f32x4 u0 = *(const f32x4*)(w_in + (size_t)k * INW + 1536), u1 = *(const f32x4*)(w_in + (size_t)k * INW + 1540);
#pragma unroll
        for (int h = 0; h < 4; ++h) { wf[h * 1024 + k] = u0[h]; wf[(4 + h) * 1024 + k] = u1[h]; } }
    __syncthreads();
    for (int gw = vcu * NWAVES + wave; gw < MTOK / 32; gw += G * NWAVES) {
        const int row0 = gw * 32, b = row0 >> 11;
        f32x4 A1[4], B1[4];
#pragma unroll
        for (int j = 0; j < 4; ++j) { const int cidx = 4 * lane + 256 * j; const f32x4 g = *(const f32x4*)(g1 + cidx), s = *(const f32x4*)(mod + (size_t)b * 6144 + 1024 + cidx);
            A1[j] = g * (s + 1.0f); B1[j] = *(const f32x4*)(mod + (size_t)b * 6144 + cidx); }
        const float* xp = x + (size_t)row0 * DMODEL + 4 * lane;
        f32x4 va[2][4], vb[2][4];
#define P1_LOAD(buf, rp) do { _Pragma("unroll") for (int q = 0; q < 2; ++q) _Pragma("unroll") for (int j = 0; j < 4; ++j) buf[q][j] = *(const f32x4*)(xp + (size_t)(2 * (rp) + q) * DMODEL + 256 * j); } while (0)
#define P1_BODY(buf, itx) do { const int r0 = row0 + 2 * (itx); float ss[2] = {0.f, 0.f}; f32x4 v[2][4]; \
            _Pragma("unroll") for (int q = 0; q < 2; ++q) { f32x2 s2 = {0.f, 0.f}; _Pragma("unroll") for (int j = 0; j < 4; ++j) { s2 = fma2(lo2(buf[q][j]), lo2(buf[q][j]), s2); s2 = fma2(hi2(buf[q][j]), hi2(buf[q][j]), s2); } ss[q] = s2.x + s2.y; } \
            _Pragma("unroll") for (int q = 0; q < 2; ++q) { const float rstd = __builtin_amdgcn_rsqf(wave_sum(ss[q]) * (1.0f / DMODEL) + NORM_EPS); \
                _Pragma("unroll") for (int j = 0; j < 4; ++j) { v[q][j] = buf[q][j] * rstd * A1[j] + B1[j]; \
                    *(u32x2*)(XN + (size_t)(r0 + q) * DMODEL + 4 * lane + 256 * j) = (u32x2){cvt_pk_bf16(v[q][j][0], v[q][j][1]), cvt_pk_bf16(v[q][j][2], v[q][j][3])}; } } \
            if ((itx) + 2 < 16) P1_LOAD(buf, (itx) + 2); \
            float af[16]; \
            _Pragma("unroll") for (int h = 0; h < 8; ++h) { f32x2 s0 = {0.f, 0.f}, s1 = {0.f, 0.f}; \
                _Pragma("unroll") for (int j = 0; j < 4; ++j) { const f32x4 w = *(const LAS f32x4*)(wf + h * 1024 + 4 * lane + 256 * j); \
                    s0 = fma2(lo2(v[0][j]), lo2(w), s0); s0 = fma2(hi2(v[0][j]), hi2(w), s0); \
                    s1 = fma2(lo2(v[1][j]), lo2(w), s1); s1 = fma2(hi2(v[1][j]), hi2(w), s1); } \
                af[h] = s0.x + s0.y; af[8 + h] = s1.x + s1.y; } \
            reduce_scatter16(af, lane); \
            if ((lane & 3) == 0) zs[(2 * (itx)) * 8 + (lane >> 2)] = af[0]; } while (0)
        P1_LOAD(va, 0); P1_LOAD(vb, 1);
#define P1_WITEM() do { if (witem < W_ITEMS) { weight_item(a, witem, scr, lane); witem += G * NWAVES; } } while (0)
#pragma unroll 1
        for (int it = 0; it < 16; it += 2) { P1_BODY(va, it); P1_BODY(vb, it + 1); P1_WITEM(); }
#undef P1_WITEM
#undef P1_LOAD
#undef P1_BODY
#pragma unroll
        for (int e = 0; e < 4; ++e) { const int idx = lane + 64 * e; const float z = zs[idx] + b_fox[idx & 7];
            logf[(size_t)row0 * AH + idx] = fminf(z, 0.f) - __builtin_amdgcn_logf(1.0f + __builtin_amdgcn_exp2f(-fabsf(z) * LOG2E)) * 0.6931471805599453f; }
    }
    for (; witem < W_ITEMS; witem += G * NWAVES) weight_item(a, witem, scr, lane);
}

__device__ __forceinline__ void p5_phase(const Args& a, LAS unsigned char* lds, int vcu, int G, int tid_, int lane_, int wave) {
    int tid = tid_; asm volatile("" : "+v"(tid)); const int lane = tid & 63, fr = lane & 15, fq = lane >> 4;
    const bf16_t* x1 = (const bf16_t*)(a.ws + WS_X1); const float* g2 = a.in[13]; const float* w_rg = a.in[14]; const float* b_rg = a.in[15]; const float* w_re = a.in[16]; const float* b_re = a.in[17];
    const float* mod = (const float*)(a.ws + WS_MOD); unsigned char* XN8 = a.ws + WS_XN;
    int* list = (int*)(a.ws + WS_LIST); f32x2* lw = (f32x2*)(a.ws + WS_LW); unsigned* gcnt = (unsigned*)(a.ws + WS_CTL) + CW_CNT;
    constexpr int WROW = 2064;
    LAS unsigned char* wth = lds; LAS unsigned char* wtl = lds + 20 * WROW;
    LAS float* ab = (LAS float*)(lds + 40 * WROW);
    LAS float* bias = (LAS float*)(lds + 40 * WROW + 8192);
    LAS int* hist = (LAS int*)(lds + 40 * WROW + 8192 + 128);
    LAS float* zs = (LAS float*)(lds + 40 * WROW + 8192 + 128 + 256) + wave * (32 * 20);
    for (int k = tid; k < 1024; k += 512) { const f32x4 g4 = *(const f32x4*)(w_rg + 4 * k);
#pragma unroll
        for (int o = 0; o < 20; ++o) { float wv; if (o < 4) wv = g4[o]; else { const f32x4 e4 = *(const f32x4*)(w_re + 16 * k + 4 * ((o - 4) >> 2)); wv = e4[(o - 4) & 3]; }
            const unsigned hb = f2bf(wv); const float hf = __uint_as_float(hb << 16); const unsigned lb = f2bf(wv - hf);
            *(LAS unsigned short*)(wth + o * WROW + 2 * k) = (unsigned short)hb; *(LAS unsigned short*)(wtl + o * WROW + 2 * k) = (unsigned short)lb; } }
    if (tid < 4) bias[tid] = b_rg[tid]; else if (tid < 20) bias[tid] = b_re[tid - 4];
    for (int gw0 = vcu * NWAVES; gw0 < MTOK / 32; gw0 += G * NWAVES) {
        const int gw = gw0 + wave, row0 = gw * 32, b = (gw0 * 32) >> 11;
        __syncthreads();
        if (tid < 64) hist[tid] = 0;
        for (int k = tid; k < 1024; k += 512) { ab[k] = g2[k] * (1.0f + mod[(size_t)b * 6144 + 4096 + k]); ab[1024 + k] = mod[(size_t)b * 6144 + 3072 + k]; }
        __syncthreads();
#pragma unroll 1
        for (int grp = 0; grp < 2; ++grp) {
            const int row = row0 + 16 * grp + fr;
            const bf16_t* xp = x1 + (size_t)row * DMODEL + 8 * fq;
            float ss = 0.f;
#pragma unroll 8
            for (int s_ = 0; s_ < 32; ++s_) { const u32x4 xv = *(const u32x4*)(xp + 32 * s_); const unsigned wd[4] = {xv.x, xv.y, xv.z, xv.w};
#pragma unroll
                for (int j = 0; j < 4; ++j) { const float p = bf_lo(wd[j]), q = bf_hi(wd[j]); ss = __builtin_fmaf(p, p, ss); ss = __builtin_fmaf(q, q, ss); } }
            ss += __shfl_xor(ss, 16); ss += __shfl_xor(ss, 32);
            const float rstd = __builtin_amdgcn_rsqf(ss * (1.0f / DMODEL) + NORM_EPS);
            f32x4 acc0 = {0.f, 0.f, 0.f, 0.f}, acc1 = {0.f, 0.f, 0.f, 0.f};
            unsigned char* xo = XN8 + (size_t)row * DMODEL + 8 * fq;
            const LAS unsigned char* wp0 = wth + fr * WROW + 16 * fq; const LAS unsigned char* wp1 = wth + (16 + (fr & 3)) * WROW + 16 * fq;
            const LAS float* abp = ab + 8 * fq;
#pragma unroll 4
            for (int s_ = 0; s_ < 32; ++s_) {
                const u32x4 xv = *(const u32x4*)(xp + 32 * s_); const unsigned wd[4] = {xv.x, xv.y, xv.z, xv.w};
                const f32x4 a0 = *(const LAS f32x4*)(abp + 32 * s_), a1 = *(const LAS f32x4*)(abp + 32 * s_ + 4);
                const f32x4 b0 = *(const LAS f32x4*)(abp + 1024 + 32 * s_), b1 = *(const LAS f32x4*)(abp + 1024 + 32 * s_ + 4);
                float h[8];
                h[0] = __builtin_fmaf(bf_lo(wd[0]) * rstd, a0[0], b0[0]); h[1] = __builtin_fmaf(bf_hi(wd[0]) * rstd, a0[1], b0[1]);
                h[2] = __builtin_fmaf(bf_lo(wd[1]) * rstd, a0[2], b0[2]); h[3] = __builtin_fmaf(bf_hi(wd[1]) * rstd, a0[3], b0[3]);
                h[4] = __builtin_fmaf(bf_lo(wd[2]) * rstd, a1[0], b1[0]); h[5] = __builtin_fmaf(bf_hi(wd[2]) * rstd, a1[1], b1[1]);
                h[6] = __builtin_fmaf(bf_lo(wd[3]) * rstd, a1[2], b1[2]); h[7] = __builtin_fmaf(bf_hi(wd[3]) * rstd, a1[3], b1[3]);
                *(u32x2*)(xo + 32 * s_) = (u32x2){pg8::pk4_fp8(h[0] * XN2_SCALE, h[1] * XN2_SCALE, h[2] * XN2_SCALE, h[3] * XN2_SCALE), pg8::pk4_fp8(h[4] * XN2_SCALE, h[5] * XN2_SCALE, h[6] * XN2_SCALE, h[7] * XN2_SCALE)};
                const unsigned t0 = cvt_pk_bf16(h[0], h[1]), t1 = cvt_pk_bf16(h[2], h[3]), t2 = cvt_pk_bf16(h[4], h[5]), t3 = cvt_pk_bf16(h[6], h[7]);
                const u32x4 hw = (u32x4){t0, t1, t2, t3};
                const u32x4 lwv = (u32x4){cvt_pk_bf16(h[0] - bf_lo(t0), h[1] - bf_hi(t0)), cvt_pk_bf16(h[2] - bf_lo(t1), h[3] - bf_hi(t1)), cvt_pk_bf16(h[4] - bf_lo(t2), h[5] - bf_hi(t2)), cvt_pk_bf16(h[6] - bf_lo(t3), h[7] - bf_hi(t3))};
                const bf16x8 Ah = __builtin_bit_cast(bf16x8, hw), Al = __builtin_bit_cast(bf16x8, lwv);
                const bf16x8 wh0 = *(const LAS bf16x8*)(wp0 + 64 * s_), wl0 = *(const LAS bf16x8*)(wp0 + 20 * WROW + 64 * s_);
                const bf16x8 wh1 = *(const LAS bf16x8*)(wp1 + 64 * s_), wl1 = *(const LAS bf16x8*)(wp1 + 20 * WROW + 64 * s_);
                acc0 = __builtin_amdgcn_mfma_f32_16x16x32_bf16(wh0, Ah, acc0, 0, 0, 0); acc0 = __builtin_amdgcn_mfma_f32_16x16x32_bf16(wh0, Al, acc0, 0, 0, 0); acc0 = __builtin_amdgcn_mfma_f32_16x16x32_bf16(wl0, Ah, acc0, 0, 0, 0);
                acc1 = __builtin_amdgcn_mfma_f32_16x16x32_bf16(wh1, Ah, acc1, 0, 0, 0); acc1 = __builtin_amdgcn_mfma_f32_16x16x32_bf16(wh1, Al, acc1, 0, 0, 0); acc1 = __builtin_amdgcn_mfma_f32_16x16x32_bf16(wl1, Ah, acc1, 0, 0, 0);
            }
            *(LAS f32x4*)(zs + (16 * grp + fr) * 20 + 4 * fq) = acc0;
            if (fq == 0) *(LAS f32x4*)(zs + (16 * grp + fr) * 20 + 16) = acc1;
        }
        int my_cls = 0; float my_wlo = 0.f, my_whi = 0.f;
        if (lane < 32) {
            float lg[20];
#pragma unroll
            for (int o = 0; o < 20; ++o) lg[o] = zs[lane * 20 + o] + bias[o];
            int gi = 0; float gm = lg[0];
#pragma unroll
            for (int o = 1; o < 4; ++o) if (lg[o] > gm) { gm = lg[o]; gi = o; }
            float gs = 0.f;
#pragma unroll
            for (int o = 0; o < 4; ++o) gs += __expf(lg[o] - gm);
            const float gp = 1.0f / gs;
            float el[4];
#pragma unroll
            for (int j = 0; j < 4; ++j) el[j] = gi == 0 ? lg[4 + j] : (gi == 1 ? lg[8 + j] : (gi == 2 ? lg[12 + j] : lg[16 + j]));
            int i1 = 0; float m1 = el[0];
#pragma unroll
            for (int j = 1; j < 4; ++j) if (el[j] > m1) { m1 = el[j]; i1 = j; }
            int i2 = -1; float m2 = -INFINITY;
#pragma unroll
            for (int j = 0; j < 4; ++j) if (j != i1 && el[j] > m2) { m2 = el[j]; i2 = j; }
            const float w1 = gp / (1.0f + __expf(m2 - m1)), w2 = gp - w1;
            const int lo = i1 < i2 ? i1 : i2, hi = i1 < i2 ? i2 : i1;
            my_wlo = i1 < i2 ? w1 : w2; my_whi = i1 < i2 ? w2 : w1;
            my_cls = gi * 6 + (lo == 0 ? hi - 1 : (lo == 1 ? hi + 1 : 5));
        }
        int rank = 0;
        if (lane < 32) rank = __hip_atomic_fetch_add(&hist[my_cls], 1, __ATOMIC_RELAXED, __HIP_MEMORY_SCOPE_WORKGROUP);
        __syncthreads();
        if (tid < NCLS) hist[32 + tid] = (int)__hip_atomic_fetch_add(gcnt + tid, (unsigned)hist[tid], __ATOMIC_RELAXED, __HIP_MEMORY_SCOPE_AGENT);
        __syncthreads();
        if (lane < 32) { const size_t pos = (size_t)my_cls * MTOK + hist[32 + my_cls] + rank; list[pos] = row0 + lane; lw[pos] = (f32x2){my_wlo, my_whi}; }
    }
}
__global__ void __launch_bounds__(NWAVES * 64, 2) layer_fwd(Args args) {
    extern __shared__ __attribute__((aligned(16))) unsigned char lds_raw[];
    LAS unsigned char* lds = (LAS unsigned char*)lds_raw;
    const int tid = threadIdx.x, lane = tid & 63, wave = __builtin_amdgcn_readfirstlane(tid >> 6);
    const int G = gridDim.x, bx = blockIdx.x;
    const int vcu = (G % 8 == 0) ? (bx % 8) * (G / 8) + bx / 8 : bx;
    unsigned char* ws = args.ws;
    gu32* ctl = (gu32*)(ws + WS_CTL);
    for (int u = tid; u < (LDS_BYTES - LDSCTL_OFF) / 4; u += NWAVES * 64) ((LAS unsigned*)(lds + LDSCTL_OFF))[u] = 0u;
    __syncthreads();
    volatile LAS unsigned* MISC = (volatile LAS unsigned*)(lds + MISC_OFF);
    XcdBarrier bar; bar.bar = (unsigned*)(ctl + CW_BAR); bar.x = 0; bar.st = nullptr;
    const int lo = args.ph_lo, hi = args.ph_hi;
    const bool one = (hi - lo) > 1;
    if (one) bar = xcd_barrier_post((unsigned*)(ctl + CW_BAR), MISC + 8);
#ifndef PH_MASK
#define PH_MASK 0xff
#endif
#ifndef REP_HGRN
#define REP_HGRN 1
#endif
#ifndef REP_ATTN
#define REP_ATTN 1
#endif
#ifndef REP_P2
#define REP_P2 1
#endif
#ifndef REP_P4
#define REP_P4 1
#endif
#ifndef REP_P6
#define REP_P6 1
#endif
#ifndef REP_P0
#define REP_P0 1
#endif
#ifndef REP_P1
#define REP_P1 1
#endif
#define IN(k) (((PH_MASK >> (k)) & 1) && lo <= (k) && (k) < hi)
#define SEAM(k) do { if (IN(k) && IN((k) + 1)) xcd_barrier(bar); } while (0)

    const bf16_t* WinT = (const bf16_t*)(ws + WS_WIN); const bf16_t* WoT = (const bf16_t*)(ws + WS_WO); const unsigned char* W1T = ws + WS_W1; const unsigned char* WdT = ws + WS_WD;
    bf16_t* XN = (bf16_t*)(ws + WS_XN); bf16_t* AO = (bf16_t*)(ws + WS_AO); bf16_t* PROJ = (bf16_t*)(ws + WS_PROJ); unsigned char* ACT = ws + WS_PROJ;
    const float* mod = (const float*)(ws + WS_MOD);

    if (IN(0)) { for (int rep = 0; rep < REP_P0; ++rep) { p0_phase(args, lds, vcu, G, tid, lane, wave); __syncthreads(); } }
    SEAM(0);
    if (IN(1)) { for (int rep = 0; rep < REP_P1; ++rep) { p1_phase(args, lds, vcu, G, tid, lane, wave); __syncthreads(); } }
    SEAM(1);
    if (IN(2)) {
        pg8::ProjPol S; S.A = (const char*)XN; S.Bt = (const char*)WinT; S.lda = 2048; S.ldb = 2048; S.hstepB = 32 * 2048; S.ks = 16; S.nN = 14; S.G = G; S.c = bx; S.bt_tile_rows = 256;
        pg8::EpiProj E{PROJ, args.in[7], args.in[8], args.in[10]};
        for (int rep = 0; rep < REP_P2; ++rep) pg8::gemm_phase(lds + RING_OFF, S, E);
    }
    SEAM(2);
    if (IN(3)) {
        const bool part = (G == 256);
        const int pp = bx >> 1, role = bx & 1;
#ifndef NO_HGRN
        for (int rep = 0; rep < REP_HGRN; ++rep) {
            if (part) { if (role == 0) hgrn::hgrn_unit(pp / HH, pp % HH, PROJ, AO, args.in[11], lds + RING_OFF); }
            else for (int u = bx; u < BATCH * HH; u += G) hgrn::hgrn_unit(u / HH, u % HH, PROJ, AO, args.in[11], lds + RING_OFF);
        }
#ifdef SHADOW_HGRN
        if (part && role == 0) hgrn::hgrn_unit<SHADOW_HGRN>(pp / HH, pp % HH, PROJ, (bf16_t*)(ws + WS_LIST), args.in[11], lds + RING_OFF);
#endif
        __syncthreads();
#endif
#ifndef NO_ATTN
        for (int rep = 0; rep < REP_ATTN; ++rep) {
            const int nun = part ? (role ? 12 : 4) : 8 * ((BATCH * AH - vcu + G - 1) / G);
            int cur_bh = -1; float m0l = 0.f;
            for (int i = 0; i < nun; ++i) {
                int bh, qb;
                if (part) { if (role) { bh = i < 8 ? 2 * pp : 2 * pp + 1; qb = i < 8 ? 7 - i : (i == 8 ? 7 : (i == 9 ? 6 : 11 - i)); } else { bh = 2 * pp + 1; qb = 5 - i; } }
                else { bh = vcu + (i >> 3) * G; qb = 7 - (i & 7); }
                bool fresh = false;
                if (bh != cur_bh) { __syncthreads(); m0l = attn_body::attn_prep(bh / AH, bh % AH, (const float*)(ws + WS_LOGF), args.in[7], args.in[8], args.in[9], (char*)lds_raw + RING_OFF); cur_bh = bh; fresh = true; }
                int nbh = -1;
                if (i + 1 < nun) { if (part) nbh = role ? (i + 1 < 8 ? 2 * pp : 2 * pp + 1) : 2 * pp + 1; else nbh = vcu + ((i + 1) >> 3) * G; }
                attn_body::attn_unit(bh / AH, bh % AH, qb, (const attn_body::bf16*)PROJ, (attn_body::bf16*)AO, m0l, (char*)lds_raw + RING_OFF, !fresh, nbh == bh);
            }
            __syncthreads();
        }
#endif
    }
    SEAM(3);
    if (IN(4)) {
        pg8::PlainPol S; S.A = (const char*)AO; S.Bt = (const char*)WoT; S.lda = 2048; S.ldb = 2048; S.hstepB = 128 * 2048; S.ks = 16; S.nN = 4; S.G = G; S.c = bx; S.bt_tile_rows = 256;
        pg8::EpiRes E{args.in[0], (bf16_t*)(ws + WS_X1), mod + 2048};
        for (int rep = 0; rep < REP_P4; ++rep) pg8::gemm_phase(lds + RING_OFF, S, E);
    }
    SEAM(4);
#ifndef REP_P5
#define REP_P5 1
#endif
    if (IN(5)) { for (int rep = 0; rep < REP_P5; ++rep) { if (rep) { xcd_barrier(bar); if (bx == 0 && tid < NCLS) __hip_atomic_store(ctl + CW_CNT + tid, 0u, RLX_AGENT); xcd_barrier(bar); } p5_phase(args, lds, vcu, G, tid, lane, wave); } }
    SEAM(5);
    LAS int* tab = (LAS int*)(lds + TAB_OFF);
    if (IN(6) || IN(7)) {
        if (tid < NCLS) tab[tid] = (int)__hip_atomic_load(ctl + CW_CNT + tid, RLX_AGENT);
        __syncthreads();
        if (tid == 0) { int p = 0; for (int c = 0; c < NCLS; ++c) { tab[32 + c] = p; p += (tab[c] + 255) >> 8; } tab[32 + NCLS] = p; }
        __syncthreads();
    }
    const pg8::MoeTab mt{tab};
    if (IN(6)) {
        pg8::Moe1Pol S; S.A = (const char*)XN; S.W1T = (const char*)W1T; S.list = (const int*)(ws + WS_LIST); S.tab = mt; S.lda = 1024; S.ldb = 1024; S.hstepB = 512 * 1024; S.ks = 8; S.G = G; S.c = bx; S.sclW = SCL_W; S.sclX = SCL_XN2;
        pg8::EpiSwiglu E{ACT, (const float*)(ws + WS_LW), mt};
        for (int rep = 0; rep < REP_P6; ++rep) pg8::gemm_phase(lds + RING_OFF, S, E);
#ifdef SHADOW_P6
        { pg8::EpiSwiglu E2{ws + WS_AO, (const float*)(ws + WS_LW), mt}; pg8::gemm_phase<pg8::Moe1Pol, pg8::EpiSwiglu, SHADOW_P6>(lds + RING_OFF, S, E2); }
#endif
    }
    SEAM(6);
    if (IN(7)) {
        pg8::Moe2Pol S; S.A = (const char*)ACT; S.WdT = (const char*)WdT; S.tab = mt; S.lda = 1024; S.ldb = 512; S.hstepB = 128 * 512; S.ks = 4; S.G = G; S.c = bx; S.sclW = SCL_W; S.sclX = SCL_ACT;
        pg8::EpiMoeOut E{args.out, (const bf16_t*)(ws + WS_X1), mod + 5120, (const int*)(ws + WS_LIST), mt};
#ifndef REP_P7
#define REP_P7 1
#endif
        for (int rep = 0; rep < REP_P7; ++rep) pg8::gemm_phase(lds + RING_OFF, S, E);
    }
#ifdef DIAG
    if (lo <= 8 && 8 < hi) {
        for (size_t i = (size_t)bx * 512 + tid; i < (size_t)MTOK * 1024; i += (size_t)G * 512) {
            const size_t row = i >> 10, c = i & 1023; float v;
            if (DIAG == 1) v = bf_lo((unsigned)XN[i]);
            else if (DIAG == 2) v = bf_lo((unsigned)PROJ[row * PW + c]) + bf_lo((unsigned)PROJ[row * PW + 1024 + c]) + bf_lo((unsigned)PROJ[row * PW + 2048 + c]) + bf_lo((unsigned)PROJ[row * PW + 2560 + c]);
            else if (DIAG == 3) v = bf_lo((unsigned)AO[i]);
            else if (DIAG == 4) v = bf_lo((unsigned)((const bf16_t*)(ws + WS_X1))[i]);
            else v = args.in[0][i];
            args.out[i] = v;
        }
    }
#endif
#undef IN
#undef SEAM
}

#ifndef MK_PER_PHASE
#define MK_PER_PHASE 0
#endif
extern "C" void kernel_launch(void* const* d_in, const int* in_sizes, int n_in, void* d_out, int out_size, void* d_ws, size_t ws_size, hipStream_t stream) {
    static int grid = 0;
    if (grid == 0) {
        if (n_in != 21 || in_sizes[0] != MTOK * DMODEL || out_size != MTOK * DMODEL || ws_size < WS_END) { fprintf(stderr, "kernel_launch: unexpected shapes (n_in %d, in0 %d, out %d, ws %zu); nothing launched\n", n_in, n_in > 0 ? in_sizes[0] : -1, out_size, ws_size); grid = -1; return; }
        int dev = 0, cus = 0, per_cu = 0;
        if (hipGetDevice(&dev) != hipSuccess || hipDeviceGetAttribute(&cus, hipDeviceAttributeMultiprocessorCount, dev) != hipSuccess) { grid = -1; return; }
        if (hipFuncSetAttribute((const void*)layer_fwd, hipFuncAttributeMaxDynamicSharedMemorySize, LDS_BYTES) != hipSuccess) { fprintf(stderr, "kernel_launch: hipFuncSetAttribute failed\n"); grid = -1; return; }
        if (hipOccupancyMaxActiveBlocksPerMultiprocessor(&per_cu, (const void*)layer_fwd, NWAVES * 64, LDS_BYTES) != hipSuccess || per_cu < 1) { fprintf(stderr, "kernel_launch: occupancy query says %d workgroups per CU\n", per_cu); per_cu = 1; }
        (void)hipGetLastError();
        grid = cus;
    }
    if (grid < 0) return;
    (void)hipMemsetAsync((char*)d_ws + WS_CTL, 0, CTL_ZERO_BYTES, stream);
    Args a{};
    for (int i = 0; i < 21; ++i) a.in[i] = (const float*)d_in[i];
    a.out = (float*)d_out; a.ws = (unsigned char*)d_ws;
#if MK_PER_PHASE
    for (int p = 0; p < 9; ++p) { a.ph_lo = p; a.ph_hi = p + 1; hipLaunchKernelGGL(layer_fwd, dim3(grid), dim3(NWAVES * 64), LDS_BYTES, stream, a); }
#else
#ifdef DIAG
    a.ph_lo = 0; a.ph_hi = 9;
#else
    a.ph_lo = 0; a.ph_hi = 8;
#endif
    hipLaunchKernelGGL(layer_fwd, dim3(grid), dim3(NWAVES * 64), LDS_BYTES, stream, a);
#endif
    const hipError_t le = hipPeekAtLastError();
    if (le != hipSuccess) fprintf(stderr, "kernel_launch: launch failed: %s\n", hipGetErrorName(le));
}
```

```cpp
#include <hip/hip_runtime.h>
#include <hip/hip_bf16.h>
#include <cstdio>
#include <cstdint>
#include <cmath>

#define LAS __attribute__((address_space(3)))
#define GAS __attribute__((address_space(1)))
typedef unsigned short bf16_t;
typedef short bf16x8 __attribute__((ext_vector_type(8)));
typedef short s16x4 __attribute__((ext_vector_type(4)));
typedef float f32x4 __attribute__((ext_vector_type(4)));
typedef float f32x2 __attribute__((ext_vector_type(2)));
typedef float f32x16 __attribute__((ext_vector_type(16)));
typedef unsigned u32x4 __attribute__((ext_vector_type(4)));
typedef unsigned u32x2 __attribute__((ext_vector_type(2)));
typedef _Float16 h16x2 __attribute__((ext_vector_type(2)));

constexpr int BATCH = 32, SEQ = 2048, DMODEL = 1024, MTOK = BATCH * SEQ;
constexpr int AH = 8, AD = 64, AW = 512, HH = 4, HK = 128, HW = 512;
constexpr int INW = 3 * AW + AH + 4 * HW;
constexpr int PW = 3584;
constexpr int PC_Q = 0, PC_K = 512, PC_V = 1024, PC_HQ = 1536, PC_HG = 2048, PC_HV = 2560, PC_HO = 3072;
constexpr int NEXP = 16, DEXP = 512, NCLS = 24;
constexpr float NORM_EPS = 1e-6f;
constexpr float LOG2E = 1.4426950408889634f;
constexpr float QSCALE = 0.125f * LOG2E;
constexpr float W_SCALE = 32.0f, XN2_SCALE = 4.0f, ACT_SCALE = 16.0f;
constexpr int SCL_W = 0x7A7A7A7A, SCL_XN2 = 0x7D7D7D7D, SCL_ACT = 0x7B7B7B7B;

typedef __bf16 bf16x2_nat __attribute__((ext_vector_type(2)));
__device__ __forceinline__ unsigned cvt_pk_bf16(float lo, float hi) { f32x2 v = {lo, hi}; bf16x2_nat b = __builtin_convertvector(v, bf16x2_nat); return __builtin_bit_cast(unsigned, b); }
__device__ __forceinline__ float bf_lo(unsigned u) { return __uint_as_float(u << 16); }
__device__ __forceinline__ float bf_hi(unsigned u) { return __uint_as_float(u & 0xffff0000u); }
__device__ __forceinline__ unsigned cvt_pk_f16(float lo, float hi) { h16x2 v = {(_Float16)lo, (_Float16)hi}; return __builtin_bit_cast(unsigned, v); }
__device__ __forceinline__ float sigmoidf_(float v) { return __builtin_amdgcn_rcpf(1.0f + __builtin_amdgcn_exp2f(-v * LOG2E)); }
__device__ __forceinline__ float siluf_(float v) { return v * sigmoidf_(v); }

namespace pg8 {
constexpr int BM = 256, BK = 64, HALF = 128, HTB = HALF * BK * 2, STAGE_BYTES = 8 * HTB, NXCD = 8, WGM = 8;
typedef int v8i32 __attribute__((ext_vector_type(8)));
typedef int v4i32 __attribute__((ext_vector_type(4)));

__host__ __device__ __forceinline__ int lds_byte(int r, int c) { const int st = (r >> 4) * 2 + (c >> 5), rr = r & 15, cc = c & 31, ob = rr * 64 + cc * 2; return st * 1024 + (ob ^ (((ob >> 9) & 1) << 5)); }
__host__ __device__ __forceinline__ void stage_rc(int b, int& R, int& C) { const int st = b / 1024, sb = b % 1024, swz = sb ^ (((sb >> 9) & 1) << 5); R = (st >> 1) * 16 + swz / 64; C = (st & 1) * 32 + (swz % 64) / 2; }
__host__ __device__ __forceinline__ int perm32(int rho) { const int n = rho >> 4, i = rho & 15; return 8 * (i >> 2) + 4 * n + (i & 3); }

struct GUnit { const char* A; const char* B0; const char* B1; int pm, pn, e0, e1, e2; };

__device__ __forceinline__ bool order_id(int i, int G, int c, int nwg, int& wgid) {
    const long L = (long)i * G + c; if (L >= nwg) return false;
    const int q = nwg / NXCD, r = nwg % NXCD, w = (int)L, xcd = w % NXCD, off = w / NXCD;
    wgid = (xcd < r ? xcd * (q + 1) : r * (q + 1) + (xcd - r) * q) + off; return true;
}

template <class Pol, class Epi, int SK = 0>
__device__ __forceinline__ void gemm_phase(LAS unsigned char* lds, const Pol& S, const Epi& E) {
    int tid = threadIdx.x; asm volatile("" : "+v"(tid));
    const int wid = __builtin_amdgcn_readfirstlane(tid >> 6), lane = tid & 63, wr = wid >> 2, wc = wid & 3, fr = lane & 15, fq = lane >> 4;
    const int RR0 = 8 * wid + (lane >> 3), RR1 = RR0 + 64, CC0 = 8 * ((lane & 7) ^ ((RR0 >> 1) & 7)), CC1 = CC0;
    const int Rb0 = Pol::HG ? (64 * (RR0 >> 5) + perm32(RR0 & 31)) : ((RR0 & ~31) + perm32(RR0 & 31)), Rb1 = Pol::HG ? (64 * (RR1 >> 5) + perm32(RR1 & 31)) : ((RR1 & ~31) + perm32(RR1 & 31));
    constexpr int NT = Pol::NT;
    const unsigned voffB00 = (unsigned)(Rb0 * S.ldb + CC0 * 2), voffB01 = (unsigned)(Rb1 * S.ldb + CC1 * 2), voffB10 = voffB00 + (unsigned)S.hstepB, voffB11 = voffB01 + (unsigned)S.hstepB;
    unsigned voffA00 = (unsigned)(RR0 * S.lda + CC0 * 2), voffA01 = (unsigned)(RR1 * S.lda + CC1 * 2), voffA10 = (unsigned)((HALF + RR0) * S.lda + CC0 * 2), voffA11 = (unsigned)((HALF + RR1) * S.lda + CC1 * 2);
    unsigned voffAn00 = voffA00, voffAn01 = voffA01, voffAn10 = voffA10, voffAn11 = voffA11;
    const size_t kstep = (size_t)(BK * 2);
    const unsigned ldsw = (unsigned)wid * 1024u;
    const int swz = (fr >> 1) & 7, aoff0 = (wr * 64 + fr) * 128 + ((fq ^ swz) << 4), aoff1 = (wr * 64 + fr) * 128 + (((4 + fq) ^ swz) << 4), boff0 = (wc * 32 + fr) * 128 + ((fq ^ swz) << 4), boff1 = (wc * 32 + fr) * 128 + (((4 + fq) ^ swz) << 4);
#define PG8_SA(b, h) (((b) * 2 + (h)) * HTB)
#define PG8_SB(b, h) ((4 + (b) * 2 + (h)) * HTB)
#define PG8_STAGE2(bufoff, gbase, v0, v1) do { if constexpr (SK != 3 && SK != 6) { \
        __builtin_amdgcn_global_load_lds((const unsigned*)((const char*)(gbase) + (v0)), (LAS unsigned*)(lds + (bufoff) + ldsw), 16, 0, 0); \
        __builtin_amdgcn_global_load_lds((const unsigned*)((const char*)(gbase) + (v1)), (LAS unsigned*)(lds + (bufoff) + ldsw + 8192), 16, 0, 0); } } while (0)
#define PG8_STAGE(bufoff, gbase, voff, h) PG8_STAGE2(bufoff, gbase, voff##h##0, voff##h##1)
#define PG8_CAT(x0, x1) __builtin_shufflevector(x0, x1, 0, 1, 2, 3, 4, 5, 6, 7)
#define PG8_LO(x) __builtin_bit_cast(bf16x8, __builtin_shufflevector(x, x, 0, 1, 2, 3))
#define PG8_HI(x) __builtin_bit_cast(bf16x8, __builtin_shufflevector(x, x, 4, 5, 6, 7))
#define PG8_LDA(dst, b, h) do { if constexpr (SK != 4 && SK != 6) _Pragma("unroll") for (int m = 0; m < 4; ++m) dst[m] = PG8_CAT(*(const LAS v4i32*)(lds + PG8_SA(b, h) + aoff0 + m * 2048), *(const LAS v4i32*)(lds + PG8_SA(b, h) + aoff1 + m * 2048)); } while (0)
#define PG8_LDB(dst, b, h) do { if constexpr (SK != 4 && SK != 6) _Pragma("unroll") for (int n = 0; n < 2; ++n) dst[n] = PG8_CAT(*(const LAS v4i32*)(lds + PG8_SB(b, h) + boff0 + n * 2048), *(const LAS v4i32*)(lds + PG8_SB(b, h) + boff1 + n * 2048)); } while (0)
#define PG8_MMA(ai, bj, At, Bt) do { __builtin_amdgcn_s_setprio(1); _Pragma("unroll") for (int m = 0; m < ((SK == 2 || SK == 6) ? 0 : (SK == 1 ? 2 : 4)); ++m) _Pragma("unroll") for (int n = 0; n < 2; ++n) { \
        if constexpr (Pol::FP8) asm volatile("v_mfma_scale_f32_16x16x128_f8f6f4 %0, %1, %2, %0, %3, %4 op_sel_hi:[0,0,0]" : "+v"(acc[ai][bj][m][n]) : "v"(Bt[n]), "v"(At[m]), "v"(sclW), "v"(sclX)); \
        else { acc[ai][bj][m][n] = __builtin_amdgcn_mfma_f32_16x16x32_bf16(PG8_LO(Bt[n]), PG8_LO(At[m]), acc[ai][bj][m][n], 0, 0, 0); \
               acc[ai][bj][m][n] = __builtin_amdgcn_mfma_f32_16x16x32_bf16(PG8_HI(Bt[n]), PG8_HI(At[m]), acc[ai][bj][m][n], 0, 0, 0); } } \
        __builtin_amdgcn_s_setprio(0); } while (0)
#define PG8_WAIT_V(n) asm volatile("s_waitcnt vmcnt(" #n ")" ::: "memory")
#define PG8_WAIT_L(n) asm volatile("s_waitcnt lgkmcnt(" #n ")" ::: "memory")
#define PG8_BAR do { if constexpr (SK != 5) __builtin_amdgcn_s_barrier(); } while (0)
#define PG8_SCHED __builtin_amdgcn_sched_barrier(0)
    int sclW = 0, sclX = 0; if constexpr (Pol::FP8) { sclW = S.sclW; sclX = S.sclX; }
    GUnit cur, nxt; int ui = 0;
    if (!S.next(0, cur)) return;
    if constexpr (Pol::GATHER) {
        const u32x4 ix = S.rows(cur, RR0, RR1);
        voffA00 = ix.x * (unsigned)S.lda + (unsigned)CC0 * 2u; voffA01 = ix.y * (unsigned)S.lda + (unsigned)CC1 * 2u;
        voffA10 = ix.z * (unsigned)S.lda + (unsigned)CC0 * 2u; voffA11 = ix.w * (unsigned)S.lda + (unsigned)CC1 * 2u;
    }
    f32x4 acc[2][2][4][2];
#pragma unroll
    for (int a = 0; a < 2; ++a)
#pragma unroll
        for (int b = 0; b < 2; ++b)
#pragma unroll
            for (int m = 0; m < 4; ++m)
#pragma unroll
                for (int n = 0; n < 2; ++n) acc[a][b][m][n] = (f32x4){0.f, 0.f, 0.f, 0.f};
    v8i32 At[4], B0[2], B1[2];
    if constexpr (SK == 4 || SK == 6) { _Pragma("unroll") for (int m = 0; m < 4; ++m) At[m] = (v8i32){1, 2, 3, 4, 5, 6, 7, 8}; B0[0] = B0[1] = B1[0] = B1[1] = (v8i32){1, 2, 3, 4, 5, 6, 7, 8}; }
    const char* cA = cur.A;
    PG8_STAGE(PG8_SB(0, 0), cur.B0, voffB, 0); PG8_STAGE(PG8_SB(0, 1), cur.B0, voffB, 1); PG8_STAGE(PG8_SA(0, 0), cA, voffA, 0); PG8_STAGE(PG8_SA(0, 1), cA, voffA, 1);
    if (wr == 1) PG8_BAR;
    PG8_WAIT_V(2); PG8_BAR;
    PG8_STAGE(PG8_SB(1, 0), cur.B0 + kstep, voffB, 0); PG8_STAGE(PG8_SA(1, 0), cA + kstep, voffA, 0); PG8_STAGE(PG8_SB(1, 1), cur.B0 + kstep, voffB, 1);
    PG8_WAIT_V(6); PG8_BAR;
    for (;;) {
        const bool has_next = S.next(ui + 1, nxt);
        const char* nA = has_next ? nxt.A : cA; const char* nB = has_next ? nxt.B0 : cur.B0;
        if constexpr (Pol::GATHER) {
            if (has_next) { int r0_ = RR0, r1_ = RR1; asm volatile("" : "+v"(r0_), "+v"(r1_)); const u32x4 ix = S.rows(nxt, r0_, r1_);
                voffAn00 = ix.x * (unsigned)S.lda + (unsigned)CC0 * 2u; voffAn01 = ix.y * (unsigned)S.lda + (unsigned)CC1 * 2u;
                voffAn10 = ix.z * (unsigned)S.lda + (unsigned)CC0 * 2u; voffAn11 = ix.w * (unsigned)S.lda + (unsigned)CC1 * 2u; }
            else { voffAn00 = voffA00; voffAn01 = voffA01; voffAn10 = voffA10; voffAn11 = voffA11; }
        }
#pragma unroll 1
        for (int t = 0; t < NT; t += 2) {
            const bool last = (t == NT - 2);
            const char* a1 = cA + (size_t)(t + 1) * kstep;
            const char* a2 = last ? nA : cA + (size_t)(t + 2) * kstep;
            const char* b2 = last ? nB : ((t + 2 < S.ks) ? cur.B0 + (size_t)(t + 2) * kstep : cur.B1 + (size_t)(t + 2 - S.ks) * kstep);
            const char* a3 = a2 + kstep; const char* b3 = b2 + kstep;
            asm volatile("" : "+s"(a1), "+s"(a2), "+s"(a3), "+s"(b2), "+s"(b3));
            const bool gl_ = Pol::GATHER && last;
            const unsigned va00 = gl_ ? voffAn00 : voffA00, va01 = gl_ ? voffAn01 : voffA01, va10 = gl_ ? voffAn10 : voffA10, va11 = gl_ ? voffAn11 : voffA11;
            PG8_LDB(B0, 0, 0); PG8_LDB(B1, 0, 1); PG8_SCHED; PG8_LDA(At, 0, 0); PG8_STAGE(PG8_SA(1, 1), a1, voffA, 1);
            PG8_WAIT_V(8); PG8_WAIT_L(0); PG8_BAR; PG8_MMA(0, 0, At, B0); PG8_MMA(0, 1, At, B1); PG8_BAR; PG8_SCHED;
            PG8_LDA(At, 0, 1); PG8_STAGE(PG8_SB(0, 0), b2, voffB, 0); PG8_STAGE(PG8_SB(0, 1), b2, voffB, 1); PG8_STAGE(PG8_SA(0, 0), a2, va, 0);
            PG8_WAIT_V(8); PG8_WAIT_L(0); PG8_BAR; PG8_MMA(1, 0, At, B0); PG8_MMA(1, 1, At, B1); PG8_BAR; PG8_SCHED;
            PG8_LDB(B0, 1, 0); PG8_LDB(B1, 1, 1); PG8_SCHED; PG8_LDA(At, 1, 0); PG8_STAGE(PG8_SA(0, 1), a2, va, 1);
            PG8_WAIT_V(8); PG8_WAIT_L(0); PG8_BAR; PG8_MMA(0, 0, At, B0); PG8_MMA(0, 1, At, B1); PG8_BAR; PG8_SCHED;
            PG8_LDA(At, 1, 1); PG8_STAGE(PG8_SB(1, 0), b3, voffB, 0); PG8_STAGE(PG8_SB(1, 1), b3, voffB, 1); PG8_STAGE(PG8_SA(1, 0), a3, va, 0);
            PG8_WAIT_V(8); PG8_WAIT_L(0); PG8_BAR; PG8_MMA(1, 0, At, B0); PG8_MMA(1, 1, At, B1); PG8_BAR; PG8_SCHED;
        }
        if (wr == 0) PG8_BAR;
        if constexpr (Pol::FP8) asm volatile("s_nop 15\n\ts_nop 7" ::: "memory");
        { int fr_e = fr, fq_e = fq; asm volatile("" : "+v"(fr_e), "+v"(fq_e));
          E(acc, cur, wr, wc, fr_e, fq_e); }
        if (!has_next) break;
#pragma unroll
        for (int a = 0; a < 2; ++a)
#pragma unroll
            for (int b = 0; b < 2; ++b)
#pragma unroll
                for (int m = 0; m < 4; ++m)
#pragma unroll
                    for (int n = 0; n < 2; ++n) acc[a][b][m][n] = (f32x4){0.f, 0.f, 0.f, 0.f};
        cur = nxt; cA = nA; ++ui;
        if constexpr (Pol::GATHER) { voffA00 = voffAn00; voffA01 = voffAn01; voffA10 = voffAn10; voffA11 = voffAn11; }
        if (wr == 1) PG8_BAR;
    }
    PG8_WAIT_V(0);
    PG8_BAR;
#undef PG8_SA
#undef PG8_SB
#undef PG8_STAGE
#undef PG8_STAGE2
#undef PG8_LDA
#undef PG8_LDB
#undef PG8_MMA
#undef PG8_CAT
#undef PG8_LO
#undef PG8_HI
#undef PG8_WAIT_V
#undef PG8_WAIT_L
#undef PG8_BAR
#undef PG8_SCHED
}
}
namespace pg8 {
struct DensePol {
    static constexpr bool GATHER = false, FP8 = false; static constexpr int NT = 16;
    const char* A; const char* Bt; int lda, ldb, hstepB, ks, nN, G, c, bt_tile_rows  ;
    __device__ __forceinline__ bool next(int i, GUnit& u) const {
        const int nM = MTOK / BM, nwg = nM * nN; int wgid; if (!order_id(i, G, c, nwg, wgid)) return false;
        const int nig = WGM * nN, gid = wgid / nig, fm = gid * WGM, gsz = (nM - fm) < WGM ? (nM - fm) : WGM;
        u.pm = fm + ((wgid % nig) % gsz); u.pn = (wgid % nig) / gsz; u.e0 = 0; u.e1 = 0; u.e2 = 0;
        u.A = A + (size_t)u.pm * BM * lda; u.B0 = Bt + (size_t)u.pn * BM * ldb; u.B1 = u.B0; return true;
    }
};
struct ProjPol : DensePol { static constexpr bool HG = true; };
struct PlainPol : DensePol { static constexpr bool HG = false; };

struct MoeTab { const LAS int* t; __device__ __forceinline__ int cnt(int c) const { return t[c]; } __device__ __forceinline__ int tpre(int c) const { return t[32 + c]; } };
__device__ __forceinline__ void moe_class_experts(int cls, int& elo, int& ehi) {
    const int g = cls / 6, p = cls % 6; const int lo = p < 3 ? 0 : (p < 5 ? 1 : 2); const int hi = p < 3 ? p + 1 : (p < 5 ? p - 1 : 3);
    elo = 4 * g + lo; ehi = 4 * g + hi;
}
struct Moe1Pol {
    static constexpr bool GATHER = true, HG = false, FP8 = true; static constexpr int NT = 8;
    const char* A; const char* W1T; const int* list; MoeTab tab; int lda, ldb, hstepB, ks, G, c, sclW, sclX;
    __device__ __forceinline__ bool next(int i, GUnit& u) const {
        const int ntile = tab.tpre(NCLS), nwg = ntile * 8; int wgid; if (!order_id(i, G, c, nwg, wgid)) return false;
        const int rtg = wgid >> 3, sub = wgid & 7, e01 = sub >> 2, ct = sub & 3;
        int cls = 0;
#pragma unroll 1
        for (int k = 1; k < NCLS; ++k) cls += (tab.tpre(k) <= rtg) ? 1 : 0;
        int elo, ehi; moe_class_experts(cls, elo, ehi); const int ex = e01 ? ehi : elo;
        u.pm = rtg; u.pn = ct; u.e0 = cls; u.e1 = rtg - tab.tpre(cls); u.e2 = e01;
        u.A = A; u.B0 = W1T + ((size_t)ex * 1024 + (size_t)ct * 128) * 1024; u.B1 = u.B0; return true;
    }
    __device__ __forceinline__ u32x4 rows(const GUnit& u, int R0, int R1) const {
        const int base = u.e1 * 256, n = tab.cnt(u.e0) - base; const int* L = list + (size_t)u.e0 * MTOK + base;
        u32x4 r;
        r.x = R0 < n ? (unsigned)L[R0] : 0u; r.y = R1 < n ? (unsigned)L[R1] : 0u;
        r.z = HALF + R0 < n ? (unsigned)L[HALF + R0] : 0u; r.w = HALF + R1 < n ? (unsigned)L[HALF + R1] : 0u;
        return r;
    }
};
struct Moe2Pol {
    static constexpr bool GATHER = false, HG = false, FP8 = true; static constexpr int NT = 8;
    const char* A; const char* WdT; MoeTab tab; int lda, ldb, hstepB, ks, G, c, sclW, sclX;
    __device__ __forceinline__ bool next(int i, GUnit& u) const {
        const int ntile = tab.tpre(NCLS), nwg = ntile * 4; int wgid; if (!order_id(i, G, c, nwg, wgid)) return false;
        const int rtg = wgid >> 2, ct = wgid & 3;
        int cls = 0;
#pragma unroll 1
        for (int k = 1; k < NCLS; ++k) cls += (tab.tpre(k) <= rtg) ? 1 : 0;
        int elo, ehi; moe_class_experts(cls, elo, ehi);
        u.pm = rtg; u.pn = ct; u.e0 = cls; u.e1 = rtg - tab.tpre(cls); u.e2 = 0;
        u.A = A + (size_t)rtg * BM * lda;
        u.B0 = WdT + ((size_t)elo * 1024 + (size_t)ct * 256) * 512; u.B1 = WdT + ((size_t)ehi * 1024 + (size_t)ct * 256) * 512; return true;
    }
};

struct EpiProj {
    bf16_t* P; const float* gq; const float* gk; const float* lbp;
    __device__ __forceinline__ void operator()(const f32x4 (&acc)[2][2][4][2], const GUnit& u, int wr, int wc, int fr, int fq) const {
#ifdef REP_EPIPROJ
        for (int rep_ = 0; rep_ < REP_EPIPROJ - 1; ++rep_) { asm volatile("" ::: "memory"); body(acc, u, wr, wc, fr, fq); }
#endif
        body(acc, u, wr, wc, fr, fq);
    }
    __device__ __forceinline__ void body(const f32x4 (&acc)[2][2][4][2], const GUnit& u, int wr, int wc, int fr, int fq) const {
        const int type = u.pn >> 1;
        const int row0 = u.pm * BM + wr * 64 + fr, lc0 = 64 * wc + 8 * fq;
        bf16_t* base = P + (size_t)row0 * PW + u.pn * BM + lc0;
        if (type <= 1) {
            const float* g = type == 0 ? gq : gk; const float sc = type == 0 ? QSCALE : 1.0f;
            f32x4 gv[2][2];
#pragma unroll
            for (int bj = 0; bj < 2; ++bj)
#pragma unroll
                for (int n = 0; n < 2; ++n) gv[bj][n] = *(const f32x4*)(g + 32 * bj + 8 * fq + 4 * n) * sc;
#pragma unroll
            for (int ai = 0; ai < 2; ++ai)
#pragma unroll
                for (int m = 0; m < 4; ++m) {
                    float ss = 0.f;
#pragma unroll
                    for (int bj = 0; bj < 2; ++bj)
#pragma unroll
                        for (int n = 0; n < 2; ++n) { const f32x4 v = acc[ai][bj][m][n]; ss += (v[0] * v[0] + v[1] * v[1]) + (v[2] * v[2] + v[3] * v[3]); }
                    ss += __shfl_xor(ss, 16); ss += __shfl_xor(ss, 32);
                    const float rstd = __builtin_amdgcn_rsqf(ss * (1.0f / 64.0f) + NORM_EPS);
                    bf16_t* rowp = base + (size_t)(ai * HALF + m * 16) * PW;
#pragma unroll
                    for (int bj = 0; bj < 2; ++bj) { const f32x4 v0 = acc[ai][bj][m][0] * rstd * gv[bj][0], v1 = acc[ai][bj][m][1] * rstd * gv[bj][1];
                        u32x4 w; w.x = cvt_pk_bf16(v0[0], v0[1]); w.y = cvt_pk_bf16(v0[2], v0[3]); w.z = cvt_pk_bf16(v1[0], v1[1]); w.w = cvt_pk_bf16(v1[2], v1[3]);
                        *(u32x4*)(rowp + 32 * bj) = w; }
                }
        } else if (type == 4) {
            const int ch0 = (u.pn - 8) * BM + lc0;
            f32x4 lbv[2][2];
#pragma unroll
            for (int bj = 0; bj < 2; ++bj)
#pragma unroll
                for (int n = 0; n < 2; ++n) { const f32x4 l0 = *(const f32x4*)(lbp + ch0 + 32 * bj + 4 * n), l1 = *(const f32x4*)(lbp + 512 + ch0 + 32 * bj + 4 * n);
#pragma unroll
                    for (int e = 0; e < 4; ++e) lbv[bj][n][e] = sigmoidf_(l0[e] - l1[e]); }
#pragma unroll
            for (int ai = 0; ai < 2; ++ai)
#pragma unroll
                for (int m = 0; m < 4; ++m) { bf16_t* rowp = base + (size_t)(ai * HALF + m * 16) * PW;
#pragma unroll
                    for (int bj = 0; bj < 2; ++bj) { float o[8];
#pragma unroll
                        for (int n = 0; n < 2; ++n)
#pragma unroll
                            for (int e = 0; e < 4; ++e) { const float lb = lbv[bj][n][e]; o[4 * n + e] = lb + (1.0f - lb) * sigmoidf_(acc[ai][bj][m][n][e]); }
                        u32x4 w; w.x = cvt_pk_f16(o[0], o[1]); w.y = cvt_pk_f16(o[2], o[3]); w.z = cvt_pk_f16(o[4], o[5]); w.w = cvt_pk_f16(o[6], o[7]);
                        *(u32x4*)(rowp + 32 * bj) = w; } }
        } else {
            const bool act = (type == 3 || type == 6);
#pragma unroll
            for (int ai = 0; ai < 2; ++ai)
#pragma unroll
                for (int m = 0; m < 4; ++m) { bf16_t* rowp = base + (size_t)(ai * HALF + m * 16) * PW;
#pragma unroll
                    for (int bj = 0; bj < 2; ++bj) { f32x4 v0 = acc[ai][bj][m][0], v1 = acc[ai][bj][m][1];
                        if (act) {
#pragma unroll
                            for (int e = 0; e < 4; ++e) { v0[e] = siluf_(v0[e]); v1[e] = siluf_(v1[e]); } }
                        u32x4 w; w.x = cvt_pk_bf16(v0[0], v0[1]); w.y = cvt_pk_bf16(v0[2], v0[3]); w.z = cvt_pk_bf16(v1[0], v1[1]); w.w = cvt_pk_bf16(v1[2], v1[3]);
                        *(u32x4*)(rowp + 32 * bj) = w; } }
        }
    }
};
struct EpiRes {
    const float* __restrict__ x; bf16_t* __restrict__ x1; const float* __restrict__ gate;
    __device__ __forceinline__ void operator()(const f32x4 (&acc)[2][2][4][2], const GUnit& u, int wr, int wc, int fr, int fq) const {
        const int row0 = u.pm * BM + wr * 64 + fr, col0 = u.pn * BM + 32 * wc + 8 * fq, b = (u.pm * BM) >> 11;
        f32x4 gv[2][2];
#pragma unroll
        for (int bj = 0; bj < 2; ++bj)
#pragma unroll
            for (int n = 0; n < 2; ++n) gv[bj][n] = *(const f32x4*)(gate + (size_t)b * 6144 + col0 + HALF * bj + 4 * n);
#pragma unroll
        for (int ai = 0; ai < 2; ++ai) {
            f32x4 xv[4][2][2];
#pragma unroll
            for (int m = 0; m < 4; ++m) { const size_t off = (size_t)(row0 + ai * HALF + m * 16) * DMODEL + col0;
#pragma unroll
                for (int bj = 0; bj < 2; ++bj) { xv[m][bj][0] = *(const f32x4*)(x + off + HALF * bj); xv[m][bj][1] = *(const f32x4*)(x + off + HALF * bj + 4); } }
#pragma unroll
            for (int m = 0; m < 4; ++m) { const size_t off = (size_t)(row0 + ai * HALF + m * 16) * DMODEL + col0;
#pragma unroll
                for (int bj = 0; bj < 2; ++bj) { const f32x4 o0 = xv[m][bj][0] + gv[bj][0] * acc[ai][bj][m][0], o1 = xv[m][bj][1] + gv[bj][1] * acc[ai][bj][m][1];
                    u32x4 w; w.x = cvt_pk_bf16(o0[0], o0[1]); w.y = cvt_pk_bf16(o0[2], o0[3]); w.z = cvt_pk_bf16(o1[0], o1[1]); w.w = cvt_pk_bf16(o1[2], o1[3]);
                    *(u32x4*)(x1 + off + HALF * bj) = w; } }
        }
    }
};
__device__ __forceinline__ float clamp448(float v) { return __builtin_amdgcn_fmed3f(v, -448.0f, 448.0f); }
__device__ __forceinline__ unsigned pk4_fp8(float a, float b, float c, float d) { int r = 0; r = __builtin_amdgcn_cvt_pk_fp8_f32(clamp448(a), clamp448(b), r, false); r = __builtin_amdgcn_cvt_pk_fp8_f32(clamp448(c), clamp448(d), r, true); return (unsigned)r; }
struct EpiSwiglu {
    unsigned char* __restrict__ act; const float* __restrict__ lw; MoeTab tab;
    __device__ __forceinline__ void operator()(const f32x4 (&acc)[2][2][4][2], const GUnit& u, int wr, int wc, int fr, int fq) const {
        const int r0 = wr * 64 + fr, n = tab.cnt(u.e0) - u.e1 * 256;
        const float* lwp = lw + ((size_t)u.e0 * MTOK + (size_t)u.e1 * 256) * 2 + u.e2;
        unsigned char* base = act + (size_t)(u.pm * BM + r0) * DMODEL + u.e2 * 512 + u.pn * 128 + 32 * wc + 8 * fq;
        float wrow[2][4];
#pragma unroll
        for (int ai = 0; ai < 2; ++ai)
#pragma unroll
            for (int m = 0; m < 4; ++m) { const int r = r0 + ai * HALF + m * 16; wrow[ai][m] = (r < n ? lwp[(size_t)r * 2] : 0.f) * ACT_SCALE; }
#pragma unroll
        for (int ai = 0; ai < 2; ++ai)
#pragma unroll
            for (int m = 0; m < 4; ++m) { const float w = wrow[ai][m];
                float o[8];
#pragma unroll
                for (int nn = 0; nn < 2; ++nn)
#pragma unroll
                    for (int e = 0; e < 4; ++e) o[4 * nn + e] = w * siluf_(acc[ai][0][m][nn][e]) * acc[ai][1][m][nn][e];
                *(u32x2*)(base + (size_t)(ai * HALF + m * 16) * DMODEL) = (u32x2){pk4_fp8(o[0], o[1], o[2], o[3]), pk4_fp8(o[4], o[5], o[6], o[7])}; }
    }
};
struct EpiMoeOut {
    float* __restrict__ out; const bf16_t* __restrict__ x1; const float* __restrict__ gate; const int* __restrict__ list; MoeTab tab;
    __device__ __forceinline__ void operator()(const f32x4 (&acc)[2][2][4][2], const GUnit& u, int wr, int wc, int fr, int fq) const {
        const int r0 = wr * 64 + fr, n = tab.cnt(u.e0) - u.e1 * 256, col0 = u.pn * BM + 32 * wc + 8 * fq;
        const int* L = list + (size_t)u.e0 * MTOK + (size_t)u.e1 * 256;
        int tok[2][4];
#pragma unroll
        for (int ai = 0; ai < 2; ++ai)
#pragma unroll
            for (int m = 0; m < 4; ++m) { const int r = r0 + ai * HALF + m * 16; tok[ai][m] = r < n ? L[r] : 0; }
#pragma unroll
        for (int ai = 0; ai < 2; ++ai)
#pragma unroll
            for (int m = 0; m < 4; ++m) { const int r = r0 + ai * HALF + m * 16, tk = tok[ai][m];
                const float* gp = gate + (size_t)(tk >> 11) * 6144 + col0; float* op = out + (size_t)tk * DMODEL + col0; const bf16_t* xp = x1 + (size_t)tk * DMODEL + col0;
                const u32x4 xa = *(const u32x4*)(xp), xb = *(const u32x4*)(xp + HALF);
                const f32x4 ga0 = *(const f32x4*)(gp), ga1 = *(const f32x4*)(gp + 4), gb0 = *(const f32x4*)(gp + HALF), gb1 = *(const f32x4*)(gp + HALF + 4);
                const f32x4 o0 = (f32x4){bf_lo(xa.x), bf_hi(xa.x), bf_lo(xa.y), bf_hi(xa.y)} + ga0 * acc[ai][0][m][0], o1 = (f32x4){bf_lo(xa.z), bf_hi(xa.z), bf_lo(xa.w), bf_hi(xa.w)} + ga1 * acc[ai][0][m][1];
                const f32x4 o2 = (f32x4){bf_lo(xb.x), bf_hi(xb.x), bf_lo(xb.y), bf_hi(xb.y)} + gb0 * acc[ai][1][m][0], o3 = (f32x4){bf_lo(xb.z), bf_hi(xb.z), bf_lo(xb.w), bf_hi(xb.w)} + gb1 * acc[ai][1][m][1];
                if (r < n) { *(f32x4*)(op) = o0; *(f32x4*)(op + 4) = o1; *(f32x4*)(op + HALF) = o2; *(f32x4*)(op + HALF + 4) = o3; } }
    }
};
}
namespace attn_body {
using bf16 = __hip_bfloat16;
constexpr int D = 64, DM = PW;
constexpr int NW = 8, QBLK = 32, QB = QBLK * NW, KVBLK = 64, NQB = SEQ / QB;
__device__ __forceinline__ int crow(int r, int hi) { return (r & 3) + 8 * (r >> 2) + 4 * hi; }
#define SBAR() __builtin_amdgcn_sched_barrier(0)
__device__ __forceinline__ void cmask(f32x16& p0, f32x16& p1, int jb, int qrel, int hi) {
    const float NEG = -INFINITY; int kb = 64 * jb + 4 * hi;
#pragma unroll
    for (int r = 0; r < 16; ++r) { int kv = kb + (r & 3) + 8 * (r >> 2); if (kv > qrel) p0[r] = NEG; if (kv + 32 > qrel) p1[r] = NEG; }
}
constexpr int NSLOT = 3, SLOTB = 8192;
constexpr int LDS_K = 0, LDS_V = NSLOT * SLOTB, LDS_WS = 2 * NSLOT * SLOTB, LDS_OST = LDS_WS + NW * 64 * 4, LDS_CUM = LDS_OST + NW * 4096, LDS_OG = LDS_CUM + SEQ * 4, LDS_BYTES = LDS_OG + 256;
__device__ __forceinline__ void glds16(const void* gsrc, unsigned lds_dst) { unsigned keep;
    asm volatile("s_mov_b32 %0, m0\n\ts_mov_b32 m0, %2\n\ts_nop 0\n\tglobal_load_lds_dwordx4 %1, off\n\ts_mov_b32 m0, %0" : "=&s"(keep) : "v"(gsrc), "s"(lds_dst) : "memory"); }
typedef float f32x2_t __attribute__((ext_vector_type(2))); typedef __bf16 bf16x2_t __attribute__((ext_vector_type(2)));
__device__ __forceinline__ unsigned cvtpk_s(float lo, float hi) { f32x2_t v = {lo, hi}; bf16x2_t b = __builtin_convertvector(v, bf16x2_t); return __builtin_bit_cast(unsigned, b); }
#define WAIT_BAR(N) asm volatile("s_waitcnt vmcnt(" #N ") lgkmcnt(0)\n\ts_barrier" ::: "memory")
typedef LAS const char* lds_cptr;
typedef short v4i16_t __attribute__((ext_vector_type(4)));
__device__ __forceinline__ void split3(float x, unsigned& w0, unsigned& w1) {
    const unsigned xb = __float_as_uint(x), hb = xb & 0xffff0000u; const float r1 = x - __uint_as_float(hb);
    const unsigned mb = __float_as_uint(r1) & 0xffff0000u; const float r2 = r1 - __uint_as_float(mb);
    w0 = (hb >> 16) | mb; w1 = __float_as_uint(r2) >> 16;
}
__device__ __forceinline__ bf16x8 kbias_frag(float nk, int hi) {
    unsigned w0, w1; split3(nk, w0, w1);
    const u32x4 v = (u32x4){hi ? w0 : 0x3F803F80u, hi ? w1 : 0x00003F80u, 0u, 0u};
    return __builtin_bit_cast(bf16x8, v);
}
__device__ __forceinline__ bf16x8 qbias_frag(float cq, int hi) {
    unsigned w0, w1; split3(cq, w0, w1);
    const u32x4 v = (u32x4){hi ? 0x3F803F80u : w0, hi ? 0x00003F80u : w1, 0u, 0u};
    return __builtin_bit_cast(bf16x8, v);
}
#define Z16 (f32x16){0.f, 0.f, 0.f, 0.f, 0.f, 0.f, 0.f, 0.f, 0.f, 0.f, 0.f, 0.f, 0.f, 0.f, 0.f, 0.f}
__device__ __forceinline__ void qkt(f32x16& p0, f32x16& p1, const char* Kslot, const bf16x8* qr, bf16x8 kb0, bf16x8 kb1, bf16x8 qb, int r32, int hi) {
    const char* kb = Kslot + hi * 1024 + r32 * 16;
    p0 = __builtin_amdgcn_mfma_f32_32x32x16_bf16(kb0, qb, Z16, 0, 0, 0); p1 = __builtin_amdgcn_mfma_f32_32x32x16_bf16(kb1, qb, Z16, 0, 0, 0);
#pragma unroll
    for (int d0 = 0; d0 < 4; ++d0) {
        const bf16x8 b0 = *reinterpret_cast<const bf16x8*>(kb + d0 * 2048);
        const bf16x8 b1 = *reinterpret_cast<const bf16x8*>(kb + d0 * 2048 + 512);
        p0 = __builtin_amdgcn_mfma_f32_32x32x16_bf16(b0, qr[d0], p0, 0, 0, 0); p1 = __builtin_amdgcn_mfma_f32_32x32x16_bf16(b1, qr[d0], p1, 0, 0, 0); }
}
__device__ __forceinline__ void kload8(bf16x8* kf, lds_cptr kp) {
    kf[0] = *(const LAS bf16x8*)(kp);        kf[1] = *(const LAS bf16x8*)(kp + 512);
    kf[2] = *(const LAS bf16x8*)(kp + 2048); kf[3] = *(const LAS bf16x8*)(kp + 2560);
    kf[4] = *(const LAS bf16x8*)(kp + 4096); kf[5] = *(const LAS bf16x8*)(kp + 4608);
    kf[6] = *(const LAS bf16x8*)(kp + 6144); kf[7] = *(const LAS bf16x8*)(kp + 6656);
}
__device__ __forceinline__ void kload2(bf16x8* kf, lds_cptr kp, int j) { kf[2 * j] = *(const LAS bf16x8*)(kp + j * 2048); kf[2 * j + 1] = *(const LAS bf16x8*)(kp + j * 2048 + 512); }
__device__ __forceinline__ s16x4 vtr(lds_cptr p) { return __builtin_bit_cast(s16x4, __builtin_amdgcn_ds_read_tr16_b64_v4i16((LAS v4i16_t*)p)); }
__device__ __forceinline__ void pv(f32x16* o, int vb, bf16x8 pa0, bf16x8 pa1, bf16x8 pa2, bf16x8 pa3) {
#pragma unroll
    for (int d0 = 0; d0 < 2; ++d0) { s16x4 lo[4], hi[4];
#pragma unroll
        for (int ks = 0; ks < 4; ++ks) {
            asm volatile("ds_read_b64_tr_b16 %0,%1 offset:%c2" : "=&v"(lo[ks]) : "v"(vb), "i"(d0 * 4096 + ks * 1024) : "memory");
            asm volatile("ds_read_b64_tr_b16 %0,%1 offset:%c2" : "=&v"(hi[ks]) : "v"(vb), "i"(d0 * 4096 + ks * 1024 + 512) : "memory"); }
        asm volatile("s_waitcnt lgkmcnt(0)" ::: "memory"); SBAR();
#define PK(k) (bf16x8){lo[k][0], lo[k][1], lo[k][2], lo[k][3], hi[k][0], hi[k][1], hi[k][2], hi[k][3]}
        o[d0] = __builtin_amdgcn_mfma_f32_32x32x16_bf16(pa0, PK(0), o[d0], 0, 0, 0);
        o[d0] = __builtin_amdgcn_mfma_f32_32x32x16_bf16(pa1, PK(1), o[d0], 0, 0, 0);
        o[d0] = __builtin_amdgcn_mfma_f32_32x32x16_bf16(pa2, PK(2), o[d0], 0, 0, 0);
        o[d0] = __builtin_amdgcn_mfma_f32_32x32x16_bf16(pa3, PK(3), o[d0], 0, 0, 0);
#undef PK
    }
}

__device__ __forceinline__ void attn_unit(int b, int h, int qb, const bf16* P, bf16* O, float m0l, char* shm, bool pre, int nqb) {
    int tid = threadIdx.x; asm volatile("" : "+v"(tid));
    const int lane = tid & 63, r32 = lane & 31, hi = lane >> 5; const int wid = __builtin_amdgcn_readfirstlane(tid >> 6);
    const long rowbase = (long)b * SEQ; const int q0 = qb * QB;
    const lds_cptr shm3 = (lds_cptr)shm;
    const float fthr = 2.0f * m0l + 32.0f;
    int t0 = 0;
    { const LAS float* nc = (const LAS float*)(shm3 + LDS_CUM); const float nq0 = nc[q0]; const int tmax = (q0 + QB) / KVBLK - 4;
      while (t0 + 2 <= tmax && nq0 - nc[KVBLK * (t0 + 2) - 1] > fthr) t0 += 2; }
    const bf16* Qw = P + (rowbase + q0 + wid * QBLK) * DM + PC_Q + h * D;
    const bf16* Kh0 = P + rowbase * DM + PC_K + h * D, *Vh0 = P + rowbase * DM + PC_V + h * D;
    const bf16* Kh = Kh0 + (long)t0 * KVBLK * DM, *Vh = Vh0 + (long)t0 * KVBLK * DM;
    const unsigned lds0 = (unsigned)(uintptr_t)shm;
    float* wsf = (float*)(shm + LDS_WS) + wid * 64;
    const bf16* ksrc = Kh + (long)lane * DM + wid * 8;
    const bf16* vsrc = Vh + (long)(16 * (wid & 3) + (lane >> 2)) * DM + (wid >> 2) * 32 + (lane & 3) * 8;
    const unsigned kdst = lds0 + LDS_K + wid * 1024, vdst = lds0 + LDS_V + wid * 1024;
#define DMA_K(t, slot) glds16(ksrc + (long)(t) * KVBLK * DM, (unsigned)__builtin_amdgcn_readfirstlane(kdst + (slot)))
#define DMA_V(t, slot) glds16(vsrc + (long)(t) * KVBLK * DM, (unsigned)__builtin_amdgcn_readfirstlane(vdst + (slot)))
    const int vb0 = (int)(lds0 + LDS_V) + ((lane >> 4) & 1) * 32 + (lane & 3) * 8 + (4 * hi + ((lane & 15) >> 2)) * 64;
    const char* Kbase = shm + LDS_K; bf16x8 kf[8];
    const lds_cptr kp0 = shm3 + LDS_K + hi * 1024 + r32 * 16; const lds_cptr vp0 = shm3 + LDS_V + ((lane >> 4) & 1) * 32 + (lane & 3) * 8 + (4 * hi + ((lane & 15) >> 2)) * 64;
    const lds_cptr cump = shm3 + LDS_CUM + t0 * 256 + r32 * 4;
    const int NT = (q0 + QB) / KVBLK - t0;
    if (!pre) { DMA_K(0, 0); DMA_V(0, 0); DMA_K(1, SLOTB); }
    bf16x8 qr[4];
#pragma unroll
    for (int d0 = 0; d0 < 4; ++d0) qr[d0] = *reinterpret_cast<const bf16x8*>(&Qw[(long)r32 * DM + d0 * 16 + hi * 8]);
    float l_reg = 0.f; f32x16 o[2]; o[0] = f32x16{}; o[1] = f32x16{};
    const int qrel = wid * QBLK + r32;
    const bf16x8 qbf = qbias_frag(-*(const LAS float*)(shm3 + LDS_CUM + (q0 + qrel) * 4) - m0l, hi);
#define CMASK(P0, P1, t) do { int jb_ = (t) - (NT - 4); if (jb_ >= 0) cmask(P0, P1, jb_, qrel, hi); } while (0)
#define CKL(t, off) (*(const LAS float*)(cump + (t) * 256 + (off)))
    f32x16 pA0, pA1, pB0, pB1;
    int sl_prev = 0, sl_cur = 0, sl_next = SLOTB;
#define ROT() do { sl_prev = sl_cur; sl_cur = sl_next; sl_next = (sl_next == (NSLOT - 1) * SLOTB) ? 0 : sl_next + SLOTB; } while (0)
    DMA_K(2, 2 * SLOTB);
    bf16x8 kb0 = kbias_frag(CKL(0, 0), hi), kb1 = kbias_frag(CKL(0, 128), hi);
    WAIT_BAR(3);
    qkt(pA0, pA1, Kbase, qr, kb0, kb1, qbf, r32, hi); asm volatile("s_nop 15\n\ts_nop 7" : "+v"(pA0), "+v"(pA1)); CMASK(pA0, pA1, 0);
#pragma unroll
    for (int r = 0; r < 16; ++r) { pA0[r] = __builtin_amdgcn_exp2f(pA0[r]); pA1[r] = __builtin_amdgcn_exp2f(pA1[r]); }
    kb0 = kbias_frag(CKL(1, 0), hi); kb1 = kbias_frag(CKL(1, 128), hi);
    WAIT_BAR(0);
    DMA_K(3, 0); DMA_V(1, SLOTB);
    ROT();
    kload8(kf, kp0 + sl_cur);
    WAIT_BAR(2);
    s16x4 vlo[8], vhi[8]; u32x4 pw0, pw1, pw2, pw3; float nk0 = 0.f, nk1 = 0.f;
#define PKW(P, B) cvtpk_s(P[B], P[B + 1])
#define PAF(k) __builtin_bit_cast(bf16x8, pw##k)
#define VFR(i) (bf16x8){vlo[i][0], vlo[i][1], vlo[i][2], vlo[i][3], vhi[i][0], vhi[i][1], vhi[i][2], vhi[i][3]}
#define PIN(x) asm volatile("" : "+v"(x))
#define GAPA(MF, A0, A1, A2, A3, W0, W1, PW_) do { MF; sacc += A0; sacc += A1; sacc += A2; sacc += A3; PIN(sacc); W0; W1; PIN(PW_); SBAR(); } while (0)
#define EX(v) __builtin_amdgcn_exp2f(v)
#define GAPB(MF, X, B) do { MF; X[B] = EX(X[B]); X[B + 1] = EX(X[B + 1]); X[B + 2] = EX(X[B + 2]); X[B + 3] = EX(X[B + 3]); PIN(X); SBAR(); } while (0)
#define VRD(i) do { vlo[i] = vtr(vp_ + (((i) >> 2) * 4096 + ((i) & 3) * 1024)); vhi[i] = vtr(vp_ + (((i) >> 2) * 4096 + ((i) & 3) * 1024 + 512)); } while (0)
#define KRD(G, j) do { if (G) { kload2(kf, kp0 + sl_next, j); SBAR(); } } while (0)
#define STEP(C0, C1, P0, P1, t, GK, GV, GL, GI) do { SBAR(); \
    const lds_cptr vp_ = vp0 + sl_prev; \
    C0 = __builtin_amdgcn_mfma_f32_32x32x16_bf16(kb0, qbf, Z16, 0, 0, 0); C1 = __builtin_amdgcn_mfma_f32_32x32x16_bf16(kb1, qbf, Z16, 0, 0, 0); \
    if (GI) { nk0 = CKL((t) + 1, 0); nk1 = CKL((t) + 1, 128); } \
    SBAR(); \
    VRD(0); SBAR(); float sacc = (P0[0] + P0[1]); \
    GAPA(C0 = __builtin_amdgcn_mfma_f32_32x32x16_bf16(kf[0], qr[0], C0, 0, 0, 0), P0[2], P0[3], P0[4], P0[5],     pw0[0] = PKW(P0, 0), pw0[1] = PKW(P0, 2), pw0); \
    VRD(4); SBAR(); GAPA(C1 = __builtin_amdgcn_mfma_f32_32x32x16_bf16(kf[1], qr[0], C1, 0, 0, 0), P0[6], P0[7], P0[8], P0[9],     pw0[2] = PKW(P0, 4), pw0[3] = PKW(P0, 6), pw0); \
    VRD(1); SBAR(); GAPA(C0 = __builtin_amdgcn_mfma_f32_32x32x16_bf16(kf[2], qr[1], C0, 0, 0, 0), P0[10], P0[11], P0[12], P0[13], pw1[0] = PKW(P0, 8), pw1[1] = PKW(P0, 10), pw1); \
    VRD(5); SBAR(); GAPA(C1 = __builtin_amdgcn_mfma_f32_32x32x16_bf16(kf[3], qr[1], C1, 0, 0, 0), P0[14], P0[15], P1[0], P1[1],   pw1[2] = PKW(P0, 12), pw1[3] = PKW(P0, 14), pw1); \
    VRD(2); SBAR(); GAPA(C0 = __builtin_amdgcn_mfma_f32_32x32x16_bf16(kf[4], qr[2], C0, 0, 0, 0), P1[2], P1[3], P1[4], P1[5],     pw2[0] = PKW(P1, 0), pw2[1] = PKW(P1, 2), pw2); \
    VRD(6); SBAR(); GAPA(C1 = __builtin_amdgcn_mfma_f32_32x32x16_bf16(kf[5], qr[2], C1, 0, 0, 0), P1[6], P1[7], P1[8], P1[9],     pw2[2] = PKW(P1, 4), pw2[3] = PKW(P1, 6), pw2); \
    VRD(3); SBAR(); GAPA(C0 = __builtin_amdgcn_mfma_f32_32x32x16_bf16(kf[6], qr[3], C0, 0, 0, 0), P1[10], P1[11], P1[12], P1[13], pw3[0] = PKW(P1, 8), pw3[1] = PKW(P1, 10), pw3); \
    VRD(7); SBAR(); GAPA(C1 = __builtin_amdgcn_mfma_f32_32x32x16_bf16(kf[7], qr[3], C1, 0, 0, 0), P1[14], P1[15], 0.f, 0.f,       pw3[2] = PKW(P1, 12), pw3[3] = PKW(P1, 14), pw3); \
    l_reg += sacc; \
    if (GI) { kb0 = kbias_frag(nk0, hi); kb1 = kbias_frag(nk1, hi); } \
    if (GK) { DMA_K((t) + 3, sl_cur); } if (GV) { DMA_V((t) + 1, sl_next); } \
    CMASK(C0, C1, t); \
    SBAR(); \
    GAPB(o[0] = __builtin_amdgcn_mfma_f32_32x32x16_bf16(PAF(0), VFR(0), o[0], 0, 0, 0), C0, 0); \
    GAPB(o[1] = __builtin_amdgcn_mfma_f32_32x32x16_bf16(PAF(0), VFR(4), o[1], 0, 0, 0), C0, 4); \
    KRD(GL, 0); GAPB(o[0] = __builtin_amdgcn_mfma_f32_32x32x16_bf16(PAF(1), VFR(1), o[0], 0, 0, 0), C0, 8); \
    KRD(GL, 1); GAPB(o[1] = __builtin_amdgcn_mfma_f32_32x32x16_bf16(PAF(1), VFR(5), o[1], 0, 0, 0), C0, 12); \
    KRD(GL, 2); GAPB(o[0] = __builtin_amdgcn_mfma_f32_32x32x16_bf16(PAF(2), VFR(2), o[0], 0, 0, 0), C1, 0); \
    KRD(GL, 3); GAPB(o[1] = __builtin_amdgcn_mfma_f32_32x32x16_bf16(PAF(2), VFR(6), o[1], 0, 0, 0), C1, 4); \
    GAPB(o[0] = __builtin_amdgcn_mfma_f32_32x32x16_bf16(PAF(3), VFR(3), o[0], 0, 0, 0), C1, 8); \
    GAPB(o[1] = __builtin_amdgcn_mfma_f32_32x32x16_bf16(PAF(3), VFR(7), o[1], 0, 0, 0), C1, 12); \
    } while (0)
    int t = 1;
#undef CMASK
#define CMASK(P0, P1, t) do {} while (0)
    for (; t + 5 < NT; t += 2) {
        STEP(pB0, pB1, pA0, pA1, t, true, true, true, true);     WAIT_BAR(2); ROT();
        STEP(pA0, pA1, pB0, pB1, t + 1, true, true, true, true); WAIT_BAR(2); ROT();
    }
#undef CMASK
#define CMASK(P0, P1, t) do { int jb_ = (t) - (NT - 4); if (jb_ >= 0) cmask(P0, P1, jb_, qrel, hi); } while (0)
#define ENDW(tt) do { if ((tt) + 3 < NT) { WAIT_BAR(2); } else if ((tt) + 2 < NT) { WAIT_BAR(1); } else { WAIT_BAR(0); } } while (0)
    for (; t + 1 < NT; t += 2) {
        STEP(pB0, pB1, pA0, pA1, t, (t + 3 < NT), (t + 1 < NT), (t + 1 < NT), (t + 1 < NT));     ENDW(t);     ROT();
        STEP(pA0, pA1, pB0, pB1, t + 1, (t + 4 < NT), (t + 2 < NT), (t + 2 < NT), (t + 2 < NT)); ENDW(t + 1); ROT();
    }
    STEP(pB0, pB1, pA0, pA1, NT - 1, false, false, false, false);
    { float sacc = pB0[0] + pB0[1];
#pragma unroll
      for (int r = 2; r < 16; ++r) sacc += pB0[r];
#pragma unroll
      for (int r = 0; r < 16; ++r) sacc += pB1[r];
      l_reg += sacc;
      pw0 = (u32x4){PKW(pB0, 0), PKW(pB0, 2), PKW(pB0, 4), PKW(pB0, 6)}; pw1 = (u32x4){PKW(pB0, 8), PKW(pB0, 10), PKW(pB0, 12), PKW(pB0, 14)}; pw2 = (u32x4){PKW(pB1, 0), PKW(pB1, 2), PKW(pB1, 4), PKW(pB1, 6)}; pw3 = (u32x4){PKW(pB1, 8), PKW(pB1, 10), PKW(pB1, 12), PKW(pB1, 14)};
      SBAR(); pv(o, vb0 + sl_cur, PAF(0), PAF(1), PAF(2), PAF(3)); }
#undef PKW
#undef PAF
#undef VFR
#undef PIN
#undef GAPA
#undef GAPB
#undef EX
#undef VRD
#undef KRD
#undef STEP
#undef ENDW
    if (nqb >= 0) { asm volatile("s_waitcnt lgkmcnt(0)\n\ts_barrier" ::: "memory");
        int t0n = 0; { const LAS float* nc = (const LAS float*)(shm3 + LDS_CUM); const float nq0 = nc[nqb * QB]; const int tmax = (nqb * QB + QB) / KVBLK - 4;
          while (t0n + 2 <= tmax && nq0 - nc[KVBLK * (t0n + 2) - 1] > fthr) t0n += 2; }
        const long dt = (long)(t0n - t0) * KVBLK * DM;
        glds16(ksrc + dt, (unsigned)__builtin_amdgcn_readfirstlane(kdst)); glds16(vsrc + dt, (unsigned)__builtin_amdgcn_readfirstlane(vdst)); glds16(ksrc + dt + (long)KVBLK * DM, (unsigned)__builtin_amdgcn_readfirstlane(kdst + SLOTB)); }
    { auto rr = __builtin_amdgcn_permlane32_swap(__float_as_uint(l_reg), __float_as_uint(l_reg), false, false); l_reg = __uint_as_float(rr[0]) + __uint_as_float(rr[1]); }
    if (hi == 0) wsf[32 + r32] = l_reg; asm volatile("s_waitcnt lgkmcnt(0)" ::: "memory");
    float rli[16];
#pragma unroll
    for (int r = 0; r < 16; ++r) rli[r] = __builtin_amdgcn_rcpf(wsf[32 + crow(r, hi)]);
    bf16* Ow = O + (rowbase + q0 + wid * QBLK) * DMODEL + h * D;
    { bf16* stg = (bf16*)(shm + LDS_OST) + wid * 2048;
#pragma unroll
      for (int r = 0; r < 16; ++r) { const int orow = crow(r, hi);
#pragma unroll
          for (int d0 = 0; d0 < 2; ++d0) stg[orow * 64 + d0 * 32 + r32] = __float2bfloat16(o[d0][r] * rli[r]); }
      asm volatile("s_waitcnt lgkmcnt(0)" ::: "memory");
      const int ch = lane & 7; const f32x4 g0 = *(const LAS f32x4*)(shm3 + LDS_OG + ch * 32), g1 = *(const LAS f32x4*)(shm3 + LDS_OG + ch * 32 + 16);
#pragma unroll
      for (int i = 0; i < 4; ++i) { const int row = i * 8 + (lane >> 3); const u32x4 v = *(const u32x4*)(stg + row * 64 + ch * 8);
          float f[8]; f[0] = bf_lo(v.x); f[1] = bf_hi(v.x); f[2] = bf_lo(v.y); f[3] = bf_hi(v.y); f[4] = bf_lo(v.z); f[5] = bf_hi(v.z); f[6] = bf_lo(v.w); f[7] = bf_hi(v.w);
          float ss = 0.f;
#pragma unroll
          for (int j = 0; j < 8; ++j) ss += f[j] * f[j];
          ss += __shfl_xor(ss, 1); ss += __shfl_xor(ss, 2); ss += __shfl_xor(ss, 4);
          const float rs = __builtin_amdgcn_rsqf(ss * (1.0f / 64.0f) + NORM_EPS);
          u32x4 w; w.x = cvtpk_s(f[0] * rs * g0[0], f[1] * rs * g0[1]); w.y = cvtpk_s(f[2] * rs * g0[2], f[3] * rs * g0[3]); w.z = cvtpk_s(f[4] * rs * g1[0], f[5] * rs * g1[1]); w.w = cvtpk_s(f[6] * rs * g1[2], f[7] * rs * g1[3]);
          *(u32x4*)(Ow + (long)row * DMODEL + ch * 8) = w; } }
    asm volatile("s_waitcnt lgkmcnt(0)\n\ts_barrier" ::: "memory");
#undef DMA_K
#undef DMA_V
#undef CMASK
#undef CKL
#undef ROT
}
constexpr int ATTN_LDS_BYTES = LDS_BYTES;

__device__ __forceinline__ float attn_prep(int b, int h, const float* logf, const float* gq, const float* gk, const float* og, char* shm) {
    int tid = threadIdx.x; asm volatile("" : "+v"(tid));
    const int lane = tid & 63, wid = tid >> 6;
    LAS float* cum = (LAS float*)((lds_cptr)shm + LDS_CUM);
    LAS float* wtot = (LAS float*)((lds_cptr)shm + LDS_WS);
    const float* src = logf + ((size_t)b * SEQ + 4 * tid) * AH + h;
    float v0 = src[0], v1 = src[AH], v2 = src[2 * AH], v3 = src[3 * AH];
    v1 += v0; v2 += v1; v3 += v2;
    float inc = v3;
#pragma unroll
    for (int o = 1; o < 64; o <<= 1) { const float y = __shfl_up(inc, o); if (lane >= o) inc += y; }
    if (lane == 63) wtot[wid] = inc;
    if (tid < D) *(LAS float*)((lds_cptr)shm + LDS_OG + tid * 4) = og[h * D + tid];
    float mq = fabsf(gq[lane]), mk = fabsf(gk[lane]);
#pragma unroll
    for (int o = 1; o < 64; o <<= 1) { mq = fmaxf(mq, __shfl_xor(mq, o)); mk = fmaxf(mk, __shfl_xor(mk, o)); }
    __syncthreads();
    float off = inc - v3;
    for (int w = 0; w < wid; ++w) off += wtot[w];
    *(LAS f32x4*)(cum + 4 * tid) = (f32x4){-(off + v0) * LOG2E, -(off + v1) * LOG2E, -(off + v2) * LOG2E, -(off + v3) * LOG2E};
    __syncthreads();
    return 8.0f * mq * mk * LOG2E;
}
#undef SBAR
#undef WAIT_BAR
}
namespace hgrn {
constexpr int C = 64, NCHUNK = SEQ / C;
constexpr int RS = 272, RS64 = 144;
constexpr int L_QT = 0, L_KT = 17408, L_QH = 34816, L_KHT = 52224, L_VT = 70656, L_ST = 89088, L_P = 123904, L_DL = 133120, L_OG = 133632, L_OUT = 134144, L_BYTES = 151552;
__device__ __forceinline__ bf16x8 frag(LAS unsigned char* lds, int base, int row, int rs, int kb) { return *(const LAS bf16x8*)(lds + base + row * rs + kb); }
__device__ __forceinline__ bf16x8 fragr(LAS unsigned char* lds, int base, int row, int kb) { return *(const LAS bf16x8*)(lds + base + row * RS + ((kb + ((row >> 3) << 5)) & 255)); }
__device__ __forceinline__ float h_lo(unsigned u) { h16x2 v = __builtin_bit_cast(h16x2, u); return (float)v.x; }
__device__ __forceinline__ float h_hi(unsigned u) { h16x2 v = __builtin_bit_cast(h16x2, u); return (float)v.y; }

template <int SKH = 0>
__device__ __forceinline__ void hgrn_unit(int b, int h, const bf16_t* P, bf16_t* AO, const float* og, LAS unsigned char* lds) {
#define HG_SYNC() do { if constexpr (SKH != 4) __syncthreads(); } while (0)
    int tid = threadIdx.x; asm volatile("" : "+v"(tid));
    const int lane = tid & 63, w = __builtin_amdgcn_readfirstlane(tid >> 6);
    const int cp = lane & 7, oct = lane >> 3, fr = lane & 15, fq = lane >> 4;
    const int k0 = 16 * w + 2 * cp;
    const size_t rowbase = (size_t)b * SEQ;
    const bf16_t* pq = P + (rowbase + 8 * oct) * PW + PC_HQ + h * HK + k0;
    const bf16_t* pg = P + (rowbase + 8 * oct) * PW + PC_HG + h * HK + k0;
    const bf16_t* pv = P + (rowbase + 8 * oct) * PW + PC_HV + h * HK + k0;
    const int tn = tid >> 3, seg = tid & 7;
    const bf16_t* pgate = P + (rowbase + tn) * PW + PC_HO + h * HK + 16 * seg;
    bf16_t* pout = AO + (rowbase + tn) * DMODEL + AW + h * HK + 16 * seg;
    if (tid < HK) *(LAS float*)(lds + L_OG + tid * 4) = og[h * HK + tid];
    for (int i = tid; i < (128 * RS) / 16; i += 512) *(LAS u32x4*)(lds + L_ST + i * 16) = (u32x4){0u, 0u, 0u, 0u};
    f32x4 sacc[8];
#pragma unroll
    for (int i = 0; i < 8; ++i) sacc[i] = (f32x4){0.f, 0.f, 0.f, 0.f};
    unsigned rq[8], rg[8], rv[8];
#pragma unroll
    for (int i = 0; i < 8; ++i) { rq[i] = *(const unsigned*)(pq + (size_t)i * PW); rg[i] = *(const unsigned*)(pg + (size_t)i * PW); rv[i] = *(const unsigned*)(pv + (size_t)i * PW); }
    const int ti = w >> 1, vh = w & 1;
#define HG_NORM(cc, G0, G1) do { if constexpr (SKH != 3) { \
        const u32x4 oa = *(const LAS u32x4*)(lds + L_OUT + tn * RS + 32 * seg), ob = *(const LAS u32x4*)(lds + L_OUT + tn * RS + 32 * seg + 16); \
        const unsigned ou[8] = {oa.x, oa.y, oa.z, oa.w, ob.x, ob.y, ob.z, ob.w}; float ss = 0.f; \
        _Pragma("unroll") for (int j = 0; j < 8; ++j) ss += bf_lo(ou[j]) * bf_lo(ou[j]) + bf_hi(ou[j]) * bf_hi(ou[j]); \
        ss += __shfl_xor(ss, 1); ss += __shfl_xor(ss, 2); ss += __shfl_xor(ss, 4); \
        const float rs = __builtin_amdgcn_rsqf(ss * (1.0f / 128.0f) + NORM_EPS); \
        const unsigned gw[8] = {G0.x, G0.y, G0.z, G0.w, G1.x, G1.y, G1.z, G1.w}; unsigned ow[8]; \
        _Pragma("unroll") for (int j = 0; j < 4; ++j) { const f32x4 g = *(const LAS f32x4*)(lds + L_OG + (16 * seg + 4 * j) * 4); \
            ow[2 * j] = cvt_pk_bf16(bf_lo(ou[2 * j]) * rs * g[0] * bf_lo(gw[2 * j]), bf_hi(ou[2 * j]) * rs * g[1] * bf_hi(gw[2 * j])); \
            ow[2 * j + 1] = cvt_pk_bf16(bf_lo(ou[2 * j + 1]) * rs * g[2] * bf_lo(gw[2 * j + 1]), bf_hi(ou[2 * j + 1]) * rs * g[3] * bf_hi(gw[2 * j + 1])); } \
        bf16_t* po = pout + (size_t)(C * (cc)) * DMODEL; \
        *(u32x4*)po = (u32x4){ow[0], ow[1], ow[2], ow[3]}; *(u32x4*)(po + 8) = (u32x4){ow[4], ow[5], ow[6], ow[7]}; } } while (0)
#pragma unroll 1
    for (int c = 0; c < NCHUNK; ++c) {
        const int cprev = c > 0 ? c - 1 : 0;
        const u32x4 gt0 = *(const u32x4*)(pgate + (size_t)(C * cprev) * PW), gt1 = *(const u32x4*)(pgate + (size_t)(C * cprev) * PW + 8);
        if constexpr (SKH != 2) {
            float f0[8], f1[8], p0[8], p1[8], s0[8], s1[8];
#pragma unroll
            for (int i = 0; i < 8; ++i) { f0[i] = h_lo(rg[i]); f1[i] = h_hi(rg[i]); }
            p0[0] = f0[0]; p1[0] = f1[0];
#pragma unroll
            for (int i = 1; i < 8; ++i) { p0[i] = p0[i - 1] * f0[i]; p1[i] = p1[i - 1] * f1[i]; }
            s0[7] = 1.0f; s1[7] = 1.0f;
#pragma unroll
            for (int i = 6; i >= 0; --i) { s0[i] = s0[i + 1] * f0[i + 1]; s1[i] = s1[i + 1] * f1[i + 1]; }
            const float lt0 = __builtin_amdgcn_logf(p0[7]), lt1 = __builtin_amdgcn_logf(p1[7]);
            float x0 = lt0, x1 = lt1;
#pragma unroll
            for (int o = 8; o < 64; o <<= 1) { const float y0 = __shfl_up(x0, o), y1 = __shfl_up(x1, o); if (lane >= o) { x0 += y0; x1 += y1; } }
            const float off0 = x0 - lt0, off1 = x1 - lt1;
            const float a0 = __shfl(x0, cp + 24), a1 = __shfl(x1, cp + 24), e0 = __shfl(x0, cp + 56), e1 = __shfl(x1, cp + 56);
            const float Eq0 = __builtin_amdgcn_exp2f(fminf(off0 - a0, 120.f)), Eq1 = __builtin_amdgcn_exp2f(fminf(off1 - a1, 120.f));
            const float Ek0 = __builtin_amdgcn_exp2f(fminf(a0 - x0, 120.f)), Ek1 = __builtin_amdgcn_exp2f(fminf(a1 - x1, 120.f));
            const float Eh0 = __builtin_amdgcn_exp2f(off0), Eh1 = __builtin_amdgcn_exp2f(off1);
            const float El0 = __builtin_amdgcn_exp2f(e0 - x0), El1 = __builtin_amdgcn_exp2f(e1 - x1);
            unsigned kh0[4], kh1[4], vt0[4], vt1[4];
            float pkh0 = 0.f, pkh1 = 0.f;
            const int rotw = (32 * (w + oct)) & 255;
#pragma unroll
            for (int i = 0; i < 8; ++i) {
                const int t = 8 * oct + i;
                const float qp0 = bf_lo(rq[i]) * p0[i], qp1 = bf_hi(rq[i]) * p1[i];
                const float ks0 = (1.0f - f0[i]) * s0[i], ks1 = (1.0f - f1[i]) * s1[i];
                *(LAS unsigned*)(lds + L_QT + t * RS + rotw + 4 * cp) = cvt_pk_bf16(qp0 * Eq0, qp1 * Eq1);
                *(LAS unsigned*)(lds + L_KT + t * RS + rotw + 4 * cp) = cvt_pk_bf16(ks0 * Ek0, ks1 * Ek1);
                *(LAS unsigned*)(lds + L_QH + t * RS + rotw + 4 * cp) = cvt_pk_bf16(qp0 * Eh0, qp1 * Eh1);
                const float kha = ks0 * El0, khb = ks1 * El1;
                if (i & 1) { kh0[i >> 1] = cvt_pk_bf16(pkh0, kha); kh1[i >> 1] = cvt_pk_bf16(pkh1, khb); vt0[i >> 1] = (rv[i - 1] & 0xffffu) | (rv[i] << 16); vt1[i >> 1] = (rv[i - 1] >> 16) | (rv[i] & 0xffff0000u); }
                else { pkh0 = kha; pkh1 = khb; }
            }
            *(LAS u32x4*)(lds + L_KHT + k0 * RS64 + 16 * oct) = (u32x4){kh0[0], kh0[1], kh0[2], kh0[3]};
            *(LAS u32x4*)(lds + L_KHT + (k0 + 1) * RS64 + 16 * oct) = (u32x4){kh1[0], kh1[1], kh1[2], kh1[3]};
            *(LAS u32x4*)(lds + L_VT + k0 * RS64 + 16 * oct) = (u32x4){vt0[0], vt0[1], vt0[2], vt0[3]};
            *(LAS u32x4*)(lds + L_VT + (k0 + 1) * RS64 + 16 * oct) = (u32x4){vt1[0], vt1[1], vt1[2], vt1[3]};
            if (oct == 0) *(LAS f32x2*)(lds + L_DL + k0 * 4) = (f32x2){__builtin_amdgcn_exp2f(e0), __builtin_amdgcn_exp2f(e1)};
        }
        if (c + 1 < NCHUNK) {
#pragma unroll
            for (int i = 0; i < 8; ++i) { const size_t o = (size_t)(C * (c + 1) + i) * PW; rq[i] = *(const unsigned*)(pq + o); rg[i] = *(const unsigned*)(pg + o); rv[i] = *(const unsigned*)(pv + o); }
        }
        HG_SYNC();
        f32x4 oacc[4] = {(f32x4){0.f, 0.f, 0.f, 0.f}, (f32x4){0.f, 0.f, 0.f, 0.f}, (f32x4){0.f, 0.f, 0.f, 0.f}, (f32x4){0.f, 0.f, 0.f, 0.f}};
        if constexpr (SKH != 1) {
            bf16x8 qf[4];
#pragma unroll
            for (int ks = 0; ks < 4; ++ks) qf[ks] = fragr(lds, L_QT, 16 * ti + fr, 64 * ks + 16 * fq);
#pragma unroll
            for (int sj = 0; sj < 2; ++sj) { const int si = 2 * vh + sj; u32x2 pk = (u32x2){0u, 0u};
                if (si <= ti) { f32x4 a = (f32x4){0.f, 0.f, 0.f, 0.f};
#pragma unroll
                    for (int ks = 0; ks < 4; ++ks) a = __builtin_amdgcn_mfma_f32_16x16x32_bf16(fragr(lds, L_KT, 16 * si + fr, 64 * ks + 16 * fq), qf[ks], a, 0, 0, 0);
                    const int s0 = 16 * si + 4 * fq, t = 16 * ti + fr;
#pragma unroll
                    for (int e = 0; e < 4; ++e) a[e] = (s0 + e <= t) ? a[e] : 0.f;
                    pk.x = cvt_pk_bf16(a[0], a[1]); pk.y = cvt_pk_bf16(a[2], a[3]); }
                *(LAS u32x2*)(lds + L_P + (16 * ti + fr) * RS64 + (16 * si + 4 * fq) * 2) = pk; }
#pragma unroll
            for (int ks = 0; ks < 4; ++ks) qf[ks] = fragr(lds, L_QH, 16 * ti + fr, 64 * ks + 16 * fq);
#pragma unroll
            for (int vj = 0; vj < 4; ++vj) { oacc[vj] = (f32x4){0.f, 0.f, 0.f, 0.f};
#pragma unroll
                for (int ks = 0; ks < 4; ++ks) oacc[vj] = __builtin_amdgcn_mfma_f32_16x16x32_bf16(frag(lds, L_ST, 16 * (4 * vh + vj) + fr, RS, 64 * ks + 16 * fq), qf[ks], oacc[vj], 0, 0, 0); }
        }
        if (c > 0) HG_NORM(c - 1, gt0, gt1);
        HG_SYNC();
        if constexpr (SKH != 1) {
            bf16x8 pf[2];
#pragma unroll
            for (int ks = 0; ks < 2; ++ks) pf[ks] = frag(lds, L_P, 16 * ti + fr, RS64, 64 * ks + 16 * fq);
#pragma unroll
            for (int vj = 0; vj < 4; ++vj)
#pragma unroll
                for (int ks = 0; ks < 2; ++ks) oacc[vj] = __builtin_amdgcn_mfma_f32_16x16x32_bf16(frag(lds, L_VT, 16 * (4 * vh + vj) + fr, RS64, 64 * ks + 16 * fq), pf[ks], oacc[vj], 0, 0, 0);
            const f32x4 dl = *(const LAS f32x4*)(lds + L_DL + (16 * w + 4 * fq) * 4);
            bf16x8 kf[2];
#pragma unroll
            for (int ks = 0; ks < 2; ++ks) kf[ks] = frag(lds, L_KHT, 16 * w + fr, RS64, 64 * ks + 16 * fq);
#pragma unroll
            for (int vt = 0; vt < 8; ++vt) { sacc[vt] = sacc[vt] * dl;
#pragma unroll
                for (int ks = 0; ks < 2; ++ks) sacc[vt] = __builtin_amdgcn_mfma_f32_16x16x32_bf16(kf[ks], frag(lds, L_VT, 16 * vt + fr, RS64, 64 * ks + 16 * fq), sacc[vt], 0, 0, 0);
                u32x2 sk; sk.x = cvt_pk_bf16(sacc[vt][0], sacc[vt][1]); sk.y = cvt_pk_bf16(sacc[vt][2], sacc[vt][3]);
                *(LAS u32x2*)(lds + L_ST + (16 * vt + fr) * RS + (16 * w + 4 * fq) * 2) = sk; }
#pragma unroll
            for (int vj = 0; vj < 4; ++vj) *(LAS u32x2*)(lds + L_OUT + (16 * ti + fr) * RS + (16 * (4 * vh + vj) + 4 * fq) * 2) = (u32x2){cvt_pk_bf16(oacc[vj][0], oacc[vj][1]), cvt_pk_bf16(oacc[vj][2], oacc[vj][3])};
        }
        HG_SYNC();
    }
    { const u32x4 gt0 = *(const u32x4*)(pgate + (size_t)(C * (NCHUNK - 1)) * PW), gt1 = *(const u32x4*)(pgate + (size_t)(C * (NCHUNK - 1)) * PW + 8); HG_NORM(NCHUNK - 1, gt0, gt1); }
    HG_SYNC();
#undef HG_NORM
#undef HG_SYNC
}
}
constexpr int NWAVES = 8;
constexpr size_t MiB = 1u << 20;
constexpr size_t WS_CTL = 0, CTL_ZERO_BYTES = 1 * MiB;
constexpr size_t WS_MOD = 1 * MiB;
constexpr size_t WS_LOGF = 2 * MiB;
constexpr size_t WS_WIN = 4 * MiB;
constexpr size_t WS_WO = 12 * MiB;
constexpr size_t WS_W1 = 14 * MiB;
constexpr size_t WS_WD = 46 * MiB;
constexpr size_t WS_LIST = 62 * MiB;
constexpr size_t WS_LW = 68 * MiB;
constexpr size_t WS_XN = 80 * MiB;
constexpr size_t WS_AO = 208 * MiB;
constexpr size_t WS_PROJ = 336 * MiB;
constexpr size_t WS_X1 = 784 * MiB;
constexpr size_t WS_END = 912 * MiB;
constexpr int CW_BAR = 4096, CW_CNT = 16384;

constexpr int RING_OFF = 0, RING_BYTES = 155648;
constexpr int LDSCTL_OFF = RING_BYTES, MISC_OFF = LDSCTL_OFF + 64, TAB_OFF = LDSCTL_OFF + 256;
constexpr int LDS_BYTES = RING_BYTES + 1024;
static_assert(hgrn::L_BYTES <= RING_BYTES && attn_body::ATTN_LDS_BYTES <= RING_BYTES && pg8::STAGE_BYTES <= RING_BYTES, "LDS map");

typedef GAS unsigned gu32;
#define RLX_AGENT __ATOMIC_RELAXED, __HIP_MEMORY_SCOPE_AGENT
#define LDS_WAIT() asm volatile("s_waitcnt lgkmcnt(0)" ::: "memory")

#define XB_TMO      128
#define XB_XCNT(j)  (256  + 64 * (j))
#define XB_XSUB(j)  (1280 + 64 * (j))
#define XB_XGEN(j)  (2304 + 64 * (j))
#define XB_TOP      3328
#define XB_TOPGEN   3392
#define XCD_BAR_WORDS 3456
#define XB_SPIN_CAP (1u << 20)
__device__ __forceinline__ unsigned xb_ld(unsigned* p)              { return __hip_atomic_load(p, __ATOMIC_RELAXED, __HIP_MEMORY_SCOPE_AGENT); }
__device__ __forceinline__ unsigned xb_add(unsigned* p, unsigned v) { return __hip_atomic_fetch_add(p, v, __ATOMIC_RELAXED, __HIP_MEMORY_SCOPE_AGENT); }
__device__ __forceinline__ unsigned xb_xcc_id() { return (unsigned)__builtin_amdgcn_s_getreg((3 << 11) | 20) & 0xFu; }
#define XB_SPIN(cond, bar) do { unsigned _sp = 0; while (cond) { __builtin_amdgcn_s_sleep(1); \
    if ((++_sp & 255u) == 0u) { if (xb_ld(&(bar)[XB_TMO])) break; if (_sp > XB_SPIN_CAP) { atomicAdd(&(bar)[XB_TMO], 1u); break; } } } } while (0)
struct XcdBarrier { unsigned* bar; unsigned x; volatile LAS unsigned* st; };
__device__ __forceinline__ XcdBarrier xcd_barrier_post(unsigned* bar, volatile LAS unsigned* st) {
    XcdBarrier b; b.bar = bar; b.x = xb_xcc_id(); b.st = st;
    if (threadIdx.x == 0) (void)xb_add(&bar[XB_XCNT(b.x)], 1u);
    return b;
}
__device__ __forceinline__ void xcd_barrier_complete(unsigned* bar, unsigned x, unsigned& nloc, unsigned& nx) {
    const unsigned G = gridDim.x * gridDim.y * gridDim.z;
    unsigned sum, cnt, mine, sp = 0u;
    for (;;) {
        sum = 0u; cnt = 0u; mine = 0u;
#pragma unroll
        for (unsigned j = 0; j < 16; ++j) { const unsigned c = xb_ld(&bar[XB_XCNT(j)]); sum += c; cnt += (c > 0u) ? 1u : 0u; mine = (j == x) ? c : mine; }
        if (sum == G) break;
        __builtin_amdgcn_s_sleep(1);
        if ((++sp & 255u) == 0u) { if (xb_ld(&bar[XB_TMO])) break; if (sp > XB_SPIN_CAP) { atomicAdd(&bar[XB_TMO], 1u); break; } }
    }
    nloc = mine > 0u ? mine : 1u; nx = cnt > 0u ? cnt : 1u;
}
__device__ __forceinline__ void xcd_barrier(const XcdBarrier& b) {
    asm volatile("s_waitcnt vmcnt(0)" ::: "memory");
    __syncthreads();
    if (threadIdx.x == 0) {
        unsigned* bar = b.bar;
        __builtin_amdgcn_s_waitcnt(0);
        unsigned nloc = b.st[0], nx = b.st[1];
        if (nloc == 0u) { xcd_barrier_complete(bar, b.x, nloc, nx); b.st[0] = nloc; b.st[1] = nx; }
        const unsigned old = xb_add(&bar[XB_XSUB(b.x)], 1u);
        const unsigned gen = old / nloc;
        if (old + 1u == (gen + 1u) * nloc) {
            __builtin_amdgcn_fence(__ATOMIC_RELEASE, "agent");
            asm volatile("s_waitcnt vmcnt(0)" ::: "memory");
            const unsigned og = xb_add(&bar[XB_TOP], 1u);
            const unsigned tg = og / nx;
            if (og + 1u == (tg + 1u) * nx) xb_add(&bar[XB_TOPGEN], 1u);
            else XB_SPIN(xb_ld(&bar[XB_TOPGEN]) == tg, bar);
            __builtin_amdgcn_fence(__ATOMIC_ACQUIRE, "agent");
            xb_add(&bar[XB_XGEN(b.x)], 1u);
            asm volatile("s_waitcnt vmcnt(0)" ::: "memory");
        } else {
            XB_SPIN(xb_ld(&bar[XB_XGEN(b.x)]) == gen, bar);
            __builtin_amdgcn_fence(__ATOMIC_ACQUIRE, "agent");
            asm volatile("s_waitcnt vmcnt(0)" ::: "memory");
        }
    }
    __syncthreads();
}

__device__ __forceinline__ f32x2 lo2(f32x4 v) { return __builtin_shufflevector(v, v, 0, 1); }
__device__ __forceinline__ f32x2 hi2(f32x4 v) { return __builtin_shufflevector(v, v, 2, 3); }
__device__ __forceinline__ f32x2 fma2(f32x2 a, f32x2 b, f32x2 c) { return __builtin_elementwise_fma(a, b, c); }
__device__ __forceinline__ float wave_sum(float v) {
#pragma unroll
    for (int o = 1; o < 64; o <<= 1) v += __shfl_xor(v, o);
    return v;
}
__device__ __forceinline__ unsigned f2bf(float f) { unsigned u = __builtin_bit_cast(unsigned, f); return (u + 0x7fffu + ((u >> 16) & 1u)) >> 16; }
__device__ __forceinline__ unsigned pk2(float lo, float hi) { return f2bf(lo) | (f2bf(hi) << 16); }

__device__ __forceinline__ void transpose_item(const float* W, int ldw, bf16_t* WT, int ldt, LAS float* scr, int lane) {
    float tv[32];
#pragma unroll
    for (int i = 0; i < 32; ++i) tv[i] = W[(size_t)(2 * i + (lane >> 5)) * ldw + (lane & 31)];
#pragma unroll
    for (int i = 0; i < 32; ++i) scr[(2 * i + (lane >> 5)) * 33 + (lane & 31)] = tv[i];
    LDS_WAIT(); asm volatile("" ::: "memory");
    const int c = lane & 7;
#pragma unroll
    for (int j = 0; j < 4; ++j) { const int n = (lane >> 3) + 8 * j; const LAS float* s = scr + (8 * c) * 33 + n;
        u32x4 o; o.x = pk2(s[0 * 33], s[1 * 33]); o.y = pk2(s[2 * 33], s[3 * 33]); o.z = pk2(s[4 * 33], s[5 * 33]); o.w = pk2(s[6 * 33], s[7 * 33]);
        *(GAS u32x4*)(WT + (size_t)n * ldt + 8 * c) = o; }
    LDS_WAIT(); asm volatile("" ::: "memory");
}

__device__ __forceinline__ void transpose_item_fp8(const float* W, int ldw, unsigned char* WT, int ldt, LAS float* scr, int lane, float scale) {
    float tv[32];
#pragma unroll
    for (int i = 0; i < 32; ++i) tv[i] = W[(size_t)(2 * i + (lane >> 5)) * ldw + (lane & 31)];
#pragma unroll
    for (int i = 0; i < 32; ++i) scr[(2 * i + (lane >> 5)) * 33 + (lane & 31)] = tv[i] * scale;
    LDS_WAIT(); asm volatile("" ::: "memory");
    const int c = lane & 3;
#pragma unroll
    for (int j = 0; j < 2; ++j) { const int n = (lane >> 2) + 16 * j; const LAS float* s = scr + (16 * c) * 33 + n;
        u32x4 o; o.x = pg8::pk4_fp8(s[0 * 33], s[1 * 33], s[2 * 33], s[3 * 33]); o.y = pg8::pk4_fp8(s[4 * 33], s[5 * 33], s[6 * 33], s[7 * 33]);
        o.z = pg8::pk4_fp8(s[8 * 33], s[9 * 33], s[10 * 33], s[11 * 33]); o.w = pg8::pk4_fp8(s[12 * 33], s[13 * 33], s[14 * 33], s[15 * 33]);
        *(GAS u32x4*)(WT + (size_t)n * ldt + 16 * c) = o; }
    LDS_WAIT(); asm volatile("" ::: "memory");
}

struct Args { const float* in[21]; float* out; unsigned char* ws; int ph_lo, ph_hi; };

__device__ __forceinline__ void p0_phase(const Args& a, LAS unsigned char* lds, int vcu, int G, int tid_, int lane_, int wave) {
    int tid = tid_; asm volatile("" : "+v"(tid)); const int lane = tid & 63;
    const float* c = a.in[1]; const float* w_ada = a.in[2]; const float* b_ada = a.in[3];
    float* mod = (float*)(a.ws + WS_MOD);
    LAS float* sc = (LAS float*)lds;
    for (int cb = vcu; cb < 6144 / 24; cb += G) {
#pragma unroll 1
        for (int i0 = tid; i0 < BATCH * DMODEL; i0 += 512 * 16) { float cv[16];
#pragma unroll
            for (int u = 0; u < 16; ++u) cv[u] = c[i0 + 512 * u];
#pragma unroll
            for (int u = 0; u < 16; ++u) { const int i = i0 + 512 * u, b = i >> 10, k = i & 1023; sc[k * 36 + b] = siluf_(cv[u]); } }
        __syncthreads();
        const int col = tid % 24, kg = tid / 24;
        float acc[32];
#pragma unroll
        for (int b = 0; b < 32; ++b) acc[b] = 0.f;
        if (kg < 16) {
            const float* wp = w_ada + (size_t)(kg * 64) * 6144 + cb * 24 + col;
            float wv[64];
#pragma unroll
            for (int k = 0; k < 64; ++k) wv[k] = wp[(size_t)k * 6144];
#pragma unroll
            for (int k = 0; k < 64; ++k) { const float w = wv[k]; const LAS f32x4* s4 = (const LAS f32x4*)(sc + (kg * 64 + k) * 36);
#pragma unroll
                for (int q = 0; q < 8; ++q) { const f32x4 s = s4[q]; acc[4 * q] += s[0] * w; acc[4 * q + 1] += s[1] * w; acc[4 * q + 2] += s[2] * w; acc[4 * q + 3] += s[3] * w; } }
        }
        __syncthreads();
        LAS float* red = (LAS float*)lds;
        if (kg < 16) {
#pragma unroll
            for (int b = 0; b < 32; ++b) red[(kg * 32 + b) * 24 + col] = acc[b]; }
        __syncthreads();
        for (int o = tid; o < 32 * 24; o += 512) { const int b = o / 24, cc = o % 24; float s = 0.f;
#pragma unroll
            for (int g = 0; g < 16; ++g) s += red[(g * 32 + b) * 24 + cc];
            mod[(size_t)b * 6144 + cb * 24 + cc] = s + b_ada[cb * 24 + cc]; }
        __syncthreads();
    }
}

constexpr int W_I_IN = 16 * 112, W_I_OUT = 16 * 32, W_I_G = 16 * 256, W_I_U = 16 * 256, W_I_D = 16 * 256, W_ITEMS = W_I_IN + W_I_OUT + W_I_G + W_I_U + W_I_D;
__device__ __forceinline__ void weight_item(const Args& a, int it, LAS float* scr, int lane_) {
    int lane = lane_; asm volatile("" : "+v"(lane));
    const float* W; int ldw, ldt; unsigned char* dst; bool f8;
    int r = it;
    if (r < W_I_IN) { const int kb = r / 112, db = r % 112, sc0 = db * 32 + (db >= 48 ? 8 : 0);
        W = a.in[5] + (size_t)(64 * kb) * INW + sc0; ldw = INW; dst = a.ws + WS_WIN + ((size_t)(db * 32) * 1024 + 64 * kb) * 2; ldt = 2048; f8 = false; }
    else if ((r -= W_I_IN) < W_I_OUT) { const int kb = r / 32, nb = r % 32;
        W = a.in[12] + (size_t)(64 * kb) * 1024 + 32 * nb; ldw = 1024; dst = a.ws + WS_WO + ((size_t)(32 * nb) * 1024 + 64 * kb) * 2; ldt = 2048; f8 = false; }
    else if ((r -= W_I_OUT) < W_I_G + W_I_U) { const bool up = r >= W_I_G; if (up) r -= W_I_G; const int e = r / 256, q = r % 256, kb = q / 16, nb = q % 16;
        W = (up ? a.in[19] : a.in[18]) + (size_t)e * 1024 * 512 + (size_t)(64 * kb) * 512 + 32 * nb; ldw = 512; dst = a.ws + WS_W1 + ((size_t)e * 1024 + (up ? 512 : 0) + 32 * nb) * 1024 + 64 * kb; ldt = 1024; f8 = true; }
    else { r -= W_I_G + W_I_U; const int e = r / 256, q = r % 256, kb = q / 32, nb = q % 32;
        W = a.in[20] + (size_t)e * 512 * 1024 + (size_t)(64 * kb) * 1024 + 32 * nb; ldw = 1024; dst = a.ws + WS_WD + ((size_t)e * 1024 + 32 * nb) * 512 + 64 * kb; ldt = 512; f8 = true; }
    const float scale = f8 ? W_SCALE : 1.0f;
    const float* wp = W + (size_t)(lane >> 5) * ldw + (lane & 31);
#pragma unroll
    for (int hh = 0; hh < 2; ++hh) { float tv[16];
#pragma unroll
        for (int i = 0; i < 16; ++i) tv[i] = wp[(size_t)(2 * (16 * hh + i)) * ldw];
#pragma unroll
        for (int i = 0; i < 16; ++i) scr[(2 * (16 * hh + i) + (lane >> 5)) * 33 + (lane & 31)] = tv[i] * scale; }
    LDS_WAIT(); asm volatile("" ::: "memory");
    if (f8) { const int c = lane & 3;
#pragma unroll
        for (int j = 0; j < 2; ++j) { const int n = (lane >> 2) + 16 * j; const LAS float* sp = scr + (16 * c) * 33 + n;
            u32x4 o; o.x = pg8::pk4_fp8(sp[0 * 33], sp[1 * 33], sp[2 * 33], sp[3 * 33]); o.y = pg8::pk4_fp8(sp[4 * 33], sp[5 * 33], sp[6 * 33], sp[7 * 33]);
            o.z = pg8::pk4_fp8(sp[8 * 33], sp[9 * 33], sp[10 * 33], sp[11 * 33]); o.w = pg8::pk4_fp8(sp[12 * 33], sp[13 * 33], sp[14 * 33], sp[15 * 33]);
            *(GAS u32x4*)(dst + (size_t)n * ldt + 16 * c) = o; } }
    else { const int c = lane & 7;
#pragma unroll
        for (int j = 0; j < 4; ++j) { const int n = (lane >> 3) + 8 * j; const LAS float* sp = scr + (8 * c) * 33 + n;
            u32x4 o; o.x = pk2(sp[0 * 33], sp[1 * 33]); o.y = pk2(sp[2 * 33], sp[3 * 33]); o.z = pk2(sp[4 * 33], sp[5 * 33]); o.w = pk2(sp[6 * 33], sp[7 * 33]);
            *(GAS u32x4*)(dst + (size_t)n * ldt + 16 * c) = o; } }
    LDS_WAIT(); asm volatile("" ::: "memory");
}

__device__ __forceinline__ void reduce_scatter16(float (&v)[16], int lane) {
    { const bool hi = lane & 32;
#pragma unroll
      for (int i = 0; i < 8; ++i) { const float snd = hi ? v[i] : v[8 + i], kp = hi ? v[8 + i] : v[i]; v[i] = kp + __shfl_xor(snd, 32); } }
    { const bool hi = lane & 16;
#pragma unroll
      for (int i = 0; i < 4; ++i) { const float snd = hi ? v[i] : v[4 + i], kp = hi ? v[4 + i] : v[i]; v[i] = kp + __shfl_xor(snd, 16); } }
    { const bool hi = lane & 8;
#pragma unroll
      for (int i = 0; i < 2; ++i) { const float snd = hi ? v[i] : v[2 + i], kp = hi ? v[2 + i] : v[i]; v[i] = kp + __shfl_xor(snd, 8); } }
    { const bool hi = lane & 4; const float snd = hi ? v[0] : v[1], kp = hi ? v[1] : v[0]; v[0] = kp + __shfl_xor(snd, 4); }
    v[0] += __shfl_xor(v[0], 2); v[0] += __shfl_xor(v[0], 1);
}
__device__ __forceinline__ void reduce_scatter4(float (&v)[4], int lane) {
    { const bool hi = lane & 32;
#pragma unroll
      for (int i = 0; i < 2; ++i) { const float snd = hi ? v[i] : v[2 + i], kp = hi ? v[2 + i] : v[i]; v[i] = kp + __shfl_xor(snd, 32); } }
    { const bool hi = lane & 16; const float snd = hi ? v[0] : v[1], kp = hi ? v[1] : v[0]; v[0] = kp + __shfl_xor(snd, 16); }
#pragma unroll
    for (int o = 8; o > 0; o >>= 1) v[0] += __shfl_xor(v[0], o);
}
__device__ __forceinline__ void p1_phase(const Args& a, LAS unsigned char* lds, int vcu, int G, int tid_, int lane_, int wave) {
    int tid = tid_; asm volatile("" : "+v"(tid)); const int lane = tid & 63;
    const float* x = a.in[0]; const float* g1 = a.in[4]; const float* w_in = a.in[5]; const float* b_fox = a.in[6];
    const float* mod = (const float*)(a.ws + WS_MOD); float* logf = (float*)(a.ws + WS_LOGF); bf16_t* XN = (bf16_t*)(a.ws + WS_XN);
    LAS float* wf = (LAS float*)lds;
    LAS float* zs = (LAS float*)(lds + 32768) + wave * 256;
    LAS float* scr = (LAS float*)(lds + 40960 + wave * 8448);
    int witem = vcu * NWAVES + wave;
    for (int k = tid; k < 1024; k += 512) { const f32x4 u0 = *(const f32x4*)(w_in + (size_t)k * INW + 1536), u1 = *(const f32x4*)(w_in + (size_t)k * INW + 1540);
#pragma unroll
        for (int h = 0; h < 4; ++h) { wf[h * 1024 + k] = u0[h]; wf[(4 + h) * 1024 + k] = u1[h]; } }
    __syncthreads();
    for (int gw = vcu * NWAVES + wave; gw < MTOK / 32; gw += G * NWAVES) {
        const int row0 = gw * 32, b = row0 >> 11;
        f32x4 A1[4], B1[4];
#pragma unroll
        for (int j = 0; j < 4; ++j) { const int cidx = 4 * lane + 256 * j; const f32x4 g = *(const f32x4*)(g1 + cidx), s = *(const f32x4*)(mod + (size_t)b * 6144 + 1024 + cidx);
            A1[j] = g * (s + 1.0f); B1[j] = *(const f32x4*)(mod + (size_t)b * 6144 + cidx); }
        const float* xp = x + (size_t)row0 * DMODEL + 4 * lane;
        f32x4 va[2][4], vb[2][4];
#define P1_LOAD(buf, rp) do { _Pragma("unroll") for (int q = 0; q < 2; ++q) _Pragma("unroll") for (int j = 0; j < 4; ++j) buf[q][j] = *(const f32x4*)(xp + (size_t)(2 * (rp) + q) * DMODEL + 256 * j); } while (0)
#define P1_BODY(buf, itx) do { const int r0 = row0 + 2 * (itx); float ss[2] = {0.f, 0.f}; f32x4 v[2][4]; \
            _Pragma("unroll") for (int q = 0; q < 2; ++q) { f32x2 s2 = {0.f, 0.f}; _Pragma("unroll") for (int j = 0; j < 4; ++j) { s2 = fma2(lo2(buf[q][j]), lo2(buf[q][j]), s2); s2 = fma2(hi2(buf[q][j]), hi2(buf[q][j]), s2); } ss[q] = s2.x + s2.y; } \
            _Pragma("unroll") for (int q = 0; q < 2; ++q) { const float rstd = __builtin_amdgcn_rsqf(wave_sum(ss[q]) * (1.0f / DMODEL) + NORM_EPS); \
                _Pragma("unroll") for (int j = 0; j < 4; ++j) { v[q][j] = buf[q][j] * rstd * A1[j] + B1[j]; \
                    *(u32x2*)(XN + (size_t)(r0 + q) * DMODEL + 4 * lane + 256 * j) = (u32x2){cvt_pk_bf16(v[q][j][0], v[q][j][1]), cvt_pk_bf16(v[q][j][2], v[q][j][3])}; } } \
            if ((itx) + 2 < 16) P1_LOAD(buf, (itx) + 2); \
            float af[16]; \
            _Pragma("unroll") for (int h = 0; h < 8; ++h) { f32x2 s0 = {0.f, 0.f}, s1 = {0.f, 0.f}; \
                _Pragma("unroll") for (int j = 0; j < 4; ++j) { const f32x4 w = *(const LAS f32x4*)(wf + h * 1024 + 4 * lane + 256 * j); \
                    s0 = fma2(lo2(v[0][j]), lo2(w), s0); s0 = fma2(hi2(v[0][j]), hi2(w), s0); \
                    s1 = fma2(lo2(v[1][j]), lo2(w), s1); s1 = fma2(hi2(v[1][j]), hi2(w), s1); } \
                af[h] = s0.x + s0.y; af[8 + h] = s1.x + s1.y; } \
            reduce_scatter16(af, lane); \
            if ((lane & 3) == 0) zs[(2 * (itx)) * 8 + (lane >> 2)] = af[0]; } while (0)
        P1_LOAD(va, 0); P1_LOAD(vb, 1);
#define P1_WITEM() do { if (witem < W_ITEMS) { weight_item(a, witem, scr, lane); witem += G * NWAVES; } } while (0)
#pragma unroll 1
        for (int it = 0; it < 16; it += 2) { P1_BODY(va, it); P1_BODY(vb, it + 1); P1_WITEM(); }
#undef P1_WITEM
#undef P1_LOAD
#undef P1_BODY
#pragma unroll
        for (int e = 0; e < 4; ++e) { const int idx = lane + 64 * e; const float z = zs[idx] + b_fox[idx & 7];
            logf[(size_t)row0 * AH + idx] = fminf(z, 0.f) - __builtin_amdgcn_logf(1.0f + __builtin_amdgcn_exp2f(-fabsf(z) * LOG2E)) * 0.6931471805599453f; }
    }
    for (; witem < W_ITEMS; witem += G * NWAVES) weight_item(a, witem, scr, lane);
}

__device__ __forceinline__ void p5_phase(const Args& a, LAS unsigned char* lds, int vcu, int G, int tid_, int lane_, int wave) {
    int tid = tid_; asm volatile("" : "+v"(tid)); const int lane = tid & 63, fr = lane & 15, fq = lane >> 4;
    const bf16_t* x1 = (const bf16_t*)(a.ws + WS_X1); const float* g2 = a.in[13]; const float* w_rg = a.in[14]; const float* b_rg = a.in[15]; const float* w_re = a.in[16]; const float* b_re = a.in[17];
    const float* mod = (const float*)(a.ws + WS_MOD); unsigned char* XN8 = a.ws + WS_XN;
    int* list = (int*)(a.ws + WS_LIST); f32x2* lw = (f32x2*)(a.ws + WS_LW); unsigned* gcnt = (unsigned*)(a.ws + WS_CTL) + CW_CNT;
    constexpr int WROW = 2064;
    LAS unsigned char* wth = lds; LAS unsigned char* wtl = lds + 20 * WROW;
    LAS float* ab = (LAS float*)(lds + 40 * WROW);
    LAS float* bias = (LAS float*)(lds + 40 * WROW + 8192);
    LAS int* hist = (LAS int*)(lds + 40 * WROW + 8192 + 128);
    LAS float* zs = (LAS float*)(lds + 40 * WROW + 8192 + 128 + 256) + wave * (32 * 20);
    for (int k = tid; k < 1024; k += 512) { const f32x4 g4 = *(const f32x4*)(w_rg + 4 * k);
#pragma unroll
        for (int o = 0; o < 20; ++o) { float wv; if (o < 4) wv = g4[o]; else { const f32x4 e4 = *(const f32x4*)(w_re + 16 * k + 4 * ((o - 4) >> 2)); wv = e4[(o - 4) & 3]; }
            const unsigned hb = f2bf(wv); const float hf = __uint_as_float(hb << 16); const unsigned lb = f2bf(wv - hf);
            *(LAS unsigned short*)(wth + o * WROW + 2 * k) = (unsigned short)hb; *(LAS unsigned short*)(wtl + o * WROW + 2 * k) = (unsigned short)lb; } }
    if (tid < 4) bias[tid] = b_rg[tid]; else if (tid < 20) bias[tid] = b_re[tid - 4];
    for (int gw0 = vcu * NWAVES; gw0 < MTOK / 32; gw0 += G * NWAVES) {
        const int gw = gw0 + wave, row0 = gw * 32, b = (gw0 * 32) >> 11;
        __syncthreads();
        if (tid < 64) hist[tid] = 0;
        for (int k = tid; k < 1024; k += 512) { ab[k] = g2[k] * (1.0f + mod[(size_t)b * 6144 + 4096 + k]); ab[1024 + k] = mod[(size_t)b * 6144 + 3072 + k]; }
        __syncthreads();
#pragma unroll 1
        for (int grp = 0; grp < 2; ++grp) {
            const int row = row0 + 16 * grp + fr;
            const bf16_t* xp = x1 + (size_t)row * DMODEL + 8 * fq;
            float ss = 0.f;
#pragma unroll 8
            for (int s_ = 0; s_ < 32; ++s_) { const u32x4 xv = *(const u32x4*)(xp + 32 * s_); const unsigned wd[4] = {xv.x, xv.y, xv.z, xv.w};
#pragma unroll
                for (int j = 0; j < 4; ++j) { const float p = bf_lo(wd[j]), q = bf_hi(wd[j]); ss = __builtin_fmaf(p, p, ss); ss = __builtin_fmaf(q, q, ss); } }
            ss += __shfl_xor(ss, 16); ss += __shfl_xor(ss, 32);
            const float rstd = __builtin_amdgcn_rsqf(ss * (1.0f / DMODEL) + NORM_EPS);
            f32x4 acc0 = {0.f, 0.f, 0.f, 0.f}, acc1 = {0.f, 0.f, 0.f, 0.f};
            unsigned char* xo = XN8 + (size_t)row * DMODEL + 8 * fq;
            const LAS unsigned char* wp0 = wth + fr * WROW + 16 * fq; const LAS unsigned char* wp1 = wth + (16 + (fr & 3)) * WROW + 16 * fq;
            const LAS float* abp = ab + 8 * fq;
#pragma unroll 4
            for (int s_ = 0; s_ < 32; ++s_) {
                const u32x4 xv = *(const u32x4*)(xp + 32 * s_); const unsigned wd[4] = {xv.x, xv.y, xv.z, xv.w};
                const f32x4 a0 = *(const LAS f32x4*)(abp + 32 * s_), a1 = *(const LAS f32x4*)(abp + 32 * s_ + 4);
                const f32x4 b0 = *(const LAS f32x4*)(abp + 1024 + 32 * s_), b1 = *(const LAS f32x4*)(abp + 1024 + 32 * s_ + 4);
                float h[8];
                h[0] = __builtin_fmaf(bf_lo(wd[0]) * rstd, a0[0], b0[0]); h[1] = __builtin_fmaf(bf_hi(wd[0]) * rstd, a0[1], b0[1]);
                h[2] = __builtin_fmaf(bf_lo(wd[1]) * rstd, a0[2], b0[2]); h[3] = __builtin_fmaf(bf_hi(wd[1]) * rstd, a0[3], b0[3]);
                h[4] = __builtin_fmaf(bf_lo(wd[2]) * rstd, a1[0], b1[0]); h[5] = __builtin_fmaf(bf_hi(wd[2]) * rstd, a1[1], b1[1]);
                h[6] = __builtin_fmaf(bf_lo(wd[3]) * rstd, a1[2], b1[2]); h[7] = __builtin_fmaf(bf_hi(wd[3]) * rstd, a1[3], b1[3]);
                *(u32x2*)(xo + 32 * s_) = (u32x2){pg8::pk4_fp8(h[0] * XN2_SCALE, h[1] * XN2_SCALE, h[2] * XN2_SCALE, h[3] * XN2_SCALE), pg8::pk4_fp8(h[4] * XN2_SCALE, h[5] * XN2_SCALE, h[6] * XN2_SCALE, h[7] * XN2_SCALE)};
                const unsigned t0 = cvt_pk_bf16(h[0], h[1]), t1 = cvt_pk_bf16(h[2], h[3]), t2 = cvt_pk_bf16(h[4], h[5]), t3 = cvt_pk_bf16(h[6], h[7]);
                const u32x4 hw = (u32x4){t0, t1, t2, t3};
                const u32x4 lwv = (u32x4){cvt_pk_bf16(h[0] - bf_lo(t0), h[1] - bf_hi(t0)), cvt_pk_bf16(h[2] - bf_lo(t1), h[3] - bf_hi(t1)), cvt_pk_bf16(h[4] - bf_lo(t2), h[5] - bf_hi(t2)), cvt_pk_bf16(h[6] - bf_lo(t3), h[7] - bf_hi(t3))};
                const bf16x8 Ah = __builtin_bit_cast(bf16x8, hw), Al = __builtin_bit_cast(bf16x8, lwv);
                const bf16x8 wh0 = *(const LAS bf16x8*)(wp0 + 64 * s_), wl0 = *(const LAS bf16x8*)(wp0 + 20 * WROW + 64 * s_);
                const bf16x8 wh1 = *(const LAS bf16x8*)(wp1 + 64 * s_), wl1 = *(const LAS bf16x8*)(wp1 + 20 * WROW + 64 * s_);
                acc0 = __builtin_amdgcn_mfma_f32_16x16x32_bf16(wh0, Ah, acc0, 0, 0, 0); acc0 = __builtin_amdgcn_mfma_f32_16x16x32_bf16(wh0, Al, acc0, 0, 0, 0); acc0 = __builtin_amdgcn_mfma_f32_16x16x32_bf16(wl0, Ah, acc0, 0, 0, 0);
                acc1 = __builtin_amdgcn_mfma_f32_16x16x32_bf16(wh1, Ah, acc1, 0, 0, 0); acc1 = __builtin_amdgcn_mfma_f32_16x16x32_bf16(wh1, Al, acc1, 0, 0, 0); acc1 = __builtin_amdgcn_mfma_f32_16x16x32_bf16(wl1, Ah, acc1, 0, 0, 0);
            }
            *(LAS f32x4*)(zs + (16 * grp + fr) * 20 + 4 * fq) = acc0;
            if (fq == 0) *(LAS f32x4*)(zs + (16 * grp + fr) * 20 + 16) = acc1;
        }
        int my_cls = 0; float my_wlo = 0.f, my_whi = 0.f;
        if (lane < 32) {
            float lg[20];
#pragma unroll
            for (int o = 0; o < 20; ++o) lg[o] = zs[lane * 20 + o] + bias[o];
            int gi = 0; float gm = lg[0];
#pragma unroll
            for (int o = 1; o < 4; ++o) if (lg[o] > gm) { gm = lg[o]; gi = o; }
            float gs = 0.f;
#pragma unroll
            for (int o = 0; o < 4; ++o) gs += __expf(lg[o] - gm);
            const float gp = 1.0f / gs;
            float el[4];
#pragma unroll
            for (int j = 0; j < 4; ++j) el[j] = gi == 0 ? lg[4 + j] : (gi == 1 ? lg[8 + j] : (gi == 2 ? lg[12 + j] : lg[16 + j]));
            int i1 = 0; float m1 = el[0];
#pragma unroll
            for (int j = 1; j < 4; ++j) if (el[j] > m1) { m1 = el[j]; i1 = j; }
            int i2 = -1; float m2 = -INFINITY;
#pragma unroll
            for (int j = 0; j < 4; ++j) if (j != i1 && el[j] > m2) { m2 = el[j]; i2 = j; }
            const float w1 = gp / (1.0f + __expf(m2 - m1)), w2 = gp - w1;
            const int lo = i1 < i2 ? i1 : i2, hi = i1 < i2 ? i2 : i1;
            my_wlo = i1 < i2 ? w1 : w2; my_whi = i1 < i2 ? w2 : w1;
            my_cls = gi * 6 + (lo == 0 ? hi - 1 : (lo == 1 ? hi + 1 : 5));
        }
        int rank = 0;
        if (lane < 32) rank = __hip_atomic_fetch_add(&hist[my_cls], 1, __ATOMIC_RELAXED, __HIP_MEMORY_SCOPE_WORKGROUP);
        __syncthreads();
        if (tid < NCLS) hist[32 + tid] = (int)__hip_atomic_fetch_add(gcnt + tid, (unsigned)hist[tid], __ATOMIC_RELAXED, __HIP_MEMORY_SCOPE_AGENT);
        __syncthreads();
        if (lane < 32) { const size_t pos = (size_t)my_cls * MTOK + hist[32 + my_cls] + rank; list[pos] = row0 + lane; lw[pos] = (f32x2){my_wlo, my_whi}; }
    }
}
__global__ void __launch_bounds__(NWAVES * 64, 2) layer_fwd(Args args) {
    extern __shared__ __attribute__((aligned(16))) unsigned char lds_raw[];
    LAS unsigned char* lds = (LAS unsigned char*)lds_raw;
    const int tid = threadIdx.x, lane = tid & 63, wave = __builtin_amdgcn_readfirstlane(tid >> 6);
    const int G = gridDim.x, bx = blockIdx.x;
    const int vcu = (G % 8 == 0) ? (bx % 8) * (G / 8) + bx / 8 : bx;
    unsigned char* ws = args.ws;
    gu32* ctl = (gu32*)(ws + WS_CTL);
    for (int u = tid; u < (LDS_BYTES - LDSCTL_OFF) / 4; u += NWAVES * 64) ((LAS unsigned*)(lds + LDSCTL_OFF))[u] = 0u;
    __syncthreads();
    volatile LAS unsigned* MISC = (volatile LAS unsigned*)(lds + MISC_OFF);
    XcdBarrier bar; bar.bar = (unsigned*)(ctl + CW_BAR); bar.x = 0; bar.st = nullptr;
    const int lo = args.ph_lo, hi = args.ph_hi;
    const bool one = (hi - lo) > 1;
    if (one) bar = xcd_barrier_post((unsigned*)(ctl + CW_BAR), MISC + 8);
#ifndef PH_MASK
#define PH_MASK 0xff
#endif
#ifndef REP_HGRN
#define REP_HGRN 1
#endif
#ifndef REP_ATTN
#define REP_ATTN 1
#endif
#ifndef REP_P2
#define REP_P2 1
#endif
#ifndef REP_P4
#define REP_P4 1
#endif
#ifndef REP_P6
#define REP_P6 1
#endif
#ifndef REP_P0
#define REP_P0 1
#endif
#ifndef REP_P1
#define REP_P1 1
#endif
#define IN(k) (((PH_MASK >> (k)) & 1) && lo <= (k) && (k) < hi)
#define SEAM(k) do { if (IN(k) && IN((k) + 1)) xcd_barrier(bar); } while (0)

    const bf16_t* WinT = (const bf16_t*)(ws + WS_WIN); const bf16_t* WoT = (const bf16_t*)(ws + WS_WO); const unsigned char* W1T = ws + WS_W1; const unsigned char* WdT = ws + WS_WD;
    bf16_t* XN = (bf16_t*)(ws + WS_XN); bf16_t* AO = (bf16_t*)(ws + WS_AO); bf16_t* PROJ = (bf16_t*)(ws + WS_PROJ); unsigned char* ACT = ws + WS_PROJ;
    const float* mod = (const float*)(ws + WS_MOD);

    if (IN(0)) { for (int rep = 0; rep < REP_P0; ++rep) { p0_phase(args, lds, vcu, G, tid, lane, wave); __syncthreads(); } }
    SEAM(0);
    if (IN(1)) { for (int rep = 0; rep < REP_P1; ++rep) { p1_phase(args, lds, vcu, G, tid, lane, wave); __syncthreads(); } }
    SEAM(1);
    if (IN(2)) {
        pg8::ProjPol S; S.A = (const char*)XN; S.Bt = (const char*)WinT; S.lda = 2048; S.ldb = 2048; S.hstepB = 32 * 2048; S.ks = 16; S.nN = 14; S.G = G; S.c = bx; S.bt_tile_rows = 256;
        pg8::EpiProj E{PROJ, args.in[7], args.in[8], args.in[10]};
        for (int rep = 0; rep < REP_P2; ++rep) pg8::gemm_phase(lds + RING_OFF, S, E);
    }
    SEAM(2);
    if (IN(3)) {
        const bool part = (G == 256);
        const int pp = bx >> 1, role = bx & 1;
#ifndef NO_HGRN
        for (int rep = 0; rep < REP_HGRN; ++rep) {
            if (part) { if (role == 0) hgrn::hgrn_unit(pp / HH, pp % HH, PROJ, AO, args.in[11], lds + RING_OFF); }
            else for (int u = bx; u < BATCH * HH; u += G) hgrn::hgrn_unit(u / HH, u % HH, PROJ, AO, args.in[11], lds + RING_OFF);
        }
#ifdef SHADOW_HGRN
        if (part && role == 0) hgrn::hgrn_unit<SHADOW_HGRN>(pp / HH, pp % HH, PROJ, (bf16_t*)(ws + WS_LIST), args.in[11], lds + RING_OFF);
#endif
        __syncthreads();
#endif
#ifndef NO_ATTN
        for (int rep = 0; rep < REP_ATTN; ++rep) {
#ifndef P3_N0
#define P3_N0 1
#endif
            const int nun = part ? (role ? 16 - P3_N0 : P3_N0) : 8 * ((BATCH * AH - vcu + G - 1) / G);
            int cur_bh = -1; float m0l = 0.f;
            for (int i = 0; i < nun; ++i) {
                int bh, qb;
                if (part) { if (role) { bh = i < 8 ? 2 * pp : 2 * pp + 1; qb = i < 8 ? 7 - i : 15 - i; } else { bh = 2 * pp + 1; qb = P3_N0 - 1 - i; } }
                else { bh = vcu + (i >> 3) * G; qb = 7 - (i & 7); }
                bool fresh = false;
                if (bh != cur_bh) { __syncthreads(); m0l = attn_body::attn_prep(bh / AH, bh % AH, (const float*)(ws + WS_LOGF), args.in[7], args.in[8], args.in[9], (char*)lds_raw + RING_OFF); cur_bh = bh; fresh = true; }
                int nbh = -1, nqb = -1;
                if (i + 1 < nun) { const int j = i + 1;
                    if (part) { if (role) { nbh = j < 8 ? 2 * pp : 2 * pp + 1; nqb = j < 8 ? 7 - j : 15 - j; } else { nbh = 2 * pp + 1; nqb = P3_N0 - 1 - j; } }
                    else { nbh = vcu + (j >> 3) * G; nqb = 7 - (j & 7); } }
                attn_body::attn_unit(bh / AH, bh % AH, qb, (const attn_body::bf16*)PROJ, (attn_body::bf16*)AO, m0l, (char*)lds_raw + RING_OFF, !fresh, nbh == bh ? nqb : -1);
            }
            __syncthreads();
        }
#endif
    }
    SEAM(3);
    if (IN(4)) {
        pg8::PlainPol S; S.A = (const char*)AO; S.Bt = (const char*)WoT; S.lda = 2048; S.ldb = 2048; S.hstepB = 128 * 2048; S.ks = 16; S.nN = 4; S.G = G; S.c = bx; S.bt_tile_rows = 256;
        pg8::EpiRes E{args.in[0], (bf16_t*)(ws + WS_X1), mod + 2048};
        for (int rep = 0; rep < REP_P4; ++rep) pg8::gemm_phase(lds + RING_OFF, S, E);
    }
    SEAM(4);
#ifndef REP_P5
#define REP_P5 1
#endif
    if (IN(5)) { for (int rep = 0; rep < REP_P5; ++rep) { if (rep) { xcd_barrier(bar); if (bx == 0 && tid < NCLS) __hip_atomic_store(ctl + CW_CNT + tid, 0u, RLX_AGENT); xcd_barrier(bar); } p5_phase(args, lds, vcu, G, tid, lane, wave); } }
    SEAM(5);
    LAS int* tab = (LAS int*)(lds + TAB_OFF);
    if (IN(6) || IN(7)) {
        if (tid < NCLS) tab[tid] = (int)__hip_atomic_load(ctl + CW_CNT + tid, RLX_AGENT);
        __syncthreads();
        if (tid == 0) { int p = 0; for (int c = 0; c < NCLS; ++c) { tab[32 + c] = p; p += (tab[c] + 255) >> 8; } tab[32 + NCLS] = p; }
        __syncthreads();
    }
    const pg8::MoeTab mt{tab};
    if (IN(6)) {
        pg8::Moe1Pol S; S.A = (const char*)XN; S.W1T = (const char*)W1T; S.list = (const int*)(ws + WS_LIST); S.tab = mt; S.lda = 1024; S.ldb = 1024; S.hstepB = 512 * 1024; S.ks = 8; S.G = G; S.c = bx; S.sclW = SCL_W; S.sclX = SCL_XN2;
        pg8::EpiSwiglu E{ACT, (const float*)(ws + WS_LW), mt};
        for (int rep = 0; rep < REP_P6; ++rep) pg8::gemm_phase(lds + RING_OFF, S, E);
#ifdef SHADOW_P6
        { pg8::EpiSwiglu E2{ws + WS_AO, (const float*)(ws + WS_LW), mt}; pg8::gemm_phase<pg8::Moe1Pol, pg8::EpiSwiglu, SHADOW_P6>(lds + RING_OFF, S, E2); }
#endif
    }
    SEAM(6);
    if (IN(7)) {
        pg8::Moe2Pol S; S.A = (const char*)ACT; S.WdT = (const char*)WdT; S.tab = mt; S.lda = 1024; S.ldb = 512; S.hstepB = 128 * 512; S.ks = 4; S.G = G; S.c = bx; S.sclW = SCL_W; S.sclX = SCL_ACT;
        pg8::EpiMoeOut E{args.out, (const bf16_t*)(ws + WS_X1), mod + 5120, (const int*)(ws + WS_LIST), mt};
#ifndef REP_P7
#define REP_P7 1
#endif
        for (int rep = 0; rep < REP_P7; ++rep) pg8::gemm_phase(lds + RING_OFF, S, E);
    }
#ifdef DIAG
    if (lo <= 8 && 8 < hi) {
        for (size_t i = (size_t)bx * 512 + tid; i < (size_t)MTOK * 1024; i += (size_t)G * 512) {
            const size_t row = i >> 10, c = i & 1023; float v;
            if (DIAG == 1) v = bf_lo((unsigned)XN[i]);
            else if (DIAG == 2) v = bf_lo((unsigned)PROJ[row * PW + c]) + bf_lo((unsigned)PROJ[row * PW + 1024 + c]) + bf_lo((unsigned)PROJ[row * PW + 2048 + c]) + bf_lo((unsigned)PROJ[row * PW + 2560 + c]);
            else if (DIAG == 3) v = bf_lo((unsigned)AO[i]);
            else if (DIAG == 4) v = bf_lo((unsigned)((const bf16_t*)(ws + WS_X1))[i]);
            else v = args.in[0][i];
            args.out[i] = v;
        }
    }
#endif
#undef IN
#undef SEAM
}

#ifndef MK_PER_PHASE
#define MK_PER_PHASE 0
#endif
extern "C" void kernel_launch(void* const* d_in, const int* in_sizes, int n_in, void* d_out, int out_size, void* d_ws, size_t ws_size, hipStream_t stream) {
    static int grid = 0;
    if (grid == 0) {
        if (n_in != 21 || in_sizes[0] != MTOK * DMODEL || out_size != MTOK * DMODEL || ws_size < WS_END) { fprintf(stderr, "kernel_launch: unexpected shapes (n_in %d, in0 %d, out %d, ws %zu); nothing launched\n", n_in, n_in > 0 ? in_sizes[0] : -1, out_size, ws_size); grid = -1; return; }
        int dev = 0, cus = 0, per_cu = 0;
        if (hipGetDevice(&dev) != hipSuccess || hipDeviceGetAttribute(&cus, hipDeviceAttributeMultiprocessorCount, dev) != hipSuccess) { grid = -1; return; }
        if (hipFuncSetAttribute((const void*)layer_fwd, hipFuncAttributeMaxDynamicSharedMemorySize, LDS_BYTES) != hipSuccess) { fprintf(stderr, "kernel_launch: hipFuncSetAttribute failed\n"); grid = -1; return; }
        if (hipOccupancyMaxActiveBlocksPerMultiprocessor(&per_cu, (const void*)layer_fwd, NWAVES * 64, LDS_BYTES) != hipSuccess || per_cu < 1) { fprintf(stderr, "kernel_launch: occupancy query says %d workgroups per CU\n", per_cu); per_cu = 1; }
        (void)hipGetLastError();
        grid = cus;
    }
    if (grid < 0) return;
    (void)hipMemsetAsync((char*)d_ws + WS_CTL, 0, CTL_ZERO_BYTES, stream);
    Args a{};
    for (int i = 0; i < 21; ++i) a.in[i] = (const float*)d_in[i];
    a.out = (float*)d_out; a.ws = (unsigned char*)d_ws;
#if MK_PER_PHASE
    for (int p = 0; p < 9; ++p) { a.ph_lo = p; a.ph_hi = p + 1; hipLaunchKernelGGL(layer_fwd, dim3(grid), dim3(NWAVES * 64), LDS_BYTES, stream, a); }
#else
#ifdef DIAG
    a.ph_lo = 0; a.ph_hi = 9;
#else
    a.ph_lo = 0; a.ph_hi = 8;
#endif
    hipLaunchKernelGGL(layer_fwd, dim3(grid), dim3(NWAVES * 64), LDS_BYTES, stream, a);
#endif
    const hipError_t le = hipPeekAtLastError();
    if (le != hipSuccess) fprintf(stderr, "kernel_launch: launch failed: %s\n", hipGetErrorName(le));
}
```

```cpp
#include <hip/hip_runtime.h>
#include <hip/hip_bf16.h>
#include <cstdio>
#include <cstdint>
#include <cmath>

#define LAS __attribute__((address_space(3)))
#define GAS __attribute__((address_space(1)))
typedef unsigned short bf16_t;
typedef short bf16x8 __attribute__((ext_vector_type(8)));
typedef short s16x4 __attribute__((ext_vector_type(4)));
typedef float f32x4 __attribute__((ext_vector_type(4)));
typedef float f32x2 __attribute__((ext_vector_type(2)));
typedef float f32x16 __attribute__((ext_vector_type(16)));
typedef unsigned u32x4 __attribute__((ext_vector_type(4)));
typedef unsigned u32x2 __attribute__((ext_vector_type(2)));
typedef _Float16 h16x2 __attribute__((ext_vector_type(2)));

constexpr int BATCH = 32, SEQ = 2048, DMODEL = 1024, MTOK = BATCH * SEQ;
constexpr int AH = 8, AD = 64, AW = 512, HH = 4, HK = 128, HW = 512;
constexpr int INW = 3 * AW + AH + 4 * HW;
constexpr int PW = 3584;
constexpr int PC_Q = 0, PC_K = 512, PC_V = 1024, PC_HQ = 1536, PC_HG = 2048, PC_HV = 2560, PC_HO = 3072;
constexpr int NEXP = 16, DEXP = 512, NCLS = 24;
constexpr float NORM_EPS = 1e-6f;
constexpr float LOG2E = 1.4426950408889634f;
constexpr float QSCALE = 0.125f * LOG2E;
constexpr float W_SCALE = 32.0f, XN2_SCALE = 4.0f, ACT_SCALE = 16.0f;
constexpr int SCL_W = 0x7A7A7A7A, SCL_XN2 = 0x7D7D7D7D, SCL_ACT = 0x7B7B7B7B;

typedef __bf16 bf16x2_nat __attribute__((ext_vector_type(2)));
__device__ __forceinline__ unsigned cvt_pk_bf16(float lo, float hi) { f32x2 v = {lo, hi}; bf16x2_nat b = __builtin_convertvector(v, bf16x2_nat); return __builtin_bit_cast(unsigned, b); }
__device__ __forceinline__ float bf_lo(unsigned u) { return __uint_as_float(u << 16); }
__device__ __forceinline__ float bf_hi(unsigned u) { return __uint_as_float(u & 0xffff0000u); }
__device__ __forceinline__ unsigned cvt_pk_f16(float lo, float hi) { h16x2 v = {(_Float16)lo, (_Float16)hi}; return __builtin_bit_cast(unsigned, v); }
__device__ __forceinline__ float sigmoidf_(float v) { return __builtin_amdgcn_rcpf(1.0f + __builtin_amdgcn_exp2f(-v * LOG2E)); }
__device__ __forceinline__ float siluf_(float v) { return v * sigmoidf_(v); }

namespace pg8 {
constexpr int BM = 256, BK = 64, HALF = 128, HTB = HALF * BK * 2, STAGE_BYTES = 8 * HTB, NXCD = 8, WGM = 8, FOXROW = 2064;
typedef int v8i32 __attribute__((ext_vector_type(8)));
typedef int v4i32 __attribute__((ext_vector_type(4)));

__host__ __device__ __forceinline__ int lds_byte(int r, int c) { const int st = (r >> 4) * 2 + (c >> 5), rr = r & 15, cc = c & 31, ob = rr * 64 + cc * 2; return st * 1024 + (ob ^ (((ob >> 9) & 1) << 5)); }
__host__ __device__ __forceinline__ void stage_rc(int b, int& R, int& C) { const int st = b / 1024, sb = b % 1024, swz = sb ^ (((sb >> 9) & 1) << 5); R = (st >> 1) * 16 + swz / 64; C = (st & 1) * 32 + (swz % 64) / 2; }
__host__ __device__ __forceinline__ int perm32(int rho) { const int n = rho >> 4, i = rho & 15; return 8 * (i >> 2) + 4 * n + (i & 3); }

struct GUnit { const char* A; const char* B0; const char* B1; int pm, pn, e0, e1, e2; };

__device__ __forceinline__ bool order_id(int i, int G, int c, int nwg, int& wgid) {
    const long L = (long)i * G + c; if (L >= nwg) return false;
    const int q = nwg / NXCD, r = nwg % NXCD, w = (int)L, xcd = w % NXCD, off = w / NXCD;
    wgid = (xcd < r ? xcd * (q + 1) : r * (q + 1) + (xcd - r) * q) + off; return true;
}

template <class Pol, class Epi, int SK = 0>
__device__ __forceinline__ void gemm_phase(LAS unsigned char* lds, const Pol& S, const Epi& E) {
    int tid = threadIdx.x; asm volatile("" : "+v"(tid));
    const int wid = __builtin_amdgcn_readfirstlane(tid >> 6), lane = tid & 63, wr = wid >> 2, wc = wid & 3, fr = lane & 15, fq = lane >> 4;
    const int RR0 = 8 * wid + (lane >> 3), RR1 = RR0 + 64, CC0 = 8 * ((lane & 7) ^ ((RR0 >> 1) & 7)), CC1 = CC0;
    const int Rb0 = Pol::HG ? (64 * (RR0 >> 5) + perm32(RR0 & 31)) : ((RR0 & ~31) + perm32(RR0 & 31)), Rb1 = Pol::HG ? (64 * (RR1 >> 5) + perm32(RR1 & 31)) : ((RR1 & ~31) + perm32(RR1 & 31));
    constexpr int NT = Pol::NT;
    const unsigned voffB00 = (unsigned)(Rb0 * S.ldb + CC0 * 2), voffB01 = (unsigned)(Rb1 * S.ldb + CC1 * 2), voffB10 = voffB00 + (unsigned)S.hstepB, voffB11 = voffB01 + (unsigned)S.hstepB;
    unsigned voffA00 = (unsigned)(RR0 * S.lda + CC0 * 2), voffA01 = (unsigned)(RR1 * S.lda + CC1 * 2), voffA10 = (unsigned)((HALF + RR0) * S.lda + CC0 * 2), voffA11 = (unsigned)((HALF + RR1) * S.lda + CC1 * 2);
    unsigned voffAn00 = voffA00, voffAn01 = voffA01, voffAn10 = voffA10, voffAn11 = voffA11;
    const size_t kstep = (size_t)(BK * 2);
    const unsigned ldsw = (unsigned)wid * 1024u;
    const int swz = (fr >> 1) & 7, aoff0 = (wr * 64 + fr) * 128 + ((fq ^ swz) << 4), aoff1 = (wr * 64 + fr) * 128 + (((4 + fq) ^ swz) << 4), boff0 = (wc * 32 + fr) * 128 + ((fq ^ swz) << 4), boff1 = (wc * 32 + fr) * 128 + (((4 + fq) ^ swz) << 4);
#define PG8_SA(b, h) (((b) * 2 + (h)) * HTB)
#define PG8_SB(b, h) ((4 + (b) * 2 + (h)) * HTB)
#define PG8_STAGE2(bufoff, gbase, v0, v1) do { if constexpr (SK != 3 && SK != 6) { \
        __builtin_amdgcn_global_load_lds((const unsigned*)((const char*)(gbase) + (v0)), (LAS unsigned*)(lds + (bufoff) + ldsw), 16, 0, 0); \
        __builtin_amdgcn_global_load_lds((const unsigned*)((const char*)(gbase) + (v1)), (LAS unsigned*)(lds + (bufoff) + ldsw + 8192), 16, 0, 0); } } while (0)
#define PG8_STAGE(bufoff, gbase, voff, h) PG8_STAGE2(bufoff, gbase, voff##h##0, voff##h##1)
#define PG8_CAT(x0, x1) __builtin_shufflevector(x0, x1, 0, 1, 2, 3, 4, 5, 6, 7)
#define PG8_LO(x) __builtin_bit_cast(bf16x8, __builtin_shufflevector(x, x, 0, 1, 2, 3))
#define PG8_HI(x) __builtin_bit_cast(bf16x8, __builtin_shufflevector(x, x, 4, 5, 6, 7))
#define PG8_LDA(dst, b, h) do { if constexpr (SK != 4 && SK != 6) _Pragma("unroll") for (int m = 0; m < 4; ++m) dst[m] = PG8_CAT(*(const LAS v4i32*)(lds + PG8_SA(b, h) + aoff0 + m * 2048), *(const LAS v4i32*)(lds + PG8_SA(b, h) + aoff1 + m * 2048)); } while (0)
#define PG8_LDB(dst, b, h) do { if constexpr (SK != 4 && SK != 6) _Pragma("unroll") for (int n = 0; n < 2; ++n) dst[n] = PG8_CAT(*(const LAS v4i32*)(lds + PG8_SB(b, h) + boff0 + n * 2048), *(const LAS v4i32*)(lds + PG8_SB(b, h) + boff1 + n * 2048)); } while (0)
#define PG8_MMA(ai, bj, At, Bt) do { __builtin_amdgcn_s_setprio(1); _Pragma("unroll") for (int m = 0; m < ((SK == 2 || SK == 6) ? 0 : (SK == 1 ? 2 : 4)); ++m) _Pragma("unroll") for (int n = 0; n < 2; ++n) { \
        if constexpr (Pol::FP8) asm volatile("v_mfma_scale_f32_16x16x128_f8f6f4 %0, %1, %2, %0, %3, %4 op_sel_hi:[0,0,0]" : "+v"(acc[ai][bj][m][n]) : "v"(Bt[n]), "v"(At[m]), "v"(sclW), "v"(sclX)); \
        else { acc[ai][bj][m][n] = __builtin_amdgcn_mfma_f32_16x16x32_bf16(PG8_LO(Bt[n]), PG8_LO(At[m]), acc[ai][bj][m][n], 0, 0, 0); \
               acc[ai][bj][m][n] = __builtin_amdgcn_mfma_f32_16x16x32_bf16(PG8_HI(Bt[n]), PG8_HI(At[m]), acc[ai][bj][m][n], 0, 0, 0); } } \
        __builtin_amdgcn_s_setprio(0); } while (0)
#define PG8_WAIT_V(n) asm volatile("s_waitcnt vmcnt(" #n ")" ::: "memory")
#define PG8_WAIT_L(n) asm volatile("s_waitcnt lgkmcnt(" #n ")" ::: "memory")
#define PG8_BAR do { if constexpr (SK != 5) __builtin_amdgcn_s_barrier(); } while (0)
#define PG8_SCHED __builtin_amdgcn_sched_barrier(0)
    int sclW = 0, sclX = 0; if constexpr (Pol::FP8) { sclW = S.sclW; sclX = S.sclX; }
    GUnit cur, nxt; int ui = 0;
    if (!S.next(0, cur)) return;
    if constexpr (Pol::GATHER) {
        const u32x4 ix = S.rows(cur, RR0, RR1);
        voffA00 = ix.x * (unsigned)S.lda + (unsigned)CC0 * 2u; voffA01 = ix.y * (unsigned)S.lda + (unsigned)CC1 * 2u;
        voffA10 = ix.z * (unsigned)S.lda + (unsigned)CC0 * 2u; voffA11 = ix.w * (unsigned)S.lda + (unsigned)CC1 * 2u;
    }
    f32x4 acc[2][2][4][2];
#pragma unroll
    for (int a = 0; a < 2; ++a)
#pragma unroll
        for (int b = 0; b < 2; ++b)
#pragma unroll
            for (int m = 0; m < 4; ++m)
#pragma unroll
                for (int n = 0; n < 2; ++n) acc[a][b][m][n] = (f32x4){0.f, 0.f, 0.f, 0.f};
    v8i32 At[4], B0[2], B1[2];
    f32x4 facc[2] = {(f32x4){0.f, 0.f, 0.f, 0.f}, (f32x4){0.f, 0.f, 0.f, 0.f}}; bf16x8 Bf[2] = {}; bool foxu = false;
    const int foxoff = STAGE_BYTES + (fr & 7) * FOXROW + fq * 16;
#define PG8_FOXLD(tt) do { if constexpr (Pol::FOX) { if (foxu) { Bf[0] = *(const LAS bf16x8*)(lds + foxoff + (tt) * 128); Bf[1] = *(const LAS bf16x8*)(lds + foxoff + (tt) * 128 + 64); } } } while (0)
#define PG8_FOXM1(ai, m) do { facc[ai] = __builtin_amdgcn_mfma_f32_16x16x32_bf16(Bf[0], PG8_LO(At[m]), facc[ai], 0, 0, 0); facc[ai] = __builtin_amdgcn_mfma_f32_16x16x32_bf16(Bf[1], PG8_HI(At[m]), facc[ai], 0, 0, 0); } while (0)
#define PG8_FOXMMA(ai) do { if constexpr (Pol::FOX) { if (foxu) { if (wc == 0) PG8_FOXM1(ai, 0); else if (wc == 1) PG8_FOXM1(ai, 1); else if (wc == 2) PG8_FOXM1(ai, 2); else PG8_FOXM1(ai, 3); } } } while (0)
    if constexpr (SK == 4 || SK == 6) { _Pragma("unroll") for (int m = 0; m < 4; ++m) At[m] = (v8i32){1, 2, 3, 4, 5, 6, 7, 8}; B0[0] = B0[1] = B1[0] = B1[1] = (v8i32){1, 2, 3, 4, 5, 6, 7, 8}; }
    const char* cA = cur.A;
    PG8_STAGE(PG8_SB(0, 0), cur.B0, voffB, 0); PG8_STAGE(PG8_SB(0, 1), cur.B0, voffB, 1); PG8_STAGE(PG8_SA(0, 0), cA, voffA, 0); PG8_STAGE(PG8_SA(0, 1), cA, voffA, 1);
    if (wr == 1) PG8_BAR;
    PG8_WAIT_V(2); PG8_BAR;
    PG8_STAGE(PG8_SB(1, 0), cur.B0 + kstep, voffB, 0); PG8_STAGE(PG8_SA(1, 0), cA + kstep, voffA, 0); PG8_STAGE(PG8_SB(1, 1), cur.B0 + kstep, voffB, 1);
    PG8_WAIT_V(6); PG8_BAR;
    for (;;) {
        if constexpr (Pol::FOX) foxu = (cur.pn == 0);
        const bool has_next = S.next(ui + 1, nxt);
        const char* nA = has_next ? nxt.A : cA; const char* nB = has_next ? nxt.B0 : cur.B0;
        if constexpr (Pol::GATHER) {
            if (has_next) { int r0_ = RR0, r1_ = RR1; asm volatile("" : "+v"(r0_), "+v"(r1_)); const u32x4 ix = S.rows(nxt, r0_, r1_);
                voffAn00 = ix.x * (unsigned)S.lda + (unsigned)CC0 * 2u; voffAn01 = ix.y * (unsigned)S.lda + (unsigned)CC1 * 2u;
                voffAn10 = ix.z * (unsigned)S.lda + (unsigned)CC0 * 2u; voffAn11 = ix.w * (unsigned)S.lda + (unsigned)CC1 * 2u; }
            else { voffAn00 = voffA00; voffAn01 = voffA01; voffAn10 = voffA10; voffAn11 = voffA11; }
        }
#pragma unroll 1
        for (int t = 0; t < NT; t += 2) {
            const bool last = (t == NT - 2);
            const char* a1 = cA + (size_t)(t + 1) * kstep;
            const char* a2 = last ? nA : cA + (size_t)(t + 2) * kstep;
            const char* b2 = last ? nB : ((t + 2 < S.ks) ? cur.B0 + (size_t)(t + 2) * kstep : cur.B1 + (size_t)(t + 2 - S.ks) * kstep);
            const char* a3 = a2 + kstep; const char* b3 = b2 + kstep;
            asm volatile("" : "+s"(a1), "+s"(a2), "+s"(a3), "+s"(b2), "+s"(b3));
            const bool gl_ = Pol::GATHER && last;
            const unsigned va00 = gl_ ? voffAn00 : voffA00, va01 = gl_ ? voffAn01 : voffA01, va10 = gl_ ? voffAn10 : voffA10, va11 = gl_ ? voffAn11 : voffA11;
            PG8_LDB(B0, 0, 0); PG8_LDB(B1, 0, 1); PG8_SCHED; PG8_LDA(At, 0, 0); PG8_FOXLD(t); PG8_STAGE(PG8_SA(1, 1), a1, voffA, 1);
            PG8_WAIT_V(8); PG8_WAIT_L(0); PG8_BAR; PG8_MMA(0, 0, At, B0); PG8_MMA(0, 1, At, B1); PG8_FOXMMA(0); PG8_BAR; PG8_SCHED;
            PG8_LDA(At, 0, 1); PG8_STAGE(PG8_SB(0, 0), b2, voffB, 0); PG8_STAGE(PG8_SB(0, 1), b2, voffB, 1); PG8_STAGE(PG8_SA(0, 0), a2, va, 0);
            PG8_WAIT_V(8); PG8_WAIT_L(0); PG8_BAR; PG8_MMA(1, 0, At, B0); PG8_MMA(1, 1, At, B1); PG8_FOXMMA(1); PG8_BAR; PG8_SCHED;
            PG8_LDB(B0, 1, 0); PG8_LDB(B1, 1, 1); PG8_SCHED; PG8_LDA(At, 1, 0); PG8_FOXLD(t + 1); PG8_STAGE(PG8_SA(0, 1), a2, va, 1);
            PG8_WAIT_V(8); PG8_WAIT_L(0); PG8_BAR; PG8_MMA(0, 0, At, B0); PG8_MMA(0, 1, At, B1); PG8_FOXMMA(0); PG8_BAR; PG8_SCHED;
            PG8_LDA(At, 1, 1); PG8_STAGE(PG8_SB(1, 0), b3, voffB, 0); PG8_STAGE(PG8_SB(1, 1), b3, voffB, 1); PG8_STAGE(PG8_SA(1, 0), a3, va, 0);
            PG8_WAIT_V(8); PG8_WAIT_L(0); PG8_BAR; PG8_MMA(1, 0, At, B0); PG8_MMA(1, 1, At, B1); PG8_FOXMMA(1); PG8_BAR; PG8_SCHED;
        }
        if (wr == 0) PG8_BAR;
        if constexpr (Pol::FP8) asm volatile("s_nop 15\n\ts_nop 7" ::: "memory");
        { int fr_e = fr, fq_e = fq; asm volatile("" : "+v"(fr_e), "+v"(fq_e));
          E(acc, cur, wr, wc, fr_e, fq_e);
          if constexpr (Pol::FOX) { if (foxu) { E.fox(facc, cur, wr, wc, fr_e, fq_e); facc[0] = (f32x4){0.f, 0.f, 0.f, 0.f}; facc[1] = (f32x4){0.f, 0.f, 0.f, 0.f}; } } }
        if (!has_next) break;
#pragma unroll
        for (int a = 0; a < 2; ++a)
#pragma unroll
            for (int b = 0; b < 2; ++b)
#pragma unroll
                for (int m = 0; m < 4; ++m)
#pragma unroll
                    for (int n = 0; n < 2; ++n) acc[a][b][m][n] = (f32x4){0.f, 0.f, 0.f, 0.f};
        cur = nxt; cA = nA; ++ui;
        if constexpr (Pol::GATHER) { voffA00 = voffAn00; voffA01 = voffAn01; voffA10 = voffAn10; voffA11 = voffAn11; }
        if (wr == 1) PG8_BAR;
    }
    PG8_WAIT_V(0);
    PG8_BAR;
#undef PG8_SA
#undef PG8_SB
#undef PG8_STAGE
#undef PG8_STAGE2
#undef PG8_LDA
#undef PG8_LDB
#undef PG8_MMA
#undef PG8_FOXLD
#undef PG8_FOXM1
#undef PG8_FOXMMA
#undef PG8_CAT
#undef PG8_LO
#undef PG8_HI
#undef PG8_WAIT_V
#undef PG8_WAIT_L
#undef PG8_BAR
#undef PG8_SCHED
}
}
namespace pg8 {
struct DensePol {
    static constexpr bool GATHER = false, FP8 = false; static constexpr int NT = 16;
    const char* A; const char* Bt; int lda, ldb, hstepB, ks, nN, G, c, bt_tile_rows  ;
    __device__ __forceinline__ bool next(int i, GUnit& u) const {
        const int nM = MTOK / BM, nwg = nM * nN; int wgid; if (!order_id(i, G, c, nwg, wgid)) return false;
        const int nig = WGM * nN, gid = wgid / nig, fm = gid * WGM, gsz = (nM - fm) < WGM ? (nM - fm) : WGM;
        u.pm = fm + ((wgid % nig) % gsz); u.pn = (wgid % nig) / gsz; u.e0 = 0; u.e1 = 0; u.e2 = 0;
        u.A = A + (size_t)u.pm * BM * lda; u.B0 = Bt + (size_t)u.pn * BM * ldb; u.B1 = u.B0; return true;
    }
};
struct ProjPol : DensePol { static constexpr bool HG = true, FOX = true; };
struct PlainPol : DensePol { static constexpr bool HG = false, FOX = false; };

struct MoeTab { const LAS int* t; __device__ __forceinline__ int cnt(int c) const { return t[c]; } __device__ __forceinline__ int tpre(int c) const { return t[32 + c]; } };
__device__ __forceinline__ void moe_class_experts(int cls, int& elo, int& ehi) {
    const int g = cls / 6, p = cls % 6; const int lo = p < 3 ? 0 : (p < 5 ? 1 : 2); const int hi = p < 3 ? p + 1 : (p < 5 ? p - 1 : 3);
    elo = 4 * g + lo; ehi = 4 * g + hi;
}
struct Moe1Pol {
    static constexpr bool GATHER = true, HG = false, FP8 = true, FOX = false; static constexpr int NT = 8;
    const char* A; const char* W1T; const int* list; MoeTab tab; int lda, ldb, hstepB, ks, G, c, sclW, sclX;
    __device__ __forceinline__ bool next(int i, GUnit& u) const {
        const int ntile = tab.tpre(NCLS), nwg = ntile * 8; int wgid; if (!order_id(i, G, c, nwg, wgid)) return false;
        const int rtg = wgid >> 3, sub = wgid & 7, e01 = sub >> 2, ct = sub & 3;
        int cls = 0;
#pragma unroll 1
        for (int k = 1; k < NCLS; ++k) cls += (tab.tpre(k) <= rtg) ? 1 : 0;
        int elo, ehi; moe_class_experts(cls, elo, ehi); const int ex = e01 ? ehi : elo;
        u.pm = rtg; u.pn = ct; u.e0 = cls; u.e1 = rtg - tab.tpre(cls); u.e2 = e01;
        u.A = A; u.B0 = W1T + ((size_t)ex * 1024 + (size_t)ct * 128) * 1024; u.B1 = u.B0; return true;
    }
    __device__ __forceinline__ u32x4 rows(const GUnit& u, int R0, int R1) const {
        const int base = u.e1 * 256, n = tab.cnt(u.e0) - base; const int* L = list + (size_t)u.e0 * MTOK + base;
        u32x4 r;
        r.x = R0 < n ? (unsigned)L[R0] : 0u; r.y = R1 < n ? (unsigned)L[R1] : 0u;
        r.z = HALF + R0 < n ? (unsigned)L[HALF + R0] : 0u; r.w = HALF + R1 < n ? (unsigned)L[HALF + R1] : 0u;
        return r;
    }
};
struct Moe2Pol {
    static constexpr bool GATHER = false, HG = false, FP8 = true, FOX = false; static constexpr int NT = 8;
    const char* A; const char* WdT; MoeTab tab; int lda, ldb, hstepB, ks, G, c, sclW, sclX;
    __device__ __forceinline__ bool next(int i, GUnit& u) const {
        const int ntile = tab.tpre(NCLS), nwg = ntile * 4; int wgid; if (!order_id(i, G, c, nwg, wgid)) return false;
        const int rtg = wgid >> 2, ct = wgid & 3;
        int cls = 0;
#pragma unroll 1
        for (int k = 1; k < NCLS; ++k) cls += (tab.tpre(k) <= rtg) ? 1 : 0;
        int elo, ehi; moe_class_experts(cls, elo, ehi);
        u.pm = rtg; u.pn = ct; u.e0 = cls; u.e1 = rtg - tab.tpre(cls); u.e2 = 0;
        u.A = A + (size_t)rtg * BM * lda;
        u.B0 = WdT + ((size_t)elo * 1024 + (size_t)ct * 256) * 512; u.B1 = WdT + ((size_t)ehi * 1024 + (size_t)ct * 256) * 512; return true;
    }
};

struct EpiProj {
    bf16_t* P; const float* gq; const float* gk; const float* lbp; float* logf; const float* bfox;
    __device__ __forceinline__ void fox(const f32x4 (&facc)[2], const GUnit& u, int wr, int wc, int fr, int fq) const {
        if (fq < 2) { const f32x4 bb = *(const f32x4*)(bfox + 4 * fq);
#pragma unroll
            for (int ai = 0; ai < 2; ++ai) { f32x4 o;
#pragma unroll
                for (int e = 0; e < 4; ++e) { const float z = facc[ai][e] + bb[e]; o[e] = fminf(z, 0.f) - __builtin_amdgcn_logf(1.0f + __builtin_amdgcn_exp2f(-fabsf(z) * LOG2E)) * 0.6931471805599453f; }
                *(f32x4*)(logf + (size_t)(u.pm * BM + ai * HALF + wr * 64 + wc * 16 + fr) * AH + 4 * fq) = o; } }
    }
    __device__ __forceinline__ void operator()(const f32x4 (&acc)[2][2][4][2], const GUnit& u, int wr, int wc, int fr, int fq) const {
#ifdef REP_EPIPROJ
        for (int rep_ = 0; rep_ < REP_EPIPROJ - 1; ++rep_) { asm volatile("" ::: "memory"); body(acc, u, wr, wc, fr, fq); }
#endif
        body(acc, u, wr, wc, fr, fq);
    }
    __device__ __forceinline__ void body(const f32x4 (&acc)[2][2][4][2], const GUnit& u, int wr, int wc, int fr, int fq) const {
        const int type = u.pn >> 1;
        const int row0 = u.pm * BM + wr * 64 + fr, lc0 = 64 * wc + 8 * fq;
        bf16_t* base = P + (size_t)row0 * PW + u.pn * BM + lc0;
        if (type <= 1) {
            const float* g = type == 0 ? gq : gk; const float sc = type == 0 ? QSCALE : 1.0f;
            f32x4 gv[2][2];
#pragma unroll
            for (int bj = 0; bj < 2; ++bj)
#pragma unroll
                for (int n = 0; n < 2; ++n) gv[bj][n] = *(const f32x4*)(g + 32 * bj + 8 * fq + 4 * n) * sc;
#pragma unroll
            for (int ai = 0; ai < 2; ++ai)
#pragma unroll
                for (int m = 0; m < 4; ++m) {
                    float ss = 0.f;
#pragma unroll
                    for (int bj = 0; bj < 2; ++bj)
#pragma unroll
                        for (int n = 0; n < 2; ++n) { const f32x4 v = acc[ai][bj][m][n]; ss += (v[0] * v[0] + v[1] * v[1]) + (v[2] * v[2] + v[3] * v[3]); }
                    ss += __shfl_xor(ss, 16); ss += __shfl_xor(ss, 32);
                    const float rstd = __builtin_amdgcn_rsqf(ss * (1.0f / 64.0f) + NORM_EPS);
                    bf16_t* rowp = base + (size_t)(ai * HALF + m * 16) * PW;
#pragma unroll
                    for (int bj = 0; bj < 2; ++bj) { const f32x4 v0 = acc[ai][bj][m][0] * rstd * gv[bj][0], v1 = acc[ai][bj][m][1] * rstd * gv[bj][1];
                        u32x4 w; w.x = cvt_pk_bf16(v0[0], v0[1]); w.y = cvt_pk_bf16(v0[2], v0[3]); w.z = cvt_pk_bf16(v1[0], v1[1]); w.w = cvt_pk_bf16(v1[2], v1[3]);
                        *(u32x4*)(rowp + 32 * bj) = w; }
                }
        } else if (type == 4) {
            const int ch0 = (u.pn - 8) * BM + lc0;
            f32x4 lbv[2][2];
#pragma unroll
            for (int bj = 0; bj < 2; ++bj)
#pragma unroll
                for (int n = 0; n < 2; ++n) { const f32x4 l0 = *(const f32x4*)(lbp + ch0 + 32 * bj + 4 * n), l1 = *(const f32x4*)(lbp + 512 + ch0 + 32 * bj + 4 * n);
#pragma unroll
                    for (int e = 0; e < 4; ++e) lbv[bj][n][e] = sigmoidf_(l0[e] - l1[e]); }
#pragma unroll
            for (int ai = 0; ai < 2; ++ai)
#pragma unroll
                for (int m = 0; m < 4; ++m) { bf16_t* rowp = base + (size_t)(ai * HALF + m * 16) * PW;
#pragma unroll
                    for (int bj = 0; bj < 2; ++bj) { float o[8];
#pragma unroll
                        for (int n = 0; n < 2; ++n)
#pragma unroll
                            for (int e = 0; e < 4; ++e) { const float lb = lbv[bj][n][e]; o[4 * n + e] = lb + (1.0f - lb) * sigmoidf_(acc[ai][bj][m][n][e]); }
                        u32x4 w; w.x = cvt_pk_f16(o[0], o[1]); w.y = cvt_pk_f16(o[2], o[3]); w.z = cvt_pk_f16(o[4], o[5]); w.w = cvt_pk_f16(o[6], o[7]);
                        *(u32x4*)(rowp + 32 * bj) = w; } }
        } else {
            const bool act = (type == 3 || type == 6);
#pragma unroll
            for (int ai = 0; ai < 2; ++ai)
#pragma unroll
                for (int m = 0; m < 4; ++m) { bf16_t* rowp = base + (size_t)(ai * HALF + m * 16) * PW;
#pragma unroll
                    for (int bj = 0; bj < 2; ++bj) { f32x4 v0 = acc[ai][bj][m][0], v1 = acc[ai][bj][m][1];
                        if (act) {
#pragma unroll
                            for (int e = 0; e < 4; ++e) { v0[e] = siluf_(v0[e]); v1[e] = siluf_(v1[e]); } }
                        u32x4 w; w.x = cvt_pk_bf16(v0[0], v0[1]); w.y = cvt_pk_bf16(v0[2], v0[3]); w.z = cvt_pk_bf16(v1[0], v1[1]); w.w = cvt_pk_bf16(v1[2], v1[3]);
                        *(u32x4*)(rowp + 32 * bj) = w; } }
        }
    }
};
struct EpiRes {
    const float* __restrict__ x; bf16_t* __restrict__ x1; const float* __restrict__ gate;
    __device__ __forceinline__ void operator()(const f32x4 (&acc)[2][2][4][2], const GUnit& u, int wr, int wc, int fr, int fq) const {
        const int row0 = u.pm * BM + wr * 64 + fr, col0 = u.pn * BM + 32 * wc + 8 * fq, b = (u.pm * BM) >> 11;
        f32x4 gv[2][2];
#pragma unroll
        for (int bj = 0; bj < 2; ++bj)
#pragma unroll
            for (int n = 0; n < 2; ++n) gv[bj][n] = *(const f32x4*)(gate + (size_t)b * 6144 + col0 + HALF * bj + 4 * n);
#pragma unroll
        for (int ai = 0; ai < 2; ++ai) {
            f32x4 xv[4][2][2];
#pragma unroll
            for (int m = 0; m < 4; ++m) { const size_t off = (size_t)(row0 + ai * HALF + m * 16) * DMODEL + col0;
#pragma unroll
                for (int bj = 0; bj < 2; ++bj) { xv[m][bj][0] = *(const f32x4*)(x + off + HALF * bj); xv[m][bj][1] = *(const f32x4*)(x + off + HALF * bj + 4); } }
#pragma unroll
            for (int m = 0; m < 4; ++m) { const size_t off = (size_t)(row0 + ai * HALF + m * 16) * DMODEL + col0;
#pragma unroll
                for (int bj = 0; bj < 2; ++bj) { const f32x4 o0 = xv[m][bj][0] + gv[bj][0] * acc[ai][bj][m][0], o1 = xv[m][bj][1] + gv[bj][1] * acc[ai][bj][m][1];
                    u32x4 w; w.x = cvt_pk_bf16(o0[0], o0[1]); w.y = cvt_pk_bf16(o0[2], o0[3]); w.z = cvt_pk_bf16(o1[0], o1[1]); w.w = cvt_pk_bf16(o1[2], o1[3]);
                    *(u32x4*)(x1 + off + HALF * bj) = w; } }
        }
    }
};
__device__ __forceinline__ float clamp448(float v) { return __builtin_amdgcn_fmed3f(v, -448.0f, 448.0f); }
__device__ __forceinline__ unsigned pk4_fp8(float a, float b, float c, float d) { int r = 0; r = __builtin_amdgcn_cvt_pk_fp8_f32(clamp448(a), clamp448(b), r, false); r = __builtin_amdgcn_cvt_pk_fp8_f32(clamp448(c), clamp448(d), r, true); return (unsigned)r; }
struct EpiSwiglu {
    unsigned char* __restrict__ act; const float* __restrict__ lw; MoeTab tab;
    __device__ __forceinline__ void operator()(const f32x4 (&acc)[2][2][4][2], const GUnit& u, int wr, int wc, int fr, int fq) const {
        const int r0 = wr * 64 + fr, n = tab.cnt(u.e0) - u.e1 * 256;
        const float* lwp = lw + ((size_t)u.e0 * MTOK + (size_t)u.e1 * 256) * 2 + u.e2;
        unsigned char* base = act + (size_t)(u.pm * BM + r0) * DMODEL + u.e2 * 512 + u.pn * 128 + 32 * wc + 8 * fq;
        float wrow[2][4];
#pragma unroll
        for (int ai = 0; ai < 2; ++ai)
#pragma unroll
            for (int m = 0; m < 4; ++m) { const int r = r0 + ai * HALF + m * 16; wrow[ai][m] = (r < n ? lwp[(size_t)r * 2] : 0.f) * ACT_SCALE; }
#pragma unroll
        for (int ai = 0; ai < 2; ++ai)
#pragma unroll
            for (int m = 0; m < 4; ++m) { const float w = wrow[ai][m];
                float o[8];
#pragma unroll
                for (int nn = 0; nn < 2; ++nn)
#pragma unroll
                    for (int e = 0; e < 4; ++e) o[4 * nn + e] = w * siluf_(acc[ai][0][m][nn][e]) * acc[ai][1][m][nn][e];
                *(u32x2*)(base + (size_t)(ai * HALF + m * 16) * DMODEL) = (u32x2){pk4_fp8(o[0], o[1], o[2], o[3]), pk4_fp8(o[4], o[5], o[6], o[7])}; }
    }
};
struct EpiMoeOut {
    float* __restrict__ out; const bf16_t* __restrict__ x1; const float* __restrict__ gate; const int* __restrict__ list; MoeTab tab; int dense;
    __device__ __forceinline__ void operator()(const f32x4 (&acc)[2][2][4][2], const GUnit& u, int wr, int wc, int fr, int fq) const {
        const int r0 = wr * 64 + fr, n = tab.cnt(u.e0) - u.e1 * 256, col0 = u.pn * BM + 32 * wc + 8 * fq;
        const int* L = list + (size_t)u.e0 * MTOK + (size_t)u.e1 * 256;
        int tok[2][4];
#pragma unroll
        for (int ai = 0; ai < 2; ++ai)
#pragma unroll
            for (int m = 0; m < 4; ++m) { const int r = r0 + ai * HALF + m * 16; tok[ai][m] = dense ? ((u.pm * BM + r) & (MTOK - 1)) : (r < n ? L[r] : 0); }
#pragma unroll
        for (int ai = 0; ai < 2; ++ai)
#pragma unroll
            for (int m = 0; m < 4; ++m) { const int r = r0 + ai * HALF + m * 16, tk = tok[ai][m];
                const float* gp = gate + (size_t)(tk >> 11) * 6144 + col0; float* op = out + (size_t)tk * DMODEL + col0; const bf16_t* xp = x1 + (size_t)tk * DMODEL + col0;
                const u32x4 xa = *(const u32x4*)(xp), xb = *(const u32x4*)(xp + HALF);
                const f32x4 ga0 = *(const f32x4*)(gp), ga1 = *(const f32x4*)(gp + 4), gb0 = *(const f32x4*)(gp + HALF), gb1 = *(const f32x4*)(gp + HALF + 4);
                const f32x4 o0 = (f32x4){bf_lo(xa.x), bf_hi(xa.x), bf_lo(xa.y), bf_hi(xa.y)} + ga0 * acc[ai][0][m][0], o1 = (f32x4){bf_lo(xa.z), bf_hi(xa.z), bf_lo(xa.w), bf_hi(xa.w)} + ga1 * acc[ai][0][m][1];
                const f32x4 o2 = (f32x4){bf_lo(xb.x), bf_hi(xb.x), bf_lo(xb.y), bf_hi(xb.y)} + gb0 * acc[ai][1][m][0], o3 = (f32x4){bf_lo(xb.z), bf_hi(xb.z), bf_lo(xb.w), bf_hi(xb.w)} + gb1 * acc[ai][1][m][1];
                if (r < n) { *(f32x4*)(op) = o0; *(f32x4*)(op + 4) = o1; *(f32x4*)(op + HALF) = o2; *(f32x4*)(op + HALF + 4) = o3; } }
    }
};
}
namespace attn_body {
using bf16 = __hip_bfloat16;
constexpr int D = 64, DM = PW;
constexpr int NW = 8, QBLK = 32, QB = QBLK * NW, KVBLK = 64, NQB = SEQ / QB;
__device__ __forceinline__ int crow(int r, int hi) { return (r & 3) + 8 * (r >> 2) + 4 * hi; }
#define SBAR() __builtin_amdgcn_sched_barrier(0)
__device__ __forceinline__ void cmask(f32x16& p0, f32x16& p1, int jb, int qrel, int hi) {
    const float NEG = -INFINITY; int kb = 64 * jb + 4 * hi;
#pragma unroll
    for (int r = 0; r < 16; ++r) { int kv = kb + (r & 3) + 8 * (r >> 2); if (kv > qrel) p0[r] = NEG; if (kv + 32 > qrel) p1[r] = NEG; }
}
constexpr int NSLOT = 3, SLOTB = 8192;
constexpr int LDS_K = 0, LDS_V = NSLOT * SLOTB, LDS_WS = 2 * NSLOT * SLOTB, LDS_OST = LDS_WS + NW * 64 * 4, LDS_CUM = LDS_OST + NW * 4096, LDS_OG = LDS_CUM + SEQ * 4, LDS_BYTES = LDS_OG + 256;
__device__ __forceinline__ void glds16(const void* gsrc, unsigned lds_dst) { unsigned keep;
    asm volatile("s_mov_b32 %0, m0\n\ts_mov_b32 m0, %2\n\ts_nop 0\n\tglobal_load_lds_dwordx4 %1, off\n\ts_mov_b32 m0, %0" : "=&s"(keep) : "v"(gsrc), "s"(lds_dst) : "memory"); }
typedef float f32x2_t __attribute__((ext_vector_type(2))); typedef __bf16 bf16x2_t __attribute__((ext_vector_type(2)));
__device__ __forceinline__ unsigned cvtpk_s(float lo, float hi) { f32x2_t v = {lo, hi}; bf16x2_t b = __builtin_convertvector(v, bf16x2_t); return __builtin_bit_cast(unsigned, b); }
#define WAIT_BAR(N) asm volatile("s_waitcnt vmcnt(" #N ") lgkmcnt(0)\n\ts_barrier" ::: "memory")
typedef LAS const char* lds_cptr;
typedef short v4i16_t __attribute__((ext_vector_type(4)));
__device__ __forceinline__ void split3(float x, unsigned& w0, unsigned& w1) {
    const unsigned xb = __float_as_uint(x), hb = xb & 0xffff0000u; const float r1 = x - __uint_as_float(hb);
    const unsigned mb = __float_as_uint(r1) & 0xffff0000u; const float r2 = r1 - __uint_as_float(mb);
    w0 = (hb >> 16) | mb; w1 = __float_as_uint(r2) >> 16;
}
__device__ __forceinline__ bf16x8 kbias_frag(float nk, int hi) {
    unsigned w0, w1; split3(nk, w0, w1);
    const u32x4 v = (u32x4){hi ? w0 : 0x3F803F80u, hi ? w1 : 0x00003F80u, 0u, 0u};
    return __builtin_bit_cast(bf16x8, v);
}
__device__ __forceinline__ bf16x8 qbias_frag(float cq, int hi) {
    unsigned w0, w1; split3(cq, w0, w1);
    const u32x4 v = (u32x4){hi ? 0x3F803F80u : w0, hi ? 0x00003F80u : w1, 0u, 0u};
    return __builtin_bit_cast(bf16x8, v);
}
#define Z16 (f32x16){0.f, 0.f, 0.f, 0.f, 0.f, 0.f, 0.f, 0.f, 0.f, 0.f, 0.f, 0.f, 0.f, 0.f, 0.f, 0.f}
__device__ __forceinline__ void qkt(f32x16& p0, f32x16& p1, const char* Kslot, const bf16x8* qr, bf16x8 kb0, bf16x8 kb1, bf16x8 qb, int r32, int hi) {
    const char* kb = Kslot + hi * 1024 + r32 * 16;
    p0 = __builtin_amdgcn_mfma_f32_32x32x16_bf16(kb0, qb, Z16, 0, 0, 0); p1 = __builtin_amdgcn_mfma_f32_32x32x16_bf16(kb1, qb, Z16, 0, 0, 0);
#pragma unroll
    for (int d0 = 0; d0 < 4; ++d0) {
        const bf16x8 b0 = *reinterpret_cast<const bf16x8*>(kb + d0 * 2048);
        const bf16x8 b1 = *reinterpret_cast<const bf16x8*>(kb + d0 * 2048 + 512);
        p0 = __builtin_amdgcn_mfma_f32_32x32x16_bf16(b0, qr[d0], p0, 0, 0, 0); p1 = __builtin_amdgcn_mfma_f32_32x32x16_bf16(b1, qr[d0], p1, 0, 0, 0); }
}
__device__ __forceinline__ void kload8(bf16x8* kf, lds_cptr kp) {
    kf[0] = *(const LAS bf16x8*)(kp);        kf[1] = *(const LAS bf16x8*)(kp + 512);
    kf[2] = *(const LAS bf16x8*)(kp + 2048); kf[3] = *(const LAS bf16x8*)(kp + 2560);
    kf[4] = *(const LAS bf16x8*)(kp + 4096); kf[5] = *(const LAS bf16x8*)(kp + 4608);
    kf[6] = *(const LAS bf16x8*)(kp + 6144); kf[7] = *(const LAS bf16x8*)(kp + 6656);
}
__device__ __forceinline__ void kload2(bf16x8* kf, lds_cptr kp, int j) { kf[2 * j] = *(const LAS bf16x8*)(kp + j * 2048); kf[2 * j + 1] = *(const LAS bf16x8*)(kp + j * 2048 + 512); }
__device__ __forceinline__ s16x4 vtr(lds_cptr p) { return __builtin_bit_cast(s16x4, __builtin_amdgcn_ds_read_tr16_b64_v4i16((LAS v4i16_t*)p)); }
__device__ __forceinline__ void pv(f32x16* o, int vb, bf16x8 pa0, bf16x8 pa1, bf16x8 pa2, bf16x8 pa3) {
#pragma unroll
    for (int d0 = 0; d0 < 2; ++d0) { s16x4 lo[4], hi[4];
#pragma unroll
        for (int ks = 0; ks < 4; ++ks) {
            asm volatile("ds_read_b64_tr_b16 %0,%1 offset:%c2" : "=&v"(lo[ks]) : "v"(vb), "i"(d0 * 4096 + ks * 1024) : "memory");
            asm volatile("ds_read_b64_tr_b16 %0,%1 offset:%c2" : "=&v"(hi[ks]) : "v"(vb), "i"(d0 * 4096 + ks * 1024 + 512) : "memory"); }
        asm volatile("s_waitcnt lgkmcnt(0)" ::: "memory"); SBAR();
#define PK(k) (bf16x8){lo[k][0], lo[k][1], lo[k][2], lo[k][3], hi[k][0], hi[k][1], hi[k][2], hi[k][3]}
        o[d0] = __builtin_amdgcn_mfma_f32_32x32x16_bf16(pa0, PK(0), o[d0], 0, 0, 0);
        o[d0] = __builtin_amdgcn_mfma_f32_32x32x16_bf16(pa1, PK(1), o[d0], 0, 0, 0);
        o[d0] = __builtin_amdgcn_mfma_f32_32x32x16_bf16(pa2, PK(2), o[d0], 0, 0, 0);
        o[d0] = __builtin_amdgcn_mfma_f32_32x32x16_bf16(pa3, PK(3), o[d0], 0, 0, 0);
#undef PK
    }
}

__device__ __forceinline__ void attn_unit(int b, int h, int qb, const bf16* P, bf16* O, float m0l, char* shm, bool pre, int nqb) {
    int tid = threadIdx.x; asm volatile("" : "+v"(tid));
    const int lane = tid & 63, r32 = lane & 31, hi = lane >> 5; const int wid = __builtin_amdgcn_readfirstlane(tid >> 6);
    const long rowbase = (long)b * SEQ; const int q0 = qb * QB;
    const lds_cptr shm3 = (lds_cptr)shm;
    const float fthr = 2.0f * m0l + 32.0f;
    int t0 = 0;
    { const LAS float* nc = (const LAS float*)(shm3 + LDS_CUM); const float nq0 = nc[q0]; const int tmax = (q0 + QB) / KVBLK - 4;
      while (t0 + 2 <= tmax && nq0 - nc[KVBLK * (t0 + 2) - 1] > fthr) t0 += 2; }
    const bf16* Qw = P + (rowbase + q0 + wid * QBLK) * DM + PC_Q + h * D;
    const bf16* Kh0 = P + rowbase * DM + PC_K + h * D, *Vh0 = P + rowbase * DM + PC_V + h * D;
    const bf16* Kh = Kh0 + (long)t0 * KVBLK * DM, *Vh = Vh0 + (long)t0 * KVBLK * DM;
    const unsigned lds0 = (unsigned)(uintptr_t)shm;
    float* wsf = (float*)(shm + LDS_WS) + wid * 64;
    const bf16* ksrc = Kh + (long)lane * DM + wid * 8;
    const bf16* vsrc = Vh + (long)(16 * (wid & 3) + (lane >> 2)) * DM + (wid >> 2) * 32 + (lane & 3) * 8;
    const unsigned kdst = lds0 + LDS_K + wid * 1024, vdst = lds0 + LDS_V + wid * 1024;
#define DMA_K(t, slot) glds16(ksrc + (long)(t) * KVBLK * DM, (unsigned)__builtin_amdgcn_readfirstlane(kdst + (slot)))
#define DMA_V(t, slot) glds16(vsrc + (long)(t) * KVBLK * DM, (unsigned)__builtin_amdgcn_readfirstlane(vdst + (slot)))
    const int vb0 = (int)(lds0 + LDS_V) + ((lane >> 4) & 1) * 32 + (lane & 3) * 8 + (4 * hi + ((lane & 15) >> 2)) * 64;
    const char* Kbase = shm + LDS_K; bf16x8 kf[8];
    const lds_cptr kp0 = shm3 + LDS_K + hi * 1024 + r32 * 16; const lds_cptr vp0 = shm3 + LDS_V + ((lane >> 4) & 1) * 32 + (lane & 3) * 8 + (4 * hi + ((lane & 15) >> 2)) * 64;
    const lds_cptr cump = shm3 + LDS_CUM + t0 * 256 + r32 * 4;
    const int NT = (q0 + QB) / KVBLK - t0;
    if (!pre) { DMA_K(0, 0); DMA_V(0, 0); DMA_K(1, SLOTB); }
    bf16x8 qr[4];
#pragma unroll
    for (int d0 = 0; d0 < 4; ++d0) qr[d0] = *reinterpret_cast<const bf16x8*>(&Qw[(long)r32 * DM + d0 * 16 + hi * 8]);
    float l_reg = 0.f; f32x16 o[2]; o[0] = f32x16{}; o[1] = f32x16{};
    const int qrel = wid * QBLK + r32;
    const bf16x8 qbf = qbias_frag(-*(const LAS float*)(shm3 + LDS_CUM + (q0 + qrel) * 4) - m0l, hi);
#define CMASK(P0, P1, t) do { int jb_ = (t) - (NT - 4); if (jb_ >= 0) cmask(P0, P1, jb_, qrel, hi); } while (0)
#define CKL(t, off) (*(const LAS float*)(cump + (t) * 256 + (off)))
    f32x16 pA0, pA1, pB0, pB1;
    int sl_prev = 0, sl_cur = 0, sl_next = SLOTB;
#define ROT() do { sl_prev = sl_cur; sl_cur = sl_next; sl_next = (sl_next == (NSLOT - 1) * SLOTB) ? 0 : sl_next + SLOTB; } while (0)
    DMA_K(2, 2 * SLOTB);
    bf16x8 kb0 = kbias_frag(CKL(0, 0), hi), kb1 = kbias_frag(CKL(0, 128), hi);
    WAIT_BAR(3);
    qkt(pA0, pA1, Kbase, qr, kb0, kb1, qbf, r32, hi); asm volatile("s_nop 15\n\ts_nop 7" : "+v"(pA0), "+v"(pA1)); CMASK(pA0, pA1, 0);
#pragma unroll
    for (int r = 0; r < 16; ++r) { pA0[r] = __builtin_amdgcn_exp2f(pA0[r]); pA1[r] = __builtin_amdgcn_exp2f(pA1[r]); }
    kb0 = kbias_frag(CKL(1, 0), hi); kb1 = kbias_frag(CKL(1, 128), hi);
    WAIT_BAR(0);
    DMA_K(3, 0); DMA_V(1, SLOTB);
    ROT();
    kload8(kf, kp0 + sl_cur);
    WAIT_BAR(2);
    s16x4 vlo[8], vhi[8]; u32x4 pw0, pw1, pw2, pw3; float nk0 = 0.f, nk1 = 0.f;
#define PKW(P, B) cvtpk_s(P[B], P[B + 1])
#define PAF(k) __builtin_bit_cast(bf16x8, pw##k)
#define VFR(i) (bf16x8){vlo[i][0], vlo[i][1], vlo[i][2], vlo[i][3], vhi[i][0], vhi[i][1], vhi[i][2], vhi[i][3]}
#define PIN(x) asm volatile("" : "+v"(x))
#define GAPA(MF, A0, A1, A2, A3, W0, W1, PW_) do { MF; sacc += A0; sacc += A1; sacc += A2; sacc += A3; PIN(sacc); W0; W1; PIN(PW_); SBAR(); } while (0)
#define EX(v) __builtin_amdgcn_exp2f(v)
#define GAPB(MF, X, B) do { MF; X[B] = EX(X[B]); X[B + 1] = EX(X[B + 1]); X[B + 2] = EX(X[B + 2]); X[B + 3] = EX(X[B + 3]); PIN(X); SBAR(); } while (0)
#define VRD(i) do { vlo[i] = vtr(vp_ + (((i) >> 2) * 4096 + ((i) & 3) * 1024)); vhi[i] = vtr(vp_ + (((i) >> 2) * 4096 + ((i) & 3) * 1024 + 512)); } while (0)
#define KRD(G, j) do { if (G) { kload2(kf, kp0 + sl_next, j); SBAR(); } } while (0)
#define STEP(C0, C1, P0, P1, t, GK, GV, GL, GI) do { SBAR(); \
    const lds_cptr vp_ = vp0 + sl_prev; \
    C0 = __builtin_amdgcn_mfma_f32_32x32x16_bf16(kb0, qbf, Z16, 0, 0, 0); C1 = __builtin_amdgcn_mfma_f32_32x32x16_bf16(kb1, qbf, Z16, 0, 0, 0); \
    if (GI) { nk0 = CKL((t) + 1, 0); nk1 = CKL((t) + 1, 128); } \
    SBAR(); \
    VRD(0); SBAR(); float sacc = (P0[0] + P0[1]); \
    GAPA(C0 = __builtin_amdgcn_mfma_f32_32x32x16_bf16(kf[0], qr[0], C0, 0, 0, 0), P0[2], P0[3], P0[4], P0[5],     pw0[0] = PKW(P0, 0), pw0[1] = PKW(P0, 2), pw0); \
    VRD(4); SBAR(); GAPA(C1 = __builtin_amdgcn_mfma_f32_32x32x16_bf16(kf[1], qr[0], C1, 0, 0, 0), P0[6], P0[7], P0[8], P0[9],     pw0[2] = PKW(P0, 4), pw0[3] = PKW(P0, 6), pw0); \
    VRD(1); SBAR(); GAPA(C0 = __builtin_amdgcn_mfma_f32_32x32x16_bf16(kf[2], qr[1], C0, 0, 0, 0), P0[10], P0[11], P0[12], P0[13], pw1[0] = PKW(P0, 8), pw1[1] = PKW(P0, 10), pw1); \
    VRD(5); SBAR(); GAPA(C1 = __builtin_amdgcn_mfma_f32_32x32x16_bf16(kf[3], qr[1], C1, 0, 0, 0), P0[14], P0[15], P1[0], P1[1],   pw1[2] = PKW(P0, 12), pw1[3] = PKW(P0, 14), pw1); \
    VRD(2); SBAR(); GAPA(C0 = __builtin_amdgcn_mfma_f32_32x32x16_bf16(kf[4], qr[2], C0, 0, 0, 0), P1[2], P1[3], P1[4], P1[5],     pw2[0] = PKW(P1, 0), pw2[1] = PKW(P1, 2), pw2); \
    VRD(6); SBAR(); GAPA(C1 = __builtin_amdgcn_mfma_f32_32x32x16_bf16(kf[5], qr[2], C1, 0, 0, 0), P1[6], P1[7], P1[8], P1[9],     pw2[2] = PKW(P1, 4), pw2[3] = PKW(P1, 6), pw2); \
    VRD(3); SBAR(); GAPA(C0 = __builtin_amdgcn_mfma_f32_32x32x16_bf16(kf[6], qr[3], C0, 0, 0, 0), P1[10], P1[11], P1[12], P1[13], pw3[0] = PKW(P1, 8), pw3[1] = PKW(P1, 10), pw3); \
    VRD(7); SBAR(); GAPA(C1 = __builtin_amdgcn_mfma_f32_32x32x16_bf16(kf[7], qr[3], C1, 0, 0, 0), P1[14], P1[15], 0.f, 0.f,       pw3[2] = PKW(P1, 12), pw3[3] = PKW(P1, 14), pw3); \
    l_reg += sacc; \
    if (GI) { kb0 = kbias_frag(nk0, hi); kb1 = kbias_frag(nk1, hi); } \
    if (GK) { DMA_K((t) + 3, sl_cur); } if (GV) { DMA_V((t) + 1, sl_next); } \
    CMASK(C0, C1, t); \
    SBAR(); \
    GAPB(o[0] = __builtin_amdgcn_mfma_f32_32x32x16_bf16(PAF(0), VFR(0), o[0], 0, 0, 0), C0, 0); \
    GAPB(o[1] = __builtin_amdgcn_mfma_f32_32x32x16_bf16(PAF(0), VFR(4), o[1], 0, 0, 0), C0, 4); \
    KRD(GL, 0); GAPB(o[0] = __builtin_amdgcn_mfma_f32_32x32x16_bf16(PAF(1), VFR(1), o[0], 0, 0, 0), C0, 8); \
    KRD(GL, 1); GAPB(o[1] = __builtin_amdgcn_mfma_f32_32x32x16_bf16(PAF(1), VFR(5), o[1], 0, 0, 0), C0, 12); \
    KRD(GL, 2); GAPB(o[0] = __builtin_amdgcn_mfma_f32_32x32x16_bf16(PAF(2), VFR(2), o[0], 0, 0, 0), C1, 0); \
    KRD(GL, 3); GAPB(o[1] = __builtin_amdgcn_mfma_f32_32x32x16_bf16(PAF(2), VFR(6), o[1], 0, 0, 0), C1, 4); \
    GAPB(o[0] = __builtin_amdgcn_mfma_f32_32x32x16_bf16(PAF(3), VFR(3), o[0], 0, 0, 0), C1, 8); \
    GAPB(o[1] = __builtin_amdgcn_mfma_f32_32x32x16_bf16(PAF(3), VFR(7), o[1], 0, 0, 0), C1, 12); \
    } while (0)
    int t = 1;
#undef CMASK
#define CMASK(P0, P1, t) do {} while (0)
    for (; t + 5 < NT; t += 2) {
        STEP(pB0, pB1, pA0, pA1, t, true, true, true, true);     WAIT_BAR(2); ROT();
        STEP(pA0, pA1, pB0, pB1, t + 1, true, true, true, true); WAIT_BAR(2); ROT();
    }
#undef CMASK
#define CMASK(P0, P1, t) do { int jb_ = (t) - (NT - 4); if (jb_ >= 0) cmask(P0, P1, jb_, qrel, hi); } while (0)
#define ENDW(tt) do { if ((tt) + 3 < NT) { WAIT_BAR(2); } else if ((tt) + 2 < NT) { WAIT_BAR(1); } else { WAIT_BAR(0); } } while (0)
    for (; t + 1 < NT; t += 2) {
        STEP(pB0, pB1, pA0, pA1, t, (t + 3 < NT), (t + 1 < NT), (t + 1 < NT), (t + 1 < NT));     ENDW(t);     ROT();
        STEP(pA0, pA1, pB0, pB1, t + 1, (t + 4 < NT), (t + 2 < NT), (t + 2 < NT), (t + 2 < NT)); ENDW(t + 1); ROT();
    }
    STEP(pB0, pB1, pA0, pA1, NT - 1, false, false, false, false);
    { float sacc = pB0[0] + pB0[1];
#pragma unroll
      for (int r = 2; r < 16; ++r) sacc += pB0[r];
#pragma unroll
      for (int r = 0; r < 16; ++r) sacc += pB1[r];
      l_reg += sacc;
      pw0 = (u32x4){PKW(pB0, 0), PKW(pB0, 2), PKW(pB0, 4), PKW(pB0, 6)}; pw1 = (u32x4){PKW(pB0, 8), PKW(pB0, 10), PKW(pB0, 12), PKW(pB0, 14)}; pw2 = (u32x4){PKW(pB1, 0), PKW(pB1, 2), PKW(pB1, 4), PKW(pB1, 6)}; pw3 = (u32x4){PKW(pB1, 8), PKW(pB1, 10), PKW(pB1, 12), PKW(pB1, 14)};
      SBAR(); pv(o, vb0 + sl_cur, PAF(0), PAF(1), PAF(2), PAF(3)); }
#undef PKW
#undef PAF
#undef VFR
#undef PIN
#undef GAPA
#undef GAPB
#undef EX
#undef VRD
#undef KRD
#undef STEP
#undef ENDW
    if (nqb >= 0) { asm volatile("s_waitcnt lgkmcnt(0)\n\ts_barrier" ::: "memory");
        int t0n = 0; { const LAS float* nc = (const LAS float*)(shm3 + LDS_CUM); const float nq0 = nc[nqb * QB]; const int tmax = (nqb * QB + QB) / KVBLK - 4;
          while (t0n + 2 <= tmax && nq0 - nc[KVBLK * (t0n + 2) - 1] > fthr) t0n += 2; }
        const long dt = (long)(t0n - t0) * KVBLK * DM;
        glds16(ksrc + dt, (unsigned)__builtin_amdgcn_readfirstlane(kdst)); glds16(vsrc + dt, (unsigned)__builtin_amdgcn_readfirstlane(vdst)); glds16(ksrc + dt + (long)KVBLK * DM, (unsigned)__builtin_amdgcn_readfirstlane(kdst + SLOTB)); }
    { auto rr = __builtin_amdgcn_permlane32_swap(__float_as_uint(l_reg), __float_as_uint(l_reg), false, false); l_reg = __uint_as_float(rr[0]) + __uint_as_float(rr[1]); }
    if (hi == 0) wsf[32 + r32] = l_reg; asm volatile("s_waitcnt lgkmcnt(0)" ::: "memory");
    float rli[16];
#pragma unroll
    for (int r = 0; r < 16; ++r) rli[r] = __builtin_amdgcn_rcpf(wsf[32 + crow(r, hi)]);
    bf16* Ow = O + (rowbase + q0 + wid * QBLK) * DMODEL + h * D;
    { bf16* stg = (bf16*)(shm + LDS_OST) + wid * 2048;
#pragma unroll
      for (int r = 0; r < 16; ++r) { const int orow = crow(r, hi);
#pragma unroll
          for (int d0 = 0; d0 < 2; ++d0) stg[orow * 64 + d0 * 32 + r32] = __float2bfloat16(o[d0][r] * rli[r]); }
      asm volatile("s_waitcnt lgkmcnt(0)" ::: "memory");
      const int ch = lane & 7; const f32x4 g0 = *(const LAS f32x4*)(shm3 + LDS_OG + ch * 32), g1 = *(const LAS f32x4*)(shm3 + LDS_OG + ch * 32 + 16);
#pragma unroll
      for (int i = 0; i < 4; ++i) { const int row = i * 8 + (lane >> 3); const u32x4 v = *(const u32x4*)(stg + row * 64 + ch * 8);
          float f[8]; f[0] = bf_lo(v.x); f[1] = bf_hi(v.x); f[2] = bf_lo(v.y); f[3] = bf_hi(v.y); f[4] = bf_lo(v.z); f[5] = bf_hi(v.z); f[6] = bf_lo(v.w); f[7] = bf_hi(v.w);
          float ss = 0.f;
#pragma unroll
          for (int j = 0; j < 8; ++j) ss += f[j] * f[j];
          ss += __shfl_xor(ss, 1); ss += __shfl_xor(ss, 2); ss += __shfl_xor(ss, 4);
          const float rs = __builtin_amdgcn_rsqf(ss * (1.0f / 64.0f) + NORM_EPS);
          u32x4 w; w.x = cvtpk_s(f[0] * rs * g0[0], f[1] * rs * g0[1]); w.y = cvtpk_s(f[2] * rs * g0[2], f[3] * rs * g0[3]); w.z = cvtpk_s(f[4] * rs * g1[0], f[5] * rs * g1[1]); w.w = cvtpk_s(f[6] * rs * g1[2], f[7] * rs * g1[3]);
          *(u32x4*)(Ow + (long)row * DMODEL + ch * 8) = w; } }
    asm volatile("s_waitcnt lgkmcnt(0)\n\ts_barrier" ::: "memory");
#undef DMA_K
#undef DMA_V
#undef CMASK
#undef CKL
#undef ROT
}
constexpr int ATTN_LDS_BYTES = LDS_BYTES;

__device__ __forceinline__ float attn_prep(int b, int h, const float* logf, const float* gq, const float* gk, const float* og, char* shm) {
    int tid = threadIdx.x; asm volatile("" : "+v"(tid));
    const int lane = tid & 63, wid = tid >> 6;
    LAS float* cum = (LAS float*)((lds_cptr)shm + LDS_CUM);
    LAS float* wtot = (LAS float*)((lds_cptr)shm + LDS_WS);
    const float* src = logf + ((size_t)b * SEQ + 4 * tid) * AH + h;
    float v0 = src[0], v1 = src[AH], v2 = src[2 * AH], v3 = src[3 * AH];
    v1 += v0; v2 += v1; v3 += v2;
    float inc = v3;
#pragma unroll
    for (int o = 1; o < 64; o <<= 1) { const float y = __shfl_up(inc, o); if (lane >= o) inc += y; }
    if (lane == 63) wtot[wid] = inc;
    if (tid < D) *(LAS float*)((lds_cptr)shm + LDS_OG + tid * 4) = og[h * D + tid];
    float mq = fabsf(gq[lane]), mk = fabsf(gk[lane]);
#pragma unroll
    for (int o = 1; o < 64; o <<= 1) { mq = fmaxf(mq, __shfl_xor(mq, o)); mk = fmaxf(mk, __shfl_xor(mk, o)); }
    __syncthreads();
    float off = inc - v3;
    for (int w = 0; w < wid; ++w) off += wtot[w];
    *(LAS f32x4*)(cum + 4 * tid) = (f32x4){-(off + v0) * LOG2E, -(off + v1) * LOG2E, -(off + v2) * LOG2E, -(off + v3) * LOG2E};
    __syncthreads();
    return 8.0f * mq * mk * LOG2E;
}
#undef SBAR
#undef WAIT_BAR
}
namespace hgrn {
constexpr int C = 64, NCHUNK = SEQ / C;
constexpr int RS = 272, RS64 = 144;
constexpr int L_QT = 0, L_KT = 17408, L_QH = 34816, L_KHT = 52224, L_VT = 70656, L_ST = 89088, L_P = 123904, L_DL = 133120, L_OG = 133632, L_OUT = 134144, L_BYTES = 151552;
__device__ __forceinline__ bf16x8 frag(LAS unsigned char* lds, int base, int row, int rs, int kb) { return *(const LAS bf16x8*)(lds + base + row * rs + kb); }
__device__ __forceinline__ bf16x8 fragr(LAS unsigned char* lds, int base, int row, int kb) { return *(const LAS bf16x8*)(lds + base + row * RS + ((kb + ((row >> 3) << 5)) & 255)); }
__device__ __forceinline__ float h_lo(unsigned u) { h16x2 v = __builtin_bit_cast(h16x2, u); return (float)v.x; }
__device__ __forceinline__ float h_hi(unsigned u) { h16x2 v = __builtin_bit_cast(h16x2, u); return (float)v.y; }

template <int SKH = 0>
__device__ __forceinline__ void hgrn_unit(int b, int h, const bf16_t* P, bf16_t* AO, const float* og, LAS unsigned char* lds) {
#define HG_SYNC() do { if constexpr (SKH != 4) __syncthreads(); } while (0)
    int tid = threadIdx.x; asm volatile("" : "+v"(tid));
    const int lane = tid & 63, w = __builtin_amdgcn_readfirstlane(tid >> 6);
    const int cp = lane & 7, oct = lane >> 3, fr = lane & 15, fq = lane >> 4;
    const int k0 = 16 * w + 2 * cp;
    const size_t rowbase = (size_t)b * SEQ;
    const bf16_t* pq = P + (rowbase + 8 * oct) * PW + PC_HQ + h * HK + k0;
    const bf16_t* pg = P + (rowbase + 8 * oct) * PW + PC_HG + h * HK + k0;
    const bf16_t* pv = P + (rowbase + 8 * oct) * PW + PC_HV + h * HK + k0;
    const int tn = tid >> 3, seg = tid & 7;
    const bf16_t* pgate = P + (rowbase + tn) * PW + PC_HO + h * HK + 16 * seg;
    bf16_t* pout = AO + (rowbase + tn) * DMODEL + AW + h * HK + 16 * seg;
    if (tid < HK) *(LAS float*)(lds + L_OG + tid * 4) = og[h * HK + tid];
    for (int i = tid; i < (128 * RS) / 16; i += 512) *(LAS u32x4*)(lds + L_ST + i * 16) = (u32x4){0u, 0u, 0u, 0u};
    f32x4 sacc[8];
#pragma unroll
    for (int i = 0; i < 8; ++i) sacc[i] = (f32x4){0.f, 0.f, 0.f, 0.f};
    unsigned rq[8], rg[8], rv[8];
#pragma unroll
    for (int i = 0; i < 8; ++i) { rq[i] = *(const unsigned*)(pq + (size_t)i * PW); rg[i] = *(const unsigned*)(pg + (size_t)i * PW); rv[i] = *(const unsigned*)(pv + (size_t)i * PW); }
    const int ti = w >> 1, vh = w & 1;
#define HG_NORM(cc, G0, G1) do { if constexpr (SKH != 3) { \
        const u32x4 oa = *(const LAS u32x4*)(lds + L_OUT + tn * RS + 32 * seg), ob = *(const LAS u32x4*)(lds + L_OUT + tn * RS + 32 * seg + 16); \
        const unsigned ou[8] = {oa.x, oa.y, oa.z, oa.w, ob.x, ob.y, ob.z, ob.w}; float ss = 0.f; \
        _Pragma("unroll") for (int j = 0; j < 8; ++j) ss += bf_lo(ou[j]) * bf_lo(ou[j]) + bf_hi(ou[j]) * bf_hi(ou[j]); \
        ss += __shfl_xor(ss, 1); ss += __shfl_xor(ss, 2); ss += __shfl_xor(ss, 4); \
        const float rs = __builtin_amdgcn_rsqf(ss * (1.0f / 128.0f) + NORM_EPS); \
        const unsigned gw[8] = {G0.x, G0.y, G0.z, G0.w, G1.x, G1.y, G1.z, G1.w}; unsigned ow[8]; \
        _Pragma("unroll") for (int j = 0; j < 4; ++j) { const f32x4 g = *(const LAS f32x4*)(lds + L_OG + (16 * seg + 4 * j) * 4); \
            ow[2 * j] = cvt_pk_bf16(bf_lo(ou[2 * j]) * rs * g[0] * bf_lo(gw[2 * j]), bf_hi(ou[2 * j]) * rs * g[1] * bf_hi(gw[2 * j])); \
            ow[2 * j + 1] = cvt_pk_bf16(bf_lo(ou[2 * j + 1]) * rs * g[2] * bf_lo(gw[2 * j + 1]), bf_hi(ou[2 * j + 1]) * rs * g[3] * bf_hi(gw[2 * j + 1])); } \
        bf16_t* po = pout + (size_t)(C * (cc)) * DMODEL; \
        *(u32x4*)po = (u32x4){ow[0], ow[1], ow[2], ow[3]}; *(u32x4*)(po + 8) = (u32x4){ow[4], ow[5], ow[6], ow[7]}; } } while (0)
#pragma unroll 1
    for (int c = 0; c < NCHUNK; ++c) {
        const int cprev = c > 0 ? c - 1 : 0;
        const u32x4 gt0 = *(const u32x4*)(pgate + (size_t)(C * cprev) * PW), gt1 = *(const u32x4*)(pgate + (size_t)(C * cprev) * PW + 8);
        if constexpr (SKH != 2) {
            float f0[8], f1[8], p0[8], p1[8], s0[8], s1[8];
#pragma unroll
            for (int i = 0; i < 8; ++i) { f0[i] = h_lo(rg[i]); f1[i] = h_hi(rg[i]); }
            p0[0] = f0[0]; p1[0] = f1[0];
#pragma unroll
            for (int i = 1; i < 8; ++i) { p0[i] = p0[i - 1] * f0[i]; p1[i] = p1[i - 1] * f1[i]; }
            s0[7] = 1.0f; s1[7] = 1.0f;
#pragma unroll
            for (int i = 6; i >= 0; --i) { s0[i] = s0[i + 1] * f0[i + 1]; s1[i] = s1[i + 1] * f1[i + 1]; }
            const float lt0 = __builtin_amdgcn_logf(p0[7]), lt1 = __builtin_amdgcn_logf(p1[7]);
            float x0 = lt0, x1 = lt1;
#pragma unroll
            for (int o = 8; o < 64; o <<= 1) { const float y0 = __shfl_up(x0, o), y1 = __shfl_up(x1, o); if (lane >= o) { x0 += y0; x1 += y1; } }
            const float off0 = x0 - lt0, off1 = x1 - lt1;
            const float a0 = __shfl(x0, cp + 24), a1 = __shfl(x1, cp + 24), e0 = __shfl(x0, cp + 56), e1 = __shfl(x1, cp + 56);
            const float Eq0 = __builtin_amdgcn_exp2f(fminf(off0 - a0, 120.f)), Eq1 = __builtin_amdgcn_exp2f(fminf(off1 - a1, 120.f));
            const float Ek0 = __builtin_amdgcn_exp2f(fminf(a0 - x0, 120.f)), Ek1 = __builtin_amdgcn_exp2f(fminf(a1 - x1, 120.f));
            const float Eh0 = __builtin_amdgcn_exp2f(off0), Eh1 = __builtin_amdgcn_exp2f(off1);
            const float El0 = __builtin_amdgcn_exp2f(e0 - x0), El1 = __builtin_amdgcn_exp2f(e1 - x1);
            unsigned kh0[4], kh1[4], vt0[4], vt1[4];
            float pkh0 = 0.f, pkh1 = 0.f;
            const int rotw = (32 * (w + oct)) & 255;
#pragma unroll
            for (int i = 0; i < 8; ++i) {
                const int t = 8 * oct + i;
                const float qp0 = bf_lo(rq[i]) * p0[i], qp1 = bf_hi(rq[i]) * p1[i];
                const float ks0 = (1.0f - f0[i]) * s0[i], ks1 = (1.0f - f1[i]) * s1[i];
                *(LAS unsigned*)(lds + L_QT + t * RS + rotw + 4 * cp) = cvt_pk_bf16(qp0 * Eq0, qp1 * Eq1);
                *(LAS unsigned*)(lds + L_KT + t * RS + rotw + 4 * cp) = cvt_pk_bf16(ks0 * Ek0, ks1 * Ek1);
                *(LAS unsigned*)(lds + L_QH + t * RS + rotw + 4 * cp) = cvt_pk_bf16(qp0 * Eh0, qp1 * Eh1);
                const float kha = ks0 * El0, khb = ks1 * El1;
                if (i & 1) { kh0[i >> 1] = cvt_pk_bf16(pkh0, kha); kh1[i >> 1] = cvt_pk_bf16(pkh1, khb); vt0[i >> 1] = (rv[i - 1] & 0xffffu) | (rv[i] << 16); vt1[i >> 1] = (rv[i - 1] >> 16) | (rv[i] & 0xffff0000u); }
                else { pkh0 = kha; pkh1 = khb; }
            }
            *(LAS u32x4*)(lds + L_KHT + k0 * RS64 + 16 * oct) = (u32x4){kh0[0], kh0[1], kh0[2], kh0[3]};
            *(LAS u32x4*)(lds + L_KHT + (k0 + 1) * RS64 + 16 * oct) = (u32x4){kh1[0], kh1[1], kh1[2], kh1[3]};
            *(LAS u32x4*)(lds + L_VT + k0 * RS64 + 16 * oct) = (u32x4){vt0[0], vt0[1], vt0[2], vt0[3]};
            *(LAS u32x4*)(lds + L_VT + (k0 + 1) * RS64 + 16 * oct) = (u32x4){vt1[0], vt1[1], vt1[2], vt1[3]};
            if (oct == 0) *(LAS f32x2*)(lds + L_DL + k0 * 4) = (f32x2){__builtin_amdgcn_exp2f(e0), __builtin_amdgcn_exp2f(e1)};
        }
        if (c + 1 < NCHUNK) {
#pragma unroll
            for (int i = 0; i < 8; ++i) { const size_t o = (size_t)(C * (c + 1) + i) * PW; rq[i] = *(const unsigned*)(pq + o); rg[i] = *(const unsigned*)(pg + o); rv[i] = *(const unsigned*)(pv + o); }
        }
        HG_SYNC();
        f32x4 oacc[4] = {(f32x4){0.f, 0.f, 0.f, 0.f}, (f32x4){0.f, 0.f, 0.f, 0.f}, (f32x4){0.f, 0.f, 0.f, 0.f}, (f32x4){0.f, 0.f, 0.f, 0.f}};
        if constexpr (SKH != 1) {
            bf16x8 qf[4];
#pragma unroll
            for (int ks = 0; ks < 4; ++ks) qf[ks] = fragr(lds, L_QT, 16 * ti + fr, 64 * ks + 16 * fq);
#pragma unroll
            for (int sj = 0; sj < 2; ++sj) { const int si = 2 * vh + sj; u32x2 pk = (u32x2){0u, 0u};
                if (si <= ti) { f32x4 a = (f32x4){0.f, 0.f, 0.f, 0.f};
#pragma unroll
                    for (int ks = 0; ks < 4; ++ks) a = __builtin_amdgcn_mfma_f32_16x16x32_bf16(fragr(lds, L_KT, 16 * si + fr, 64 * ks + 16 * fq), qf[ks], a, 0, 0, 0);
                    const int s0 = 16 * si + 4 * fq, t = 16 * ti + fr;
#pragma unroll
                    for (int e = 0; e < 4; ++e) a[e] = (s0 + e <= t) ? a[e] : 0.f;
                    pk.x = cvt_pk_bf16(a[0], a[1]); pk.y = cvt_pk_bf16(a[2], a[3]); }
                *(LAS u32x2*)(lds + L_P + (16 * ti + fr) * RS64 + (16 * si + 4 * fq) * 2) = pk; }
#pragma unroll
            for (int ks = 0; ks < 4; ++ks) qf[ks] = fragr(lds, L_QH, 16 * ti + fr, 64 * ks + 16 * fq);
#pragma unroll
            for (int vj = 0; vj < 4; ++vj) { oacc[vj] = (f32x4){0.f, 0.f, 0.f, 0.f};
#pragma unroll
                for (int ks = 0; ks < 4; ++ks) oacc[vj] = __builtin_amdgcn_mfma_f32_16x16x32_bf16(frag(lds, L_ST, 16 * (4 * vh + vj) + fr, RS, 64 * ks + 16 * fq), qf[ks], oacc[vj], 0, 0, 0); }
        }
        if (c > 0) HG_NORM(c - 1, gt0, gt1);
        HG_SYNC();
        if constexpr (SKH != 1) {
            bf16x8 pf[2];
#pragma unroll
            for (int ks = 0; ks < 2; ++ks) pf[ks] = frag(lds, L_P, 16 * ti + fr, RS64, 64 * ks + 16 * fq);
#pragma unroll
            for (int vj = 0; vj < 4; ++vj)
#pragma unroll
                for (int ks = 0; ks < 2; ++ks) oacc[vj] = __builtin_amdgcn_mfma_f32_16x16x32_bf16(frag(lds, L_VT, 16 * (4 * vh + vj) + fr, RS64, 64 * ks + 16 * fq), pf[ks], oacc[vj], 0, 0, 0);
            const f32x4 dl = *(const LAS f32x4*)(lds + L_DL + (16 * w + 4 * fq) * 4);
            bf16x8 kf[2];
#pragma unroll
            for (int ks = 0; ks < 2; ++ks) kf[ks] = frag(lds, L_KHT, 16 * w + fr, RS64, 64 * ks + 16 * fq);
#pragma unroll
            for (int vt = 0; vt < 8; ++vt) { sacc[vt] = sacc[vt] * dl;
#pragma unroll
                for (int ks = 0; ks < 2; ++ks) sacc[vt] = __builtin_amdgcn_mfma_f32_16x16x32_bf16(kf[ks], frag(lds, L_VT, 16 * vt + fr, RS64, 64 * ks + 16 * fq), sacc[vt], 0, 0, 0);
                u32x2 sk; sk.x = cvt_pk_bf16(sacc[vt][0], sacc[vt][1]); sk.y = cvt_pk_bf16(sacc[vt][2], sacc[vt][3]);
                *(LAS u32x2*)(lds + L_ST + (16 * vt + fr) * RS + (16 * w + 4 * fq) * 2) = sk; }
#pragma unroll
            for (int vj = 0; vj < 4; ++vj) *(LAS u32x2*)(lds + L_OUT + (16 * ti + fr) * RS + (16 * (4 * vh + vj) + 4 * fq) * 2) = (u32x2){cvt_pk_bf16(oacc[vj][0], oacc[vj][1]), cvt_pk_bf16(oacc[vj][2], oacc[vj][3])};
        }
        HG_SYNC();
    }
    { const u32x4 gt0 = *(const u32x4*)(pgate + (size_t)(C * (NCHUNK - 1)) * PW), gt1 = *(const u32x4*)(pgate + (size_t)(C * (NCHUNK - 1)) * PW + 8); HG_NORM(NCHUNK - 1, gt0, gt1); }
    HG_SYNC();
#undef HG_NORM
#undef HG_SYNC
}
}
constexpr int NWAVES = 8;
constexpr size_t MiB = 1u << 20;
constexpr size_t WS_CTL = 0, CTL_ZERO_BYTES = 1 * MiB;
constexpr size_t WS_MOD = 1 * MiB;
constexpr size_t WS_LOGF = 2 * MiB;
constexpr size_t WS_WIN = 4 * MiB;
constexpr size_t WS_WO = 12 * MiB;
constexpr size_t WS_W1 = 14 * MiB;
constexpr size_t WS_WD = 46 * MiB;
constexpr size_t WS_LIST = 62 * MiB;
constexpr size_t WS_LW = 68 * MiB;
constexpr size_t WS_XN = 80 * MiB;
constexpr size_t WS_AO = 208 * MiB;
constexpr size_t WS_PROJ = 336 * MiB;
constexpr size_t WS_X1 = 784 * MiB;
constexpr size_t WS_END = 912 * MiB;
constexpr int CW_BAR = 4096, CW_CNT = 16384;

constexpr int RING_OFF = 0, RING_BYTES = 155648;
constexpr int LDSCTL_OFF = RING_BYTES, MISC_OFF = LDSCTL_OFF + 64, TAB_OFF = LDSCTL_OFF + 256;
constexpr int LDS_BYTES = RING_BYTES + 1024;
static_assert(hgrn::L_BYTES <= RING_BYTES && attn_body::ATTN_LDS_BYTES <= RING_BYTES && pg8::STAGE_BYTES <= RING_BYTES, "LDS map");

typedef GAS unsigned gu32;
#define RLX_AGENT __ATOMIC_RELAXED, __HIP_MEMORY_SCOPE_AGENT
#define LDS_WAIT() asm volatile("s_waitcnt lgkmcnt(0)" ::: "memory")

#define XB_TMO      128
#define XB_XCNT(j)  (256  + 64 * (j))
#define XB_XSUB(j)  (1280 + 64 * (j))
#define XB_XGEN(j)  (2304 + 64 * (j))
#define XB_TOP      3328
#define XB_TOPGEN   3392
#define XCD_BAR_WORDS 3456
#define XB_SPIN_CAP (1u << 20)
__device__ __forceinline__ unsigned xb_ld(unsigned* p)              { return __hip_atomic_load(p, __ATOMIC_RELAXED, __HIP_MEMORY_SCOPE_AGENT); }
__device__ __forceinline__ unsigned xb_add(unsigned* p, unsigned v) { return __hip_atomic_fetch_add(p, v, __ATOMIC_RELAXED, __HIP_MEMORY_SCOPE_AGENT); }
__device__ __forceinline__ unsigned xb_xcc_id() { return (unsigned)__builtin_amdgcn_s_getreg((3 << 11) | 20) & 0xFu; }
#define XB_SPIN(cond, bar) do { unsigned _sp = 0; while (cond) { __builtin_amdgcn_s_sleep(1); \
    if ((++_sp & 255u) == 0u) { if (xb_ld(&(bar)[XB_TMO])) break; if (_sp > XB_SPIN_CAP) { atomicAdd(&(bar)[XB_TMO], 1u); break; } } } } while (0)
struct XcdBarrier { unsigned* bar; unsigned x; volatile LAS unsigned* st; };
__device__ __forceinline__ XcdBarrier xcd_barrier_post(unsigned* bar, volatile LAS unsigned* st) {
    XcdBarrier b; b.bar = bar; b.x = xb_xcc_id(); b.st = st;
    if (threadIdx.x == 0) (void)xb_add(&bar[XB_XCNT(b.x)], 1u);
    return b;
}
__device__ __forceinline__ void xcd_barrier_complete(unsigned* bar, unsigned x, unsigned& nloc, unsigned& nx) {
    const unsigned G = gridDim.x * gridDim.y * gridDim.z;
    unsigned sum, cnt, mine, sp = 0u;
    for (;;) {
        sum = 0u; cnt = 0u; mine = 0u;
#pragma unroll
        for (unsigned j = 0; j < 16; ++j) { const unsigned c = xb_ld(&bar[XB_XCNT(j)]); sum += c; cnt += (c > 0u) ? 1u : 0u; mine = (j == x) ? c : mine; }
        if (sum == G) break;
        __builtin_amdgcn_s_sleep(1);
        if ((++sp & 255u) == 0u) { if (xb_ld(&bar[XB_TMO])) break; if (sp > XB_SPIN_CAP) { atomicAdd(&bar[XB_TMO], 1u); break; } }
    }
    nloc = mine > 0u ? mine : 1u; nx = cnt > 0u ? cnt : 1u;
}
__device__ __forceinline__ void xcd_barrier(const XcdBarrier& b) {
    asm volatile("s_waitcnt vmcnt(0)" ::: "memory");
    __syncthreads();
    if (threadIdx.x == 0) {
        unsigned* bar = b.bar;
        __builtin_amdgcn_s_waitcnt(0);
        unsigned nloc = b.st[0], nx = b.st[1];
        if (nloc == 0u) { xcd_barrier_complete(bar, b.x, nloc, nx); b.st[0] = nloc; b.st[1] = nx; }
        const unsigned old = xb_add(&bar[XB_XSUB(b.x)], 1u);
        const unsigned gen = old / nloc;
        if (old + 1u == (gen + 1u) * nloc) {
            __builtin_amdgcn_fence(__ATOMIC_RELEASE, "agent");
            asm volatile("s_waitcnt vmcnt(0)" ::: "memory");
            const unsigned og = xb_add(&bar[XB_TOP], 1u);
            const unsigned tg = og / nx;
            if (og + 1u == (tg + 1u) * nx) xb_add(&bar[XB_TOPGEN], 1u);
            else XB_SPIN(xb_ld(&bar[XB_TOPGEN]) == tg, bar);
            __builtin_amdgcn_fence(__ATOMIC_ACQUIRE, "agent");
            xb_add(&bar[XB_XGEN(b.x)], 1u);
            asm volatile("s_waitcnt vmcnt(0)" ::: "memory");
        } else {
            XB_SPIN(xb_ld(&bar[XB_XGEN(b.x)]) == gen, bar);
            __builtin_amdgcn_fence(__ATOMIC_ACQUIRE, "agent");
            asm volatile("s_waitcnt vmcnt(0)" ::: "memory");
        }
    }
    __syncthreads();
}

__device__ __forceinline__ f32x2 lo2(f32x4 v) { return __builtin_shufflevector(v, v, 0, 1); }
__device__ __forceinline__ f32x2 hi2(f32x4 v) { return __builtin_shufflevector(v, v, 2, 3); }
__device__ __forceinline__ f32x2 fma2(f32x2 a, f32x2 b, f32x2 c) { return __builtin_elementwise_fma(a, b, c); }
__device__ __forceinline__ float wave_sum(float v) {
#pragma unroll
    for (int o = 1; o < 64; o <<= 1) v += __shfl_xor(v, o);
    return v;
}
__device__ __forceinline__ unsigned f2bf(float f) { unsigned u = __builtin_bit_cast(unsigned, f); return (u + 0x7fffu + ((u >> 16) & 1u)) >> 16; }
__device__ __forceinline__ unsigned pk2(float lo, float hi) { return f2bf(lo) | (f2bf(hi) << 16); }

__device__ __forceinline__ void transpose_item(const float* W, int ldw, bf16_t* WT, int ldt, LAS float* scr, int lane) {
    float tv[32];
#pragma unroll
    for (int i = 0; i < 32; ++i) tv[i] = W[(size_t)(2 * i + (lane >> 5)) * ldw + (lane & 31)];
#pragma unroll
    for (int i = 0; i < 32; ++i) scr[(2 * i + (lane >> 5)) * 33 + (lane & 31)] = tv[i];
    LDS_WAIT(); asm volatile("" ::: "memory");
    const int c = lane & 7;
#pragma unroll
    for (int j = 0; j < 4; ++j) { const int n = (lane >> 3) + 8 * j; const LAS float* s = scr + (8 * c) * 33 + n;
        u32x4 o; o.x = pk2(s[0 * 33], s[1 * 33]); o.y = pk2(s[2 * 33], s[3 * 33]); o.z = pk2(s[4 * 33], s[5 * 33]); o.w = pk2(s[6 * 33], s[7 * 33]);
        *(GAS u32x4*)(WT + (size_t)n * ldt + 8 * c) = o; }
    LDS_WAIT(); asm volatile("" ::: "memory");
}

__device__ __forceinline__ void transpose_item_fp8(const float* W, int ldw, unsigned char* WT, int ldt, LAS float* scr, int lane, float scale) {
    float tv[32];
#pragma unroll
    for (int i = 0; i < 32; ++i) tv[i] = W[(size_t)(2 * i + (lane >> 5)) * ldw + (lane & 31)];
#pragma unroll
    for (int i = 0; i < 32; ++i) scr[(2 * i + (lane >> 5)) * 33 + (lane & 31)] = tv[i] * scale;
    LDS_WAIT(); asm volatile("" ::: "memory");
    const int c = lane & 3;
#pragma unroll
    for (int j = 0; j < 2; ++j) { const int n = (lane >> 2) + 16 * j; const LAS float* s = scr + (16 * c) * 33 + n;
        u32x4 o; o.x = pg8::pk4_fp8(s[0 * 33], s[1 * 33], s[2 * 33], s[3 * 33]); o.y = pg8::pk4_fp8(s[4 * 33], s[5 * 33], s[6 * 33], s[7 * 33]);
        o.z = pg8::pk4_fp8(s[8 * 33], s[9 * 33], s[10 * 33], s[11 * 33]); o.w = pg8::pk4_fp8(s[12 * 33], s[13 * 33], s[14 * 33], s[15 * 33]);
        *(GAS u32x4*)(WT + (size_t)n * ldt + 16 * c) = o; }
    LDS_WAIT(); asm volatile("" ::: "memory");
}

struct Args { const float* in[21]; float* out; unsigned char* ws; int ph_lo, ph_hi; };

__device__ __forceinline__ void p0_phase(const Args& a, LAS unsigned char* lds, int vcu, int G, int tid_, int lane_, int wave) {
    int tid = tid_; asm volatile("" : "+v"(tid)); const int lane = tid & 63;
    const float* c = a.in[1]; const float* w_ada = a.in[2]; const float* b_ada = a.in[3];
    float* mod = (float*)(a.ws + WS_MOD);
    LAS float* sc = (LAS float*)lds;
    for (int cb = vcu; cb < 6144 / 24; cb += G) {
#pragma unroll 1
        for (int i0 = tid; i0 < BATCH * DMODEL; i0 += 512 * 16) { float cv[16];
#pragma unroll
            for (int u = 0; u < 16; ++u) cv[u] = c[i0 + 512 * u];
#pragma unroll
            for (int u = 0; u < 16; ++u) { const int i = i0 + 512 * u, b = i >> 10, k = i & 1023; sc[k * 36 + b] = siluf_(cv[u]); } }
        __syncthreads();
        const int col = tid % 24, kg = tid / 24;
        float acc[32];
#pragma unroll
        for (int b = 0; b < 32; ++b) acc[b] = 0.f;
        if (kg < 16) {
            const float* wp = w_ada + (size_t)(kg * 64) * 6144 + cb * 24 + col;
            float wv[64];
#pragma unroll
            for (int k = 0; k < 64; ++k) wv[k] = wp[(size_t)k * 6144];
#pragma unroll
            for (int k = 0; k < 64; ++k) { const float w = wv[k]; const LAS f32x4* s4 = (const LAS f32x4*)(sc + (kg * 64 + k) * 36);
#pragma unroll
                for (int q = 0; q < 8; ++q) { const f32x4 s = s4[q]; acc[4 * q] += s[0] * w; acc[4 * q + 1] += s[1] * w; acc[4 * q + 2] += s[2] * w; acc[4 * q + 3] += s[3] * w; } }
        }
        __syncthreads();
        LAS float* red = (LAS float*)lds;
        if (kg < 16) {
#pragma unroll
            for (int b = 0; b < 32; ++b) red[(kg * 32 + b) * 24 + col] = acc[b]; }
        __syncthreads();
        for (int o = tid; o < 32 * 24; o += 512) { const int b = o / 24, cc = o % 24; float s = 0.f;
#pragma unroll
            for (int g = 0; g < 16; ++g) s += red[(g * 32 + b) * 24 + cc];
            mod[(size_t)b * 6144 + cb * 24 + cc] = s + b_ada[cb * 24 + cc]; }
        __syncthreads();
    }
}

constexpr int W_I_IN = 16 * 112, W_I_OUT = 16 * 32, W_I_G = 16 * 256, W_I_U = 16 * 256, W_I_D = 16 * 256, W_ITEMS = W_I_IN + W_I_OUT + W_I_G + W_I_U + W_I_D;
__device__ __forceinline__ void weight_item(const Args& a, int it, LAS float* scr, int lane_) {
    int lane = lane_; asm volatile("" : "+v"(lane));
    const float* W; int ldw, ldt; unsigned char* dst; bool f8;
    int r = it;
    if (r < W_I_IN) { const int kb = r / 112, db = r % 112, sc0 = db * 32 + (db >= 48 ? 8 : 0);
        W = a.in[5] + (size_t)(64 * kb) * INW + sc0; ldw = INW; dst = a.ws + WS_WIN + ((size_t)(db * 32) * 1024 + 64 * kb) * 2; ldt = 2048; f8 = false; }
    else if ((r -= W_I_IN) < W_I_OUT) { const int kb = r / 32, nb = r % 32;
        W = a.in[12] + (size_t)(64 * kb) * 1024 + 32 * nb; ldw = 1024; dst = a.ws + WS_WO + ((size_t)(32 * nb) * 1024 + 64 * kb) * 2; ldt = 2048; f8 = false; }
    else if ((r -= W_I_OUT) < W_I_G + W_I_U) { const bool up = r >= W_I_G; if (up) r -= W_I_G; const int e = r / 256, q = r % 256, kb = q / 16, nb = q % 16;
        W = (up ? a.in[19] : a.in[18]) + (size_t)e * 1024 * 512 + (size_t)(64 * kb) * 512 + 32 * nb; ldw = 512; dst = a.ws + WS_W1 + ((size_t)e * 1024 + (up ? 512 : 0) + 32 * nb) * 1024 + 64 * kb; ldt = 1024; f8 = true; }
    else { r -= W_I_G + W_I_U; const int e = r / 256, q = r % 256, kb = q / 32, nb = q % 32;
        W = a.in[20] + (size_t)e * 512 * 1024 + (size_t)(64 * kb) * 1024 + 32 * nb; ldw = 1024; dst = a.ws + WS_WD + ((size_t)e * 1024 + 32 * nb) * 512 + 64 * kb; ldt = 512; f8 = true; }
    const float scale = f8 ? W_SCALE : 1.0f;
    const float* wp = W + (size_t)(lane >> 5) * ldw + (lane & 31);
#pragma unroll
    for (int hh = 0; hh < 2; ++hh) { float tv[16];
#pragma unroll
        for (int i = 0; i < 16; ++i) tv[i] = wp[(size_t)(2 * (16 * hh + i)) * ldw];
#pragma unroll
        for (int i = 0; i < 16; ++i) scr[(2 * (16 * hh + i) + (lane >> 5)) * 33 + (lane & 31)] = tv[i] * scale; }
    LDS_WAIT(); asm volatile("" ::: "memory");
    if (f8) { const int c = lane & 3;
#pragma unroll
        for (int j = 0; j < 2; ++j) { const int n = (lane >> 2) + 16 * j; const LAS float* sp = scr + (16 * c) * 33 + n;
            u32x4 o; o.x = pg8::pk4_fp8(sp[0 * 33], sp[1 * 33], sp[2 * 33], sp[3 * 33]); o.y = pg8::pk4_fp8(sp[4 * 33], sp[5 * 33], sp[6 * 33], sp[7 * 33]);
            o.z = pg8::pk4_fp8(sp[8 * 33], sp[9 * 33], sp[10 * 33], sp[11 * 33]); o.w = pg8::pk4_fp8(sp[12 * 33], sp[13 * 33], sp[14 * 33], sp[15 * 33]);
            *(GAS u32x4*)(dst + (size_t)n * ldt + 16 * c) = o; } }
    else { const int c = lane & 7;
#pragma unroll
        for (int j = 0; j < 4; ++j) { const int n = (lane >> 3) + 8 * j; const LAS float* sp = scr + (8 * c) * 33 + n;
            u32x4 o; o.x = pk2(sp[0 * 33], sp[1 * 33]); o.y = pk2(sp[2 * 33], sp[3 * 33]); o.z = pk2(sp[4 * 33], sp[5 * 33]); o.w = pk2(sp[6 * 33], sp[7 * 33]);
            *(GAS u32x4*)(dst + (size_t)n * ldt + 16 * c) = o; } }
    LDS_WAIT(); asm volatile("" ::: "memory");
}

__device__ __forceinline__ void reduce_scatter16(float (&v)[16], int lane) {
    { const bool hi = lane & 32;
#pragma unroll
      for (int i = 0; i < 8; ++i) { const float snd = hi ? v[i] : v[8 + i], kp = hi ? v[8 + i] : v[i]; v[i] = kp + __shfl_xor(snd, 32); } }
    { const bool hi = lane & 16;
#pragma unroll
      for (int i = 0; i < 4; ++i) { const float snd = hi ? v[i] : v[4 + i], kp = hi ? v[4 + i] : v[i]; v[i] = kp + __shfl_xor(snd, 16); } }
    { const bool hi = lane & 8;
#pragma unroll
      for (int i = 0; i < 2; ++i) { const float snd = hi ? v[i] : v[2 + i], kp = hi ? v[2 + i] : v[i]; v[i] = kp + __shfl_xor(snd, 8); } }
    { const bool hi = lane & 4; const float snd = hi ? v[0] : v[1], kp = hi ? v[1] : v[0]; v[0] = kp + __shfl_xor(snd, 4); }
    v[0] += __shfl_xor(v[0], 2); v[0] += __shfl_xor(v[0], 1);
}
__device__ __forceinline__ void reduce_scatter4(float (&v)[4], int lane) {
    { const bool hi = lane & 32;
#pragma unroll
      for (int i = 0; i < 2; ++i) { const float snd = hi ? v[i] : v[2 + i], kp = hi ? v[2 + i] : v[i]; v[i] = kp + __shfl_xor(snd, 32); } }
    { const bool hi = lane & 16; const float snd = hi ? v[0] : v[1], kp = hi ? v[1] : v[0]; v[0] = kp + __shfl_xor(snd, 16); }
#pragma unroll
    for (int o = 8; o > 0; o >>= 1) v[0] += __shfl_xor(v[0], o);
}
__device__ __forceinline__ void p1_phase(const Args& a, LAS unsigned char* lds, int vcu, int G, int tid_, int lane_, int wave) {
    int tid = tid_; asm volatile("" : "+v"(tid)); const int lane = tid & 63;
    const float* x = a.in[0]; const float* g1 = a.in[4];
    const float* mod = (const float*)(a.ws + WS_MOD); bf16_t* XN = (bf16_t*)(a.ws + WS_XN);
    LAS float* scr = (LAS float*)(lds + wave * 8448);
    int witem = vcu * NWAVES + wave;
    for (int gw = vcu * NWAVES + wave; gw < MTOK / 32; gw += G * NWAVES) {
        const int row0 = gw * 32, b = row0 >> 11;
        f32x4 A1[4], B1[4];
#pragma unroll
        for (int j = 0; j < 4; ++j) { const int cidx = 4 * lane + 256 * j; const f32x4 g = *(const f32x4*)(g1 + cidx), s = *(const f32x4*)(mod + (size_t)b * 6144 + 1024 + cidx);
            A1[j] = g * (s + 1.0f); B1[j] = *(const f32x4*)(mod + (size_t)b * 6144 + cidx); }
        const float* xp = x + (size_t)row0 * DMODEL + 4 * lane;
        f32x4 va[2][4], vb[2][4];
#define P1_LOAD(buf, rp) do { _Pragma("unroll") for (int q = 0; q < 2; ++q) _Pragma("unroll") for (int j = 0; j < 4; ++j) buf[q][j] = *(const f32x4*)(xp + (size_t)(2 * (rp) + q) * DMODEL + 256 * j); } while (0)
#define P1_BODY(buf, itx) do { const int r0 = row0 + 2 * (itx); float ss[2]; f32x4 v[2][4]; \
            _Pragma("unroll") for (int q = 0; q < 2; ++q) { f32x2 s2 = {0.f, 0.f}; _Pragma("unroll") for (int j = 0; j < 4; ++j) { s2 = fma2(lo2(buf[q][j]), lo2(buf[q][j]), s2); s2 = fma2(hi2(buf[q][j]), hi2(buf[q][j]), s2); } ss[q] = s2.x + s2.y; } \
            _Pragma("unroll") for (int q = 0; q < 2; ++q) { const float rstd = __builtin_amdgcn_rsqf(wave_sum(ss[q]) * (1.0f / DMODEL) + NORM_EPS); \
                _Pragma("unroll") for (int j = 0; j < 4; ++j) { v[q][j] = buf[q][j] * rstd * A1[j] + B1[j]; \
                    *(u32x2*)(XN + (size_t)(r0 + q) * DMODEL + 4 * lane + 256 * j) = (u32x2){cvt_pk_bf16(v[q][j][0], v[q][j][1]), cvt_pk_bf16(v[q][j][2], v[q][j][3])}; } } \
            if ((itx) + 2 < 16) P1_LOAD(buf, (itx) + 2); } while (0)
        P1_LOAD(va, 0); P1_LOAD(vb, 1);
#define P1_WITEM() do { if (witem < W_ITEMS) { weight_item(a, witem, scr, lane); witem += G * NWAVES; } } while (0)
#pragma unroll 1
        for (int it = 0; it < 16; it += 2) { P1_BODY(va, it); P1_BODY(vb, it + 1); P1_WITEM(); }
#undef P1_WITEM
#undef P1_LOAD
#undef P1_BODY
    }
    for (; witem < W_ITEMS; witem += G * NWAVES) weight_item(a, witem, scr, lane);
}

__device__ __forceinline__ void p5_phase(const Args& a, LAS unsigned char* lds, int vcu, int G, int tid_, int lane_, int wave) {
    int tid = tid_; asm volatile("" : "+v"(tid)); const int lane = tid & 63, fr = lane & 15, fq = lane >> 4;
    const bf16_t* x1 = (const bf16_t*)(a.ws + WS_X1); const float* g2 = a.in[13]; const float* w_rg = a.in[14]; const float* b_rg = a.in[15]; const float* w_re = a.in[16]; const float* b_re = a.in[17];
    const float* mod = (const float*)(a.ws + WS_MOD); unsigned char* XN8 = a.ws + WS_XN;
    int* list = (int*)(a.ws + WS_LIST); f32x2* lw = (f32x2*)(a.ws + WS_LW); unsigned* gcnt = (unsigned*)(a.ws + WS_CTL) + CW_CNT;
    constexpr int WROW = 2064;
    LAS unsigned char* wth = lds; LAS unsigned char* wtl = lds + 20 * WROW;
    LAS float* ab = (LAS float*)(lds + 40 * WROW);
    LAS float* bias = (LAS float*)(lds + 40 * WROW + 8192);
    LAS int* hist = (LAS int*)(lds + 40 * WROW + 8192 + 128);
    LAS float* zs = (LAS float*)(lds + 40 * WROW + 8192 + 128 + 256) + wave * (32 * 20);
    for (int k = tid; k < 1024; k += 512) { const f32x4 g4 = *(const f32x4*)(w_rg + 4 * k);
#pragma unroll
        for (int o = 0; o < 20; ++o) { float wv; if (o < 4) wv = g4[o]; else { const f32x4 e4 = *(const f32x4*)(w_re + 16 * k + 4 * ((o - 4) >> 2)); wv = e4[(o - 4) & 3]; }
            const unsigned hb = f2bf(wv); const float hf = __uint_as_float(hb << 16); const unsigned lb = f2bf(wv - hf);
            *(LAS unsigned short*)(wth + o * WROW + 2 * k) = (unsigned short)hb; *(LAS unsigned short*)(wtl + o * WROW + 2 * k) = (unsigned short)lb; } }
    if (tid < 4) bias[tid] = b_rg[tid]; else if (tid < 20) bias[tid] = b_re[tid - 4];
    for (int gw0 = vcu * NWAVES; gw0 < MTOK / 32; gw0 += G * NWAVES) {
        const int gw = gw0 + wave, row0 = gw * 32, b = (gw0 * 32) >> 11;
        __syncthreads();
        if (tid < 64) hist[tid] = 0;
        for (int k = tid; k < 1024; k += 512) { ab[k] = g2[k] * (1.0f + mod[(size_t)b * 6144 + 4096 + k]); ab[1024 + k] = mod[(size_t)b * 6144 + 3072 + k]; }
        __syncthreads();
#pragma unroll 1
        for (int grp = 0; grp < 2; ++grp) {
            const int row = row0 + 16 * grp + fr;
            const bf16_t* xp = x1 + (size_t)row * DMODEL + 8 * fq;
            float ss = 0.f;
#pragma unroll 8
            for (int s_ = 0; s_ < 32; ++s_) { const u32x4 xv = *(const u32x4*)(xp + 32 * s_); const unsigned wd[4] = {xv.x, xv.y, xv.z, xv.w};
#pragma unroll
                for (int j = 0; j < 4; ++j) { const float p = bf_lo(wd[j]), q = bf_hi(wd[j]); ss = __builtin_fmaf(p, p, ss); ss = __builtin_fmaf(q, q, ss); } }
            ss += __shfl_xor(ss, 16); ss += __shfl_xor(ss, 32);
            const float rstd = __builtin_amdgcn_rsqf(ss * (1.0f / DMODEL) + NORM_EPS);
            f32x4 acc0 = {0.f, 0.f, 0.f, 0.f}, acc1 = {0.f, 0.f, 0.f, 0.f};
            unsigned char* xo = XN8 + (size_t)row * DMODEL + 8 * fq;
            const LAS unsigned char* wp0 = wth + fr * WROW + 16 * fq; const LAS unsigned char* wp1 = wth + (16 + (fr & 3)) * WROW + 16 * fq;
            const LAS float* abp = ab + 8 * fq;
#pragma unroll 4
            for (int s_ = 0; s_ < 32; ++s_) {
                const u32x4 xv = *(const u32x4*)(xp + 32 * s_); const unsigned wd[4] = {xv.x, xv.y, xv.z, xv.w};
                const f32x4 a0 = *(const LAS f32x4*)(abp + 32 * s_), a1 = *(const LAS f32x4*)(abp + 32 * s_ + 4);
                const f32x4 b0 = *(const LAS f32x4*)(abp + 1024 + 32 * s_), b1 = *(const LAS f32x4*)(abp + 1024 + 32 * s_ + 4);
                float h[8];
                h[0] = __builtin_fmaf(bf_lo(wd[0]) * rstd, a0[0], b0[0]); h[1] = __builtin_fmaf(bf_hi(wd[0]) * rstd, a0[1], b0[1]);
                h[2] = __builtin_fmaf(bf_lo(wd[1]) * rstd, a0[2], b0[2]); h[3] = __builtin_fmaf(bf_hi(wd[1]) * rstd, a0[3], b0[3]);
                h[4] = __builtin_fmaf(bf_lo(wd[2]) * rstd, a1[0], b1[0]); h[5] = __builtin_fmaf(bf_hi(wd[2]) * rstd, a1[1], b1[1]);
                h[6] = __builtin_fmaf(bf_lo(wd[3]) * rstd, a1[2], b1[2]); h[7] = __builtin_fmaf(bf_hi(wd[3]) * rstd, a1[3], b1[3]);
                *(u32x2*)(xo + 32 * s_) = (u32x2){pg8::pk4_fp8(h[0] * XN2_SCALE, h[1] * XN2_SCALE, h[2] * XN2_SCALE, h[3] * XN2_SCALE), pg8::pk4_fp8(h[4] * XN2_SCALE, h[5] * XN2_SCALE, h[6] * XN2_SCALE, h[7] * XN2_SCALE)};
                const unsigned t0 = cvt_pk_bf16(h[0], h[1]), t1 = cvt_pk_bf16(h[2], h[3]), t2 = cvt_pk_bf16(h[4], h[5]), t3 = cvt_pk_bf16(h[6], h[7]);
                const u32x4 hw = (u32x4){t0, t1, t2, t3};
                const u32x4 lwv = (u32x4){cvt_pk_bf16(h[0] - bf_lo(t0), h[1] - bf_hi(t0)), cvt_pk_bf16(h[2] - bf_lo(t1), h[3] - bf_hi(t1)), cvt_pk_bf16(h[4] - bf_lo(t2), h[5] - bf_hi(t2)), cvt_pk_bf16(h[6] - bf_lo(t3), h[7] - bf_hi(t3))};
                const bf16x8 Ah = __builtin_bit_cast(bf16x8, hw), Al = __builtin_bit_cast(bf16x8, lwv);
                const bf16x8 wh0 = *(const LAS bf16x8*)(wp0 + 64 * s_), wl0 = *(const LAS bf16x8*)(wp0 + 20 * WROW + 64 * s_);
                const bf16x8 wh1 = *(const LAS bf16x8*)(wp1 + 64 * s_), wl1 = *(const LAS bf16x8*)(wp1 + 20 * WROW + 64 * s_);
                acc0 = __builtin_amdgcn_mfma_f32_16x16x32_bf16(wh0, Ah, acc0, 0, 0, 0); acc0 = __builtin_amdgcn_mfma_f32_16x16x32_bf16(wh0, Al, acc0, 0, 0, 0); acc0 = __builtin_amdgcn_mfma_f32_16x16x32_bf16(wl0, Ah, acc0, 0, 0, 0);
                acc1 = __builtin_amdgcn_mfma_f32_16x16x32_bf16(wh1, Ah, acc1, 0, 0, 0); acc1 = __builtin_amdgcn_mfma_f32_16x16x32_bf16(wh1, Al, acc1, 0, 0, 0); acc1 = __builtin_amdgcn_mfma_f32_16x16x32_bf16(wl1, Ah, acc1, 0, 0, 0);
            }
            *(LAS f32x4*)(zs + (16 * grp + fr) * 20 + 4 * fq) = acc0;
            if (fq == 0) *(LAS f32x4*)(zs + (16 * grp + fr) * 20 + 16) = acc1;
        }
        int my_cls = 0; float my_wlo = 0.f, my_whi = 0.f;
        if (lane < 32) {
            float lg[20];
#pragma unroll
            for (int o = 0; o < 20; ++o) lg[o] = zs[lane * 20 + o] + bias[o];
            int gi = 0; float gm = lg[0];
#pragma unroll
            for (int o = 1; o < 4; ++o) if (lg[o] > gm) { gm = lg[o]; gi = o; }
            float gs = 0.f;
#pragma unroll
            for (int o = 0; o < 4; ++o) gs += __expf(lg[o] - gm);
            const float gp = 1.0f / gs;
            float el[4];
#pragma unroll
            for (int j = 0; j < 4; ++j) el[j] = gi == 0 ? lg[4 + j] : (gi == 1 ? lg[8 + j] : (gi == 2 ? lg[12 + j] : lg[16 + j]));
            int i1 = 0; float m1 = el[0];
#pragma unroll
            for (int j = 1; j < 4; ++j) if (el[j] > m1) { m1 = el[j]; i1 = j; }
            int i2 = -1; float m2 = -INFINITY;
#pragma unroll
            for (int j = 0; j < 4; ++j) if (j != i1 && el[j] > m2) { m2 = el[j]; i2 = j; }
            const float w1 = gp / (1.0f + __expf(m2 - m1)), w2 = gp - w1;
            const int lo = i1 < i2 ? i1 : i2, hi = i1 < i2 ? i2 : i1;
            my_wlo = i1 < i2 ? w1 : w2; my_whi = i1 < i2 ? w2 : w1;
            my_cls = gi * 6 + (lo == 0 ? hi - 1 : (lo == 1 ? hi + 1 : 5));
        }
        int rank = 0;
        if (lane < 32) rank = __hip_atomic_fetch_add(&hist[my_cls], 1, __ATOMIC_RELAXED, __HIP_MEMORY_SCOPE_WORKGROUP);
        __syncthreads();
        if (tid < NCLS) hist[32 + tid] = (int)__hip_atomic_fetch_add(gcnt + tid, (unsigned)hist[tid], __ATOMIC_RELAXED, __HIP_MEMORY_SCOPE_AGENT);
        __syncthreads();
        if (lane < 32) { const size_t pos = (size_t)my_cls * MTOK + hist[32 + my_cls] + rank; list[pos] = row0 + lane; lw[pos] = (f32x2){my_wlo, my_whi}; }
    }
}
#define SHADOW_P7_DENSE 0
__global__ void __launch_bounds__(NWAVES * 64, 2) layer_fwd(Args args) {
    extern __shared__ __attribute__((aligned(16))) unsigned char lds_raw[];
    LAS unsigned char* lds = (LAS unsigned char*)lds_raw;
    const int tid = threadIdx.x, lane = tid & 63, wave = __builtin_amdgcn_readfirstlane(tid >> 6);
    const int G = gridDim.x, bx = blockIdx.x;
    const int vcu = (G % 8 == 0) ? (bx % 8) * (G / 8) + bx / 8 : bx;
    unsigned char* ws = args.ws;
    gu32* ctl = (gu32*)(ws + WS_CTL);
    for (int u = tid; u < (LDS_BYTES - LDSCTL_OFF) / 4; u += NWAVES * 64) ((LAS unsigned*)(lds + LDSCTL_OFF))[u] = 0u;
    __syncthreads();
    volatile LAS unsigned* MISC = (volatile LAS unsigned*)(lds + MISC_OFF);
    XcdBarrier bar; bar.bar = (unsigned*)(ctl + CW_BAR); bar.x = 0; bar.st = nullptr;
    const int lo = args.ph_lo, hi = args.ph_hi;
    const bool one = (hi - lo) > 1;
    if (one) bar = xcd_barrier_post((unsigned*)(ctl + CW_BAR), MISC + 8);
#ifndef PH_MASK
#define PH_MASK 0xff
#endif
#ifndef REP_HGRN
#define REP_HGRN 1
#endif
#ifndef REP_ATTN
#define REP_ATTN 1
#endif
#ifndef REP_P2
#define REP_P2 1
#endif
#ifndef REP_P4
#define REP_P4 1
#endif
#ifndef REP_P6
#define REP_P6 1
#endif
#ifndef REP_P0
#define REP_P0 1
#endif
#ifndef REP_P1
#define REP_P1 1
#endif
#define IN(k) (((PH_MASK >> (k)) & 1) && lo <= (k) && (k) < hi)
#define SEAM(k) do { if (IN(k) && IN((k) + 1)) xcd_barrier(bar); } while (0)

    const bf16_t* WinT = (const bf16_t*)(ws + WS_WIN); const bf16_t* WoT = (const bf16_t*)(ws + WS_WO); const unsigned char* W1T = ws + WS_W1; const unsigned char* WdT = ws + WS_WD;
    bf16_t* XN = (bf16_t*)(ws + WS_XN); bf16_t* AO = (bf16_t*)(ws + WS_AO); bf16_t* PROJ = (bf16_t*)(ws + WS_PROJ); unsigned char* ACT = ws + WS_PROJ;
    const float* mod = (const float*)(ws + WS_MOD);

    if (IN(0)) { for (int rep = 0; rep < REP_P0; ++rep) { p0_phase(args, lds, vcu, G, tid, lane, wave); __syncthreads(); } }
    SEAM(0);
    if (IN(1)) { for (int rep = 0; rep < REP_P1; ++rep) { p1_phase(args, lds, vcu, G, tid, lane, wave); __syncthreads(); } }
    SEAM(1);
    if (IN(2)) {
        pg8::ProjPol S; S.A = (const char*)XN; S.Bt = (const char*)WinT; S.lda = 2048; S.ldb = 2048; S.hstepB = 32 * 2048; S.ks = 16; S.nN = 14; S.G = G; S.c = bx; S.bt_tile_rows = 256;
        pg8::EpiProj E{PROJ, args.in[7], args.in[8], args.in[10], (float*)(ws + WS_LOGF), args.in[6]};
        for (int k = tid; k < 1024; k += 512) { const f32x4 u0 = *(const f32x4*)(args.in[5] + (size_t)k * INW + 1536), u1 = *(const f32x4*)(args.in[5] + (size_t)k * INW + 1540);
#pragma unroll
            for (int h = 0; h < 4; ++h) { *(LAS unsigned short*)(lds + pg8::STAGE_BYTES + h * pg8::FOXROW + 2 * k) = (unsigned short)f2bf(u0[h]); *(LAS unsigned short*)(lds + pg8::STAGE_BYTES + (4 + h) * pg8::FOXROW + 2 * k) = (unsigned short)f2bf(u1[h]); } }
        __syncthreads();
        for (int rep = 0; rep < REP_P2; ++rep) pg8::gemm_phase(lds + RING_OFF, S, E);
    }
    SEAM(2);
    if (IN(3)) {
        const bool part = (G == 256);
        const int pp = bx >> 1, role = bx & 1;
#ifndef NO_HGRN
        for (int rep = 0; rep < REP_HGRN; ++rep) {
            if (part) { if (role == 0) hgrn::hgrn_unit(pp / HH, pp % HH, PROJ, AO, args.in[11], lds + RING_OFF); }
            else for (int u = bx; u < BATCH * HH; u += G) hgrn::hgrn_unit(u / HH, u % HH, PROJ, AO, args.in[11], lds + RING_OFF);
        }
#ifdef SHADOW_HGRN
        if (part && role == 0) hgrn::hgrn_unit<SHADOW_HGRN>(pp / HH, pp % HH, PROJ, (bf16_t*)(ws + WS_LIST), args.in[11], lds + RING_OFF);
#endif
        __syncthreads();
#endif
#ifndef NO_ATTN
        for (int rep = 0; rep < REP_ATTN; ++rep) {
#ifndef P3_N0
#define P3_N0 1
#endif
            const int nun = part ? (role ? 16 - P3_N0 : P3_N0) : 8 * ((BATCH * AH - vcu + G - 1) / G);
            int cur_bh = -1; float m0l = 0.f;
            for (int i = 0; i < nun; ++i) {
                int bh, qb;
                if (part) { if (role) { bh = i < 8 ? 2 * pp : 2 * pp + 1; qb = i < 8 ? 7 - i : 15 - i; } else { bh = 2 * pp + 1; qb = P3_N0 - 1 - i; } }
                else { bh = vcu + (i >> 3) * G; qb = 7 - (i & 7); }
                bool fresh = false;
                if (bh != cur_bh) { __syncthreads(); m0l = attn_body::attn_prep(bh / AH, bh % AH, (const float*)(ws + WS_LOGF), args.in[7], args.in[8], args.in[9], (char*)lds_raw + RING_OFF); cur_bh = bh; fresh = true; }
                int nbh = -1, nqb = -1;
                if (i + 1 < nun) { const int j = i + 1;
                    if (part) { if (role) { nbh = j < 8 ? 2 * pp : 2 * pp + 1; nqb = j < 8 ? 7 - j : 15 - j; } else { nbh = 2 * pp + 1; nqb = P3_N0 - 1 - j; } }
                    else { nbh = vcu + (j >> 3) * G; nqb = 7 - (j & 7); } }
                attn_body::attn_unit(bh / AH, bh % AH, qb, (const attn_body::bf16*)PROJ, (attn_body::bf16*)AO, m0l, (char*)lds_raw + RING_OFF, !fresh, nbh == bh ? nqb : -1);
            }
            __syncthreads();
        }
#endif
    }
    SEAM(3);
    if (IN(4)) {
        pg8::PlainPol S; S.A = (const char*)AO; S.Bt = (const char*)WoT; S.lda = 2048; S.ldb = 2048; S.hstepB = 128 * 2048; S.ks = 16; S.nN = 4; S.G = G; S.c = bx; S.bt_tile_rows = 256;
        pg8::EpiRes E{args.in[0], (bf16_t*)(ws + WS_X1), mod + 2048};
        for (int rep = 0; rep < REP_P4; ++rep) pg8::gemm_phase(lds + RING_OFF, S, E);
    }
    SEAM(4);
#ifndef REP_P5
#define REP_P5 1
#endif
    if (IN(5)) { for (int rep = 0; rep < REP_P5; ++rep) { if (rep) { xcd_barrier(bar); if (bx == 0 && tid < NCLS) __hip_atomic_store(ctl + CW_CNT + tid, 0u, RLX_AGENT); xcd_barrier(bar); } p5_phase(args, lds, vcu, G, tid, lane, wave); } }
    SEAM(5);
    LAS int* tab = (LAS int*)(lds + TAB_OFF);
    if (IN(6) || IN(7)) {
        if (tid < NCLS) tab[tid] = (int)__hip_atomic_load(ctl + CW_CNT + tid, RLX_AGENT);
        __syncthreads();
        if (tid == 0) { int p = 0; for (int c = 0; c < NCLS; ++c) { tab[32 + c] = p; p += (tab[c] + 255) >> 8; } tab[32 + NCLS] = p; }
        __syncthreads();
    }
    const pg8::MoeTab mt{tab};
    if (IN(6)) {
        pg8::Moe1Pol S; S.A = (const char*)XN; S.W1T = (const char*)W1T; S.list = (const int*)(ws + WS_LIST); S.tab = mt; S.lda = 1024; S.ldb = 1024; S.hstepB = 512 * 1024; S.ks = 8; S.G = G; S.c = bx; S.sclW = SCL_W; S.sclX = SCL_XN2;
        pg8::EpiSwiglu E{ACT, (const float*)(ws + WS_LW), mt};
        for (int rep = 0; rep < REP_P6; ++rep) pg8::gemm_phase(lds + RING_OFF, S, E);
#ifdef SHADOW_P6
        { pg8::EpiSwiglu E2{ws + WS_AO, (const float*)(ws + WS_LW), mt}; pg8::gemm_phase<pg8::Moe1Pol, pg8::EpiSwiglu, SHADOW_P6>(lds + RING_OFF, S, E2); }
#endif
    }
    SEAM(6);
    if (IN(7)) {
        pg8::Moe2Pol S; S.A = (const char*)ACT; S.WdT = (const char*)WdT; S.tab = mt; S.lda = 1024; S.ldb = 512; S.hstepB = 128 * 512; S.ks = 4; S.G = G; S.c = bx; S.sclW = SCL_W; S.sclX = SCL_ACT;
        pg8::EpiMoeOut E{args.out, (const bf16_t*)(ws + WS_X1), mod + 5120, (const int*)(ws + WS_LIST), mt, 0};
#ifndef REP_P7
#define REP_P7 1
#endif
#ifndef P7_STAGGER
#define P7_STAGGER 0
#endif
        if (P7_STAGGER > 0) {
            const unsigned long long t0s = __builtin_amdgcn_s_memrealtime(), dl = (unsigned long long)((bx >> 3) & 1) * (P7_STAGGER * 100);
            while (__builtin_amdgcn_s_memrealtime() - t0s < dl) __builtin_amdgcn_s_sleep(8);
        }
        for (int rep = 0; rep < REP_P7; ++rep) pg8::gemm_phase(lds + RING_OFF, S, E);
#ifdef SHADOW_P7
        { pg8::EpiMoeOut E2{(float*)(ws + WS_XN), (const bf16_t*)(ws + WS_X1), mod + 5120, (const int*)(ws + WS_LIST), mt, SHADOW_P7_DENSE}; pg8::gemm_phase<pg8::Moe2Pol, pg8::EpiMoeOut, SHADOW_P7>(lds + RING_OFF, S, E2); }
#endif
    }
#ifdef DIAG
    if (lo <= 8 && 8 < hi) {
        for (size_t i = (size_t)bx * 512 + tid; i < (size_t)MTOK * 1024; i += (size_t)G * 512) {
            const size_t row = i >> 10, c = i & 1023; float v;
            if (DIAG == 1) v = bf_lo((unsigned)XN[i]);
            else if (DIAG == 2) v = bf_lo((unsigned)PROJ[row * PW + c]) + bf_lo((unsigned)PROJ[row * PW + 1024 + c]) + bf_lo((unsigned)PROJ[row * PW + 2048 + c]) + bf_lo((unsigned)PROJ[row * PW + 2560 + c]);
            else if (DIAG == 3) v = bf_lo((unsigned)AO[i]);
            else if (DIAG == 4) v = bf_lo((unsigned)((const bf16_t*)(ws + WS_X1))[i]);
            else v = args.in[0][i];
            args.out[i] = v;
        }
    }
#endif
#undef IN
#undef SEAM
}

#ifndef MK_PER_PHASE
#define MK_PER_PHASE 0
#endif
extern "C" void kernel_launch(void* const* d_in, const int* in_sizes, int n_in, void* d_out, int out_size, void* d_ws, size_t ws_size, hipStream_t stream) {
    static int grid = 0;
    if (grid == 0) {
        if (n_in != 21 || in_sizes[0] != MTOK * DMODEL || out_size != MTOK * DMODEL || ws_size < WS_END) { fprintf(stderr, "kernel_launch: unexpected shapes (n_in %d, in0 %d, out %d, ws %zu); nothing launched\n", n_in, n_in > 0 ? in_sizes[0] : -1, out_size, ws_size); grid = -1; return; }
        int dev = 0, cus = 0, per_cu = 0;
        if (hipGetDevice(&dev) != hipSuccess || hipDeviceGetAttribute(&cus, hipDeviceAttributeMultiprocessorCount, dev) != hipSuccess) { grid = -1; return; }
        if (hipFuncSetAttribute((const void*)layer_fwd, hipFuncAttributeMaxDynamicSharedMemorySize, LDS_BYTES) != hipSuccess) { fprintf(stderr, "kernel_launch: hipFuncSetAttribute failed\n"); grid = -1; return; }
        if (hipOccupancyMaxActiveBlocksPerMultiprocessor(&per_cu, (const void*)layer_fwd, NWAVES * 64, LDS_BYTES) != hipSuccess || per_cu < 1) { fprintf(stderr, "kernel_launch: occupancy query says %d workgroups per CU\n", per_cu); per_cu = 1; }
        (void)hipGetLastError();
        grid = cus;
    }
    if (grid < 0) return;
    (void)hipMemsetAsync((char*)d_ws + WS_CTL, 0, CTL_ZERO_BYTES, stream);
    Args a{};
    for (int i = 0; i < 21; ++i) a.in[i] = (const float*)d_in[i];
    a.out = (float*)d_out; a.ws = (unsigned char*)d_ws;
#if MK_PER_PHASE
    for (int p = 0; p < 9; ++p) { a.ph_lo = p; a.ph_hi = p + 1; hipLaunchKernelGGL(layer_fwd, dim3(grid), dim3(NWAVES * 64), LDS_BYTES, stream, a); }
#else
#ifdef DIAG
    a.ph_lo = 0; a.ph_hi = 9;
#else
    a.ph_lo = 0; a.ph_hi = 8;
#endif
    hipLaunchKernelGGL(layer_fwd, dim3(grid), dim3(NWAVES * 64), LDS_BYTES, stream, a);
#endif
    const hipError_t le = hipPeekAtLastError();
    if (le != hipSuccess) fprintf(stderr, "kernel_launch: launch failed: %s\n", hipGetErrorName(le));
}
```
